# Optimizing an MI355X kernel written in HIP

```python
import math
import jax, jax.numpy as jnp
from jax import lax
import numpy as np

D_MODEL = 1024
BATCH = 1
SEQ = 16384
DEPTH = 4
DEC_BATCH = 32
DEC_SEQ = 16
PAST_LEN = 2048

CHUNK = 64
Q_BLOCK = 128
POOL_WINDOWS = (2, 4, 8, 16)
POOL_GROUPS = 4
W_A = D_MODEL // 4
GA = W_A // POOL_GROUPS
POOL_STATE = max(POOL_WINDOWS) - 1
W_B = D_MODEL // 4
SCONV_K = 3
W_C = D_MODEL // 4
CCONV_K = 31
HEAD_DIM = 64
N_HEADS = D_MODEL // (4 * HEAD_DIM)
W_D = N_HEADS * 2 * HEAD_DIM
ROPE_THETA = 10000.0
N_BRANCH = 4
OFF_A = 0
OFF_B = OFF_A + W_A
OFF_C = OFF_B + 3 * W_B
OFF_D = OFF_C + 2 * W_C
OFF_G = OFF_D + 3 * W_D
IN_WIDTH = OFF_G + N_BRANCH * D_MODEL
D_FF = ((8 * D_MODEL // 3 + 127) // 128) * 128
EPS = 1e-6

kernel_name = 'hybrid_streaming_encoder_step'


def _rmsnorm(x, g):
    xf = x.astype(jnp.float32)
    r = lax.rsqrt(jnp.mean(xf * xf, axis=-1, keepdims=True) + EPS)
    return (xf * r * g.astype(jnp.float32)).astype(x.dtype)


def _layernorm(x, g, b):
    xf = x.astype(jnp.float32)
    mu = jnp.mean(xf, axis=-1, keepdims=True)
    var = jnp.mean(jnp.square(xf - mu), axis=-1, keepdims=True)
    y = (xf - mu) * lax.rsqrt(var + EPS) * g.astype(jnp.float32) + b.astype(jnp.float32)
    return y.astype(x.dtype)


def _swiglu(x, wg, wu, wd):
    return (jax.nn.silu(x @ wg) * (x @ wu)) @ wd


def _rope(x, pos):
    half = HEAD_DIM // 2
    inv_freq = ROPE_THETA ** (-jnp.arange(half, dtype=jnp.float32) / half)
    ang = pos.astype(jnp.float32)[:, None] * inv_freq[None, :]
    cos = jnp.cos(ang)[None, :, None, :]
    sin = jnp.sin(ang)[None, :, None, :]
    xf = x.astype(jnp.float32)
    x1, x2 = xf[..., :half], xf[..., half:]
    return jnp.concatenate([x1 * cos - x2 * sin, x2 * cos + x1 * sin], axis=-1).astype(x.dtype)


def _causal_dwconv(u, state, w):
    ext = jnp.concatenate([state, u], axis=1)
    y = lax.conv_general_dilated(ext, w[:, None, :].astype(u.dtype), window_strides=(1,), padding='VALID',
                                 dimension_numbers=('NWC', 'WIO', 'NWC'), feature_group_count=u.shape[-1])
    return y, ext[:, -(w.shape[0] - 1):]


def _pool_mixer(u, state, pos0, pool_w, pool_scale):
    B, T, _ = u.shape
    ext = jnp.concatenate([state, u], axis=1)
    cs = jnp.cumsum(ext.astype(jnp.float32), axis=1)
    cs = jnp.concatenate([jnp.zeros((B, 1, W_A), jnp.float32), cs], axis=1)
    end = cs[:, POOL_STATE + 1:]
    pos = pos0 + jnp.arange(T)
    means = []
    for g, win in enumerate(POOL_WINDOWS):
        sl = slice(g * GA, (g + 1) * GA)
        start = cs[:, POOL_STATE + 1 - win: POOL_STATE + 1 - win + T, sl]
        cnt = jnp.minimum(pos + 1, win).astype(jnp.float32)[None, :, None]
        means.append((end[..., sl] - start) / cnt)
    mean = jnp.concatenate(means, axis=-1)
    d = (mean - u.astype(jnp.float32)).astype(u.dtype).reshape(B, T, POOL_GROUPS, GA)
    y = jnp.einsum('btgc,gcd->btgd', d, pool_w).reshape(B, T, W_A) * pool_scale
    return y, ext[:, -POOL_STATE:]


def _diff_attn_core(q, k, v, lam, mask):
    s = jnp.einsum('bqhd,bkhd->bhqk', q, k).astype(jnp.float32) * (HEAD_DIM ** -0.5)
    if mask is not None:
        s = jnp.where(mask[None, None], s, -jnp.inf)
    p = jax.nn.softmax(s, axis=-1)
    B, _, Tq, Tk = p.shape
    p = p.reshape(B, N_HEADS, 2, Tq, Tk)
    a = (p[:, :, 0] - lam * p[:, :, 1]).astype(v.dtype)
    return jnp.einsum('bhqk,bkhe->bqhe', a, v)


def _diff_attn_prompt(q, k, v, lam):
    B, S = q.shape[0], q.shape[1]
    nb = S // Q_BLOCK
    qb = q.reshape(B, nb, Q_BLOCK, 2 * N_HEADS, HEAD_DIM).transpose(1, 0, 2, 3, 4)
    key_chunk = jnp.arange(S) // CHUNK

    def one(args):
        q_blk, i = args
        q_chunk = (i * Q_BLOCK + jnp.arange(Q_BLOCK)) // CHUNK
        mask = key_chunk[None, :] <= q_chunk[:, None]
        return _diff_attn_core(q_blk, k, v, lam, mask)

    o = lax.map(one, (qb, jnp.arange(nb)))
    return o.transpose(1, 0, 2, 3, 4).reshape(B, S, N_HEADS, 2 * HEAD_DIM)


def _layer(x, pos0, lam_init, pool_st, sconv_st, cconv_st, k_past, v_past, w):
    B, T, _ = x.shape
    x = x + 0.5 * _swiglu(_rmsnorm(x, w['g_ffn1']), w['w1_gate'], w['w1_up'], w['w1_down'])
    h = _rmsnorm(x, w['g_mix'])
    z = h @ w['w_in']
    pos = pos0 + jnp.arange(T)

    ya, pool_new = _pool_mixer(z[..., OFF_A:OFF_A + W_A], pool_st, pos0, w['pool_w'], w['pool_scale'])

    b_gate = z[..., OFF_B:OFF_B + W_B]
    c_gate = z[..., OFF_B + W_B:OFF_B + 2 * W_B]
    s_in = z[..., OFF_B + 2 * W_B:OFF_B + 3 * W_B]
    sconv_out, sconv_new = _causal_dwconv(c_gate * s_in, sconv_st, w['sconv_w'])
    yb = b_gate * sconv_out

    glu = z[..., OFF_C:OFF_C + W_C] * jax.nn.sigmoid(z[..., OFF_C + W_C:OFF_C + 2 * W_C])
    cconv_out, cconv_new = _causal_dwconv(glu, cconv_st, w['cconv_w'])
    yc = jax.nn.silu(_layernorm(cconv_out + w['cconv_b'], w['ln_g'], w['ln_b']))

    q = z[..., OFF_D:OFF_D + W_D].reshape(B, T, 2 * N_HEADS, HEAD_DIM)
    k = z[..., OFF_D + W_D:OFF_D + 2 * W_D].reshape(B, T, 2 * N_HEADS, HEAD_DIM)
    v = z[..., OFF_D + 2 * W_D:OFF_D + 3 * W_D].reshape(B, T, N_HEADS, 2 * HEAD_DIM)
    q = _rope(_rmsnorm(q, w['q_norm_g']), pos)
    k = _rope(_rmsnorm(k, w['k_norm_g']), pos)
    f32 = jnp.float32
    lam = (jnp.exp(jnp.sum(w['lam_q1'].astype(f32) * w['lam_k1'].astype(f32)))
           - jnp.exp(jnp.sum(w['lam_q2'].astype(f32) * w['lam_k2'].astype(f32))) + lam_init)
    if k_past is None:
        o = _diff_attn_prompt(q, k, v, lam)
    else:
        o = _diff_attn_core(q, jnp.concatenate([k_past, k], axis=1),
                            jnp.concatenate([v_past, v], axis=1), lam, None)
    yd = (_rmsnorm(o, w['subln_g']) * (1.0 - lam_init)).reshape(B, T, W_D)

    gates = jax.nn.sigmoid(z[..., OFF_G:]).reshape(B, T, N_BRANCH, D_MODEL)
    merged = (gates[:, :, 0] * (ya @ w['wp_a']) + gates[:, :, 1] * (yb @ w['wp_b'])
              + gates[:, :, 2] * (yc @ w['wp_c']) + gates[:, :, 3] * (yd @ w['wp_d']))
    x = x + merged @ w['w_out']
    x = x + 0.5 * _swiglu(_rmsnorm(x, w['g_ffn2']), w['w2_gate'], w['w2_up'], w['w2_down'])
    return x, k, v, pool_new, sconv_new, cconv_new


def setup_inputs(seed: int = 0) -> dict:
    key = jax.random.key(seed)
    ks = jax.random.split(key, 48)
    ctr = [0]

    def nxt():
        k = ks[ctr[0]]
        ctr[0] += 1
        return k

    def nrm(shape, scale):
        return jax.random.normal(nxt(), shape, jnp.float32) * scale

    def gain(shape):
        return 1.0 + 0.02 * jax.random.normal(nxt(), shape, jnp.float32)

    L = DEPTH
    return {
        'x_prompt': nrm((BATCH, SEQ, D_MODEL), 1.0),
        'x_sample': nrm((DEC_BATCH, DEC_SEQ, D_MODEL), 1.0),
        'cache_k': nrm((L, DEC_BATCH, PAST_LEN, 2 * N_HEADS, HEAD_DIM), 1.0),
        'cache_v': nrm((L, DEC_BATCH, PAST_LEN, N_HEADS, 2 * HEAD_DIM), 1.0),
        'state_pool': nrm((L, DEC_BATCH, POOL_STATE, W_A), 1.0),
        'state_sconv': nrm((L, DEC_BATCH, SCONV_K - 1, W_B), 1.0),
        'state_cconv': nrm((L, DEC_BATCH, CCONV_K - 1, W_C), 0.5),
        'g_ffn1': gain((L, D_MODEL)),
        'w1_gate': nrm((L, D_MODEL, D_FF), D_MODEL ** -0.5),
        'w1_up': nrm((L, D_MODEL, D_FF), D_MODEL ** -0.5),
        'w1_down': nrm((L, D_FF, D_MODEL), D_FF ** -0.5),
        'g_mix': gain((L, D_MODEL)),
        'w_in': nrm((L, D_MODEL, IN_WIDTH), D_MODEL ** -0.5),
        'pool_w': nrm((L, POOL_GROUPS, GA, GA), GA ** -0.5),
        'pool_scale': gain((L, W_A)),
        'sconv_w': nrm((L, SCONV_K, W_B), SCONV_K ** -0.5),
        'cconv_w': nrm((L, CCONV_K, W_C), CCONV_K ** -0.5),
        'cconv_b': nrm((L, W_C), 0.01),
        'ln_g': gain((L, W_C)),
        'ln_b': nrm((L, W_C), 0.01),
        'q_norm_g': gain((L, HEAD_DIM)),
        'k_norm_g': gain((L, HEAD_DIM)),
        'lam_q1': nrm((L, HEAD_DIM), 0.1),
        'lam_k1': nrm((L, HEAD_DIM), 0.1),
        'lam_q2': nrm((L, HEAD_DIM), 0.1),
        'lam_k2': nrm((L, HEAD_DIM), 0.1),
        'subln_g': gain((L, 2 * HEAD_DIM)),
        'wp_a': nrm((L, W_A, D_MODEL), W_A ** -0.5),
        'wp_b': nrm((L, W_B, D_MODEL), W_B ** -0.5),
        'wp_c': nrm((L, W_C, D_MODEL), W_C ** -0.5),
        'wp_d': nrm((L, W_D, D_MODEL), W_D ** -0.5),
        'w_out': nrm((L, D_MODEL, D_MODEL), D_MODEL ** -0.5),
        'g_ffn2': gain((L, D_MODEL)),
        'w2_gate': nrm((L, D_MODEL, D_FF), D_MODEL ** -0.5),
        'w2_up': nrm((L, D_MODEL, D_FF), D_MODEL ** -0.5),
        'w2_down': nrm((L, D_FF, D_MODEL), D_FF ** -0.5),
    }


def reference(x_prompt, x_sample, cache_k, cache_v, state_pool, state_sconv, state_cconv,
              g_ffn1, w1_gate, w1_up, w1_down, g_mix, w_in, pool_w, pool_scale, sconv_w,
              cconv_w, cconv_b, ln_g, ln_b, q_norm_g, k_norm_g, lam_q1, lam_k1, lam_q2, lam_k2,
              subln_g, wp_a, wp_b, wp_c, wp_d, w_out, g_ffn2, w2_gate, w2_up, w2_down):
    yp, ys = x_prompt, x_sample
    bp = x_prompt.shape[0]
    kp_l, vp_l, pp_l, sp_l, cp_l = [], [], [], [], []
    ks_l, vs_l, ps_l, ss_l, cs_l = [], [], [], [], []
    for l in range(DEPTH):
        w = {
            'g_ffn1': g_ffn1[l], 'w1_gate': w1_gate[l], 'w1_up': w1_up[l], 'w1_down': w1_down[l],
            'g_mix': g_mix[l], 'w_in': w_in[l], 'pool_w': pool_w[l], 'pool_scale': pool_scale[l],
            'sconv_w': sconv_w[l], 'cconv_w': cconv_w[l], 'cconv_b': cconv_b[l],
            'ln_g': ln_g[l], 'ln_b': ln_b[l], 'q_norm_g': q_norm_g[l], 'k_norm_g': k_norm_g[l],
            'lam_q1': lam_q1[l], 'lam_k1': lam_k1[l], 'lam_q2': lam_q2[l], 'lam_k2': lam_k2[l],
            'subln_g': subln_g[l], 'wp_a': wp_a[l], 'wp_b': wp_b[l], 'wp_c': wp_c[l], 'wp_d': wp_d[l],
            'w_out': w_out[l], 'g_ffn2': g_ffn2[l], 'w2_gate': w2_gate[l], 'w2_up': w2_up[l],
            'w2_down': w2_down[l],
        }
        lam_init = 0.8 - 0.6 * math.exp(-0.3 * l)
        yp, kp, vp, pp, sp, cp = _layer(
            yp, 0, lam_init,
            jnp.zeros((bp, POOL_STATE, W_A), yp.dtype),
            jnp.zeros((bp, SCONV_K - 1, W_B), yp.dtype),
            jnp.zeros((bp, CCONV_K - 1, W_C), yp.dtype),
            None, None, w)
        ys, kn, vn, pn, sn, cn = _layer(
            ys, PAST_LEN, lam_init, state_pool[l], state_sconv[l], state_cconv[l],
            cache_k[l], cache_v[l], w)
        kp_l.append(kp); vp_l.append(vp); pp_l.append(pp); sp_l.append(sp); cp_l.append(cp)
        ks_l.append(kn); vs_l.append(vn); ps_l.append(pn); ss_l.append(sn); cs_l.append(cn)
    return (yp, ys,
            jnp.stack(kp_l), jnp.stack(vp_l), jnp.stack(pp_l), jnp.stack(sp_l), jnp.stack(cp_l),
            jnp.stack(ks_l), jnp.stack(vs_l), jnp.stack(ps_l), jnp.stack(ss_l), jnp.stack(cs_l))
```

```cpp
#ifndef CPU_TEST
#include <hip/hip_runtime.h>
#include <hip/hip_bf16.h>
#endif
#include <cstdio>
#include <cstdint>
#include <cmath>
#include <cstring>

#ifndef CFG_SEQ
#define CFG_SEQ 16384
#endif
#ifndef CFG_DEPTH
#define CFG_DEPTH 4
#endif
#ifndef CFG_DECB
#define CFG_DECB 32
#endif
#ifndef CFG_PAST
#define CFG_PAST 2048
#endif
constexpr int D = 1024, SEQ = CFG_SEQ, DEPTH = CFG_DEPTH, DECB = CFG_DECB, DECS = 16, PAST = CFG_PAST;
constexpr int MS = DECB * DECS, M = SEQ + MS;
constexpr int FF = 2816, NGU = 2 * FF, ZW = 7168, YW = 1280;
constexpr int KSROWS = PAST + 128;
constexpr int QSROWS = 256;
constexpr int ROPE_ROWS = (SEQ > PAST + DECS) ? SEQ : (PAST + DECS);
constexpr float EPS = 1e-6f;
constexpr float C2 = 0.125f * 1.4426950408889634f;

constexpr size_t O_YP = 0, O_YS = O_YP + (size_t)SEQ * D, O_KP = O_YS + (size_t)MS * D, O_VP = O_KP + (size_t)DEPTH * SEQ * 512,
                 O_POOLP = O_VP + (size_t)DEPTH * SEQ * 512, O_SCP = O_POOLP + (size_t)DEPTH * 15 * 256, O_CCP = O_SCP + (size_t)DEPTH * 2 * 256,
                 O_KS = O_CCP + (size_t)DEPTH * 30 * 256, O_VS = O_KS + (size_t)DEPTH * MS * 512, O_POOLS = O_VS + (size_t)DEPTH * MS * 512,
                 O_SCS = O_POOLS + (size_t)DEPTH * DECB * 15 * 256, O_CCS = O_SCS + (size_t)DEPTH * DECB * 2 * 256, O_END = O_CCS + (size_t)DEPTH * DECB * 30 * 256;

typedef unsigned short bf16_t;
#ifdef CPU_TEST
#define HD inline
#define LDSF float*
#else
#define HD __device__ __forceinline__
#define LAS __attribute__((address_space(3)))
#define LDSF LAS float*
#endif
#ifdef CPU_TEST
#define CBAR()
#else
#define CBAR() asm volatile("" ::: "memory")
#endif
HD unsigned f2bf(float f) { unsigned u = __builtin_bit_cast(unsigned, f); return (u + 0x7fffu + ((u >> 16) & 1u)) >> 16; }
HD float bf2f(bf16_t b) { return __builtin_bit_cast(float, (unsigned)b << 16); }
HD float sigmoid_f(float x) { return 1.0f / (1.0f + expf(-x)); }

HD void ld_bf16x8(const bf16_t* p, float* o) {
#ifdef CPU_TEST
    for (int i = 0; i < 8; ++i) o[i] = bf2f(p[i]);
#else
    typedef unsigned u4 __attribute__((ext_vector_type(4)));
    const u4 w = *(const u4*)p;
    o[0] = __builtin_bit_cast(float, w.x << 16); o[1] = __builtin_bit_cast(float, w.x & 0xffff0000u);
    o[2] = __builtin_bit_cast(float, w.y << 16); o[3] = __builtin_bit_cast(float, w.y & 0xffff0000u);
    o[4] = __builtin_bit_cast(float, w.z << 16); o[5] = __builtin_bit_cast(float, w.z & 0xffff0000u);
    o[6] = __builtin_bit_cast(float, w.w << 16); o[7] = __builtin_bit_cast(float, w.w & 0xffff0000u);
#endif
}
HD void st_bf16x8(bf16_t* p, const float* v) {
#ifdef CPU_TEST
    for (int i = 0; i < 8; ++i) p[i] = (bf16_t)f2bf(v[i]);
#else
    typedef unsigned u4 __attribute__((ext_vector_type(4)));
    u4 w; w.x = f2bf(v[0]) | (f2bf(v[1]) << 16); w.y = f2bf(v[2]) | (f2bf(v[3]) << 16); w.z = f2bf(v[4]) | (f2bf(v[5]) << 16); w.w = f2bf(v[6]) | (f2bf(v[7]) << 16);
    *(u4*)p = w;
#endif
}

struct MixP {
    const bf16_t* Z; bf16_t* Y;
    bf16_t *Qp, *Kp, *Vp;
    bf16_t *QS, *KS, *VS;
    float* out;
    const float *st_pool, *st_sconv, *st_cconv;
    const float *pool_w, *pool_scale, *sconv_w, *cconv_w, *cconv_b, *ln_g, *ln_b, *qg, *kg;
    const float* rope;
    int layer;
};
struct MixItem { int sample, b, t0, nrows; };
constexpr int MIX_PROWS = 32, N_MIX_PROMPT = SEQ / MIX_PROWS, N_MIX_ITEMS = N_MIX_PROMPT + DECB;
HD MixItem mix_item(int it) { MixItem I; if (it < N_MIX_PROMPT) { I.sample = 0; I.b = 0; I.t0 = it * MIX_PROWS; I.nrows = MIX_PROWS; } else { I.sample = 1; I.b = it - N_MIX_PROMPT; I.t0 = 0; I.nrows = DECS; } return I; }

HD void mix_c_fill(const MixP& P, const MixItem& I, int tid, LDSF T) {
    const int ch = tid & 255, half = tid >> 8, l = P.layer, b = I.b; const size_t mb = I.sample ? (size_t)SEQ + (size_t)DECS * b : 0;
    for (int i = half; i < I.nrows + 30; i += 2) { const int t = I.t0 - 30 + i; float v;
        if (t >= 0) { const bf16_t* zr = P.Z + (mb + t) * ZW; v = bf2f(zr[1024 + ch]) * sigmoid_f(bf2f(zr[1280 + ch])); }
        else v = I.sample ? P.st_cconv[((size_t)b * 30 + (30 + t)) * 256 + ch] : 0.f;
        T[i * 256 + ch] = v;
        if (!I.sample) { if (t >= I.t0 && t >= SEQ - 30) P.out[O_CCP + ((size_t)l * 30 + (t - (SEQ - 30))) * 256 + ch] = v; }
        else { if (t + 14 >= 0) P.out[O_CCS + (((size_t)l * DECB + b) * 30 + (t + 14)) * 256 + ch] = v; } }
}
HD void mix_c_conv(const MixP& P, const MixItem& I, int tid, LDSF T, LDSF cv) {
    const int ch = tid & 255, half = tid >> 8;
    float w[31];
#pragma unroll
    for (int j = 0; j < 31; ++j) w[j] = P.cconv_w[j * 256 + ch];
    for (int r = half; r < I.nrows; r += 2) { float a = 0.f;
#pragma unroll
        for (int j = 0; j < 31; ++j) a += w[j] * T[(r + j) * 256 + ch];
        cv[r * 256 + ch] = a; }
}
HD void mix_b_fill(const MixP& P, const MixItem& I, int tid, LDSF T) {
    const int ch = tid & 255, half = tid >> 8, l = P.layer, b = I.b; const size_t mb = I.sample ? (size_t)SEQ + (size_t)DECS * b : 0;
    for (int i = half; i < I.nrows + 2; i += 2) { const int t = I.t0 - 2 + i; float v;
        if (t >= 0) { const bf16_t* zr = P.Z + (mb + t) * ZW; v = bf2f(zr[512 + ch]) * bf2f(zr[768 + ch]); }
        else v = I.sample ? P.st_sconv[((size_t)b * 2 + (2 + t)) * 256 + ch] : 0.f;
        T[i * 256 + ch] = v;
        if (!I.sample) { if (t >= I.t0 && t >= SEQ - 2) P.out[O_SCP + ((size_t)l * 2 + (t - (SEQ - 2))) * 256 + ch] = v; }
        else { if (t >= DECS - 2) P.out[O_SCS + (((size_t)l * DECB + b) * 2 + (t - (DECS - 2))) * 256 + ch] = v; } }
}
HD void mix_b_conv(const MixP& P, const MixItem& I, int tid, LDSF T) {
    const int ch = tid & 255, half = tid >> 8; const size_t mb = I.sample ? (size_t)SEQ + (size_t)DECS * I.b : 0;
    const float w0 = P.sconv_w[ch], w1 = P.sconv_w[256 + ch], w2 = P.sconv_w[512 + ch];
    for (int r = half; r < I.nrows; r += 2) { const int t = I.t0 + r; const float y = w0 * T[r * 256 + ch] + w1 * T[(r + 1) * 256 + ch] + w2 * T[(r + 2) * 256 + ch];
        const float zb = bf2f(P.Z[(mb + t) * ZW + 256 + ch]);
        P.Y[(mb + t) * YW + 256 + ch] = (bf16_t)f2bf(zb * y); }
}
HD void mix_a_fill(const MixP& P, const MixItem& I, int tid, LDSF T) {
    const int ch = tid & 255, half = tid >> 8, l = P.layer, b = I.b; const size_t mb = I.sample ? (size_t)SEQ + (size_t)DECS * b : 0;
    for (int i = half; i < I.nrows + 15; i += 2) { const int t = I.t0 - 15 + i;
        const float v = (t >= 0) ? bf2f(P.Z[(mb + t) * ZW + ch]) : (I.sample ? P.st_pool[((size_t)b * 15 + (15 + t)) * 256 + ch] : 0.f);
        T[i * 256 + ch] = v;
        if (!I.sample) { if (t >= I.t0 && t >= SEQ - 15) P.out[O_POOLP + ((size_t)l * 15 + (t - (SEQ - 15))) * 256 + ch] = v; }
        else { if (t >= 1) P.out[O_POOLS + (((size_t)l * DECB + b) * 15 + (t - 1)) * 256 + ch] = v; } }
}
HD void mix_a_pool(const MixP& P, const MixItem& I, int tid, LDSF T, LDSF dA) {
    const int ch = tid & 255, half = tid >> 8; const int win = 2 << (ch >> 6);
    for (int r = half; r < I.nrows; r += 2) { const int t = I.t0 + r; float s = 0.f;
        for (int j = 0; j < win; ++j) s += T[(15 + r - j) * 256 + ch];
        const int pos = I.sample ? PAST + t : t; const int cnt = (pos + 1 < win) ? pos + 1 : win;
        dA[r * 256 + ch] = s / (float)cnt - T[(15 + r) * 256 + ch]; }
}
HD void mix_s2(const MixP& P, const MixItem& I, int tid, LDSF cv, LDSF dA, LDSF st) {
    const int ch = tid & 255, half = tid >> 8, g = ch >> 6, dd = ch & 63;
    const size_t mb = I.sample ? (size_t)SEQ + (size_t)DECS * I.b : 0;
    float acc[16];
#pragma unroll
    for (int k = 0; k < 16; ++k) acc[k] = 0.f;
    for (int c = 0; c < 64; ++c) { const float w = P.pool_w[(g * 64 + c) * 64 + dd];
#pragma unroll
        for (int k = 0; k < 16; ++k) acc[k] += dA[(half + 2 * k) * 256 + g * 64 + c] * w; }
    const float sc = P.pool_scale[ch];
#pragma unroll
    for (int k = 0; k < 16; ++k) { const int r = half + 2 * k; if (r < I.nrows) P.Y[(mb + I.t0 + r) * YW + ch] = (bf16_t)f2bf(acc[k] * sc); }
    if (tid < I.nrows) { float s = 0.f;
        for (int c = 0; c < 256; ++c) s += cv[tid * 256 + c] + P.cconv_b[c];
        const float mean = s * (1.f / 256.f); float q = 0.f;
        for (int c = 0; c < 256; ++c) { const float d = cv[tid * 256 + c] + P.cconv_b[c] - mean; q += d * d; }
        st[2 * tid] = mean; st[2 * tid + 1] = 1.0f / sqrtf(q * (1.f / 256.f) + EPS); }
}
HD void mix_s3(const MixP& P, const MixItem& I, int tid, LDSF cv, LDSF st) {
    const int ch = tid & 255, half = tid >> 8;
    const size_t mb = I.sample ? (size_t)SEQ + (size_t)DECS * I.b : 0;
    const float bi = P.cconv_b[ch], lg = P.ln_g[ch], lb = P.ln_b[ch];
    for (int r = half; r < I.nrows; r += 2) { const float v = (cv[r * 256 + ch] + bi - st[2 * r]) * st[2 * r + 1] * lg + lb;
        P.Y[(mb + I.t0 + r) * YW + 512 + ch] = (bf16_t)f2bf(v * sigmoid_f(v)); }
}
HD void mix_s4(const MixP& P, const MixItem& I, int tid) {
    const int kind = tid >> 8, rr = (tid >> 3) & 31, map = tid & 7, l = P.layer, b = I.b;
    const size_t mb = I.sample ? (size_t)SEQ + (size_t)DECS * b : 0;
    if (rr < I.nrows) {
        const int t = I.t0 + rr; const bf16_t* src = P.Z + (mb + t) * ZW + 1536 + kind * 512 + map * 64;
        float v[64];
#pragma unroll
        for (int i = 0; i < 8; ++i) ld_bf16x8(src + 8 * i, v + 8 * i);
        float ss = 0.f;
#pragma unroll
        for (int i = 0; i < 64; ++i) ss += v[i] * v[i];
        const float rn = 1.0f / sqrtf(ss * (1.f / 64.f) + EPS);
        const float* gp = kind ? P.kg : P.qg;
        const int pos = I.sample ? PAST + t : t; const float* rp = P.rope + (size_t)pos * 64;
        float o[64];
#pragma unroll
        for (int i = 0; i < 32; ++i) { const float a = v[i] * rn * gp[i], c = v[i + 32] * rn * gp[i + 32], co = rp[i], si = rp[32 + i];
            o[i] = a * co - c * si; o[i + 32] = c * co + a * si; }
        if (kind == 0) {
            bf16_t* dst = I.sample ? P.QS + ((size_t)b * QSROWS + t) * 512 + map * 64 : P.Qp + (size_t)t * 512 + map * 64;
#pragma unroll
            for (int i = 0; i < 64; ++i) o[i] *= C2;
#pragma unroll
            for (int i = 0; i < 8; ++i) st_bf16x8(dst + 8 * i, o + 8 * i);
        } else {
            bf16_t* dst = I.sample ? P.KS + ((size_t)b * KSROWS + PAST + t) * 512 + map * 64 : P.Kp + (size_t)t * 512 + map * 64;
#pragma unroll
            for (int i = 0; i < 8; ++i) st_bf16x8(dst + 8 * i, o + 8 * i);
            float* od = I.sample ? P.out + O_KS + (((size_t)l * DECB + b) * DECS + t) * 512 + map * 64 : P.out + O_KP + ((size_t)l * SEQ + t) * 512 + map * 64;
#pragma unroll
            for (int i = 0; i < 64; ++i) od[i] = o[i];
        }
    }
    for (int idx = tid; idx < I.nrows * 512; idx += 512) { const int r2 = idx >> 9, c = idx & 511, t = I.t0 + r2;
        const bf16_t val = P.Z[(mb + t) * ZW + 2560 + c];
        if (I.sample) { P.VS[((size_t)b * KSROWS + PAST + t) * 512 + c] = val; P.out[O_VS + (((size_t)l * DECB + b) * DECS + t) * 512 + c] = bf2f(val); }
        else { P.Vp[(size_t)t * 512 + c] = val; P.out[O_VP + ((size_t)l * SEQ + t) * 512 + c] = bf2f(val); } }
}
HD void post_thread(const bf16_t* Orow  , bf16_t* Ydst  , int h, float lam, float scale, const float* subln_g) {
    const bf16_t* a = Orow + (2 * h) * 128; const bf16_t* c = a + 128; float ss = 0.f;
    for (int i = 0; i < 16; ++i) { float x[8], y[8]; ld_bf16x8(a + 8 * i, x); ld_bf16x8(c + 8 * i, y);
#pragma unroll
        for (int j = 0; j < 8; ++j) { const float o = x[j] - lam * y[j]; ss += o * o; } }
    const float rn = scale / sqrtf(ss * (1.f / 128.f) + EPS);
    for (int i = 0; i < 16; ++i) { float x[8], y[8], o[8]; ld_bf16x8(a + 8 * i, x); ld_bf16x8(c + 8 * i, y);
#pragma unroll
        for (int j = 0; j < 8; ++j) o[j] = (x[j] - lam * y[j]) * rn * subln_g[8 * i + j];
        st_bf16x8(Ydst + h * 128 + 8 * i, o); }
}
#ifndef CPU_TEST
namespace pg8 {
#define PG8_LAS __attribute__((address_space(3)))
#define PG8_GAS __attribute__((address_space(1)))
typedef short bf16x8 __attribute__((ext_vector_type(8)));
typedef float f32x4 __attribute__((ext_vector_type(4)));
typedef float f32x2 __attribute__((ext_vector_type(2)));
typedef unsigned u32x4 __attribute__((ext_vector_type(4)));
typedef unsigned u32x2 __attribute__((ext_vector_type(2)));
constexpr int BM = 256, BK = 64, HALF = 128, HTB = HALF * BK * 2  , STAGE_BYTES = 8 * HTB, NXCD = 8, WGM = 8;

__host__ __device__ __forceinline__ int lds_byte(int r, int c) { const int st = (r >> 4) * 2 + (c >> 5), rr = r & 15, cc = c & 31, ob = rr * 64 + cc * 2; return st * 1024 + (ob ^ (((ob >> 9) & 1) << 5)); }
__host__ __device__ __forceinline__ void stage_rc(int b, int& R, int& C) { const int st = b / 1024, sb = b % 1024, swz = sb ^ (((sb >> 9) & 1) << 5); R = (st >> 1) * 16 + swz / 64; C = (st & 1) * 32 + (swz % 64) / 2; }
__host__ __device__ __forceinline__ int perm32(int rho) { const int n = rho >> 4, i = rho & 15; return 8 * (i >> 2) + 4 * n + (i & 3); }

struct Unit { int pm, pn; };
struct Gemm { const bf16_t* A; const bf16_t* Bt; int M, N, K, lda, ldb; };

struct StaticOrder {
    int nM, nN, nwg, G, c;
    __host__ __device__ void init(int M_, int N_, int G_, int c_) { nM = M_ / BM; nN = N_ / BM; nwg = nM * nN; G = G_; c = c_; }
    __host__ __device__ bool next(int i, Unit& u) const {
        const long L = (long)i * G + c; if (L >= nwg) return false;
        int wgid = (int)L; { const int q = nwg / NXCD, r = nwg % NXCD, xcd = wgid % NXCD, off = wgid / NXCD; wgid = (xcd < r ? xcd * (q + 1) : r * (q + 1) + (xcd - r) * q) + off; }
        const int nig = WGM * nN, gid = wgid / nig, fm = gid * WGM, gsz = (nM - fm) < WGM ? (nM - fm) : WGM;
        u.pm = fm + ((wgid % nig) % gsz); u.pn = (wgid % nig) / gsz; return true;
    }
    __device__ __forceinline__ void a_ready(const Unit&) const {}
    __device__ __forceinline__ void done(const Unit&) const {}
};

typedef __bf16 bf16x2_v __attribute__((ext_vector_type(2)));
__device__ __forceinline__ unsigned cvt_pk_bf16(float lo, float hi) { f32x2 v = {lo, hi}; const bf16x2_v b = __builtin_convertvector(v, bf16x2_v); return __builtin_bit_cast(unsigned, b); }
__device__ __forceinline__ float fast_sigmoid(float x) { return __builtin_amdgcn_rcpf(1.0f + __expf(-x)); }

struct RowScale { const float* SS4; const float* SS16; int nfast; };
__device__ __forceinline__ void row_rscales(const RowScale& R, int row0, float (&rs)[2][4]) {
    if (row0 < R.nfast) { f32x4 q[2][4];
#pragma unroll
        for (int ai = 0; ai < 2; ++ai)
#pragma unroll
            for (int m = 0; m < 4; ++m) q[ai][m] = *(const PG8_GAS f32x4*)(R.SS4 + (size_t)(row0 + ai * HALF + m * 16) * 4);
#pragma unroll
        for (int ai = 0; ai < 2; ++ai)
#pragma unroll
            for (int m = 0; m < 4; ++m) rs[ai][m] = 1.0f / sqrtf(((q[ai][m][0] + q[ai][m][1]) + (q[ai][m][2] + q[ai][m][3])) * (1.0f / 1024.0f) + 1e-6f);
    } else {
#pragma unroll
        for (int ai = 0; ai < 2; ++ai)
#pragma unroll
            for (int m = 0; m < 4; ++m) { const PG8_GAS f32x4* p = (const PG8_GAS f32x4*)(R.SS16 + (size_t)(row0 + ai * HALF + m * 16 - R.nfast) * 16); const f32x4 a = p[0], b = p[1], c = p[2], d = p[3];
                const float ss = ((a[0] + a[1]) + (a[2] + a[3])) + ((b[0] + b[1]) + (b[2] + b[3])) + ((c[0] + c[1]) + (c[2] + c[3])) + ((d[0] + d[1]) + (d[2] + d[3]));
                rs[ai][m] = 1.0f / sqrtf(ss * (1.0f / 1024.0f) + 1e-6f); }
    }
}
struct EpiSwiGLU {
    static constexpr bool PERM = true, AFTER_DRAIN = false, MID = false, ROWSCALE = true;
    bf16_t* O; RowScale R; int ldc, pad;
    __device__ __forceinline__ void operator()(const f32x4 (&acc)[2][2][4][2], const Unit& u, int wr, int wc, int fr, int fq, const float (&rsv)[2][4]) const {
        const int row0 = u.pm * BM + wr * 64 + fr, col0 = u.pn * HALF + wc * 32 + 8 * fq;
#pragma unroll
        for (int ai = 0; ai < 2; ++ai)
#pragma unroll
            for (int m = 0; m < 4; ++m) { bf16_t* rowp = O + (size_t)(row0 + ai * HALF + m * 16) * ldc + col0; const float rs = rsv[ai][m];
                float v[8];
#pragma unroll
                for (int n = 0; n < 2; ++n)
#pragma unroll
                    for (int i = 0; i < 4; ++i) { const float g = acc[ai][0][m][n][i] * rs, up = acc[ai][1][m][n][i] * rs; v[4 * n + i] = g * fast_sigmoid(g) * up; }
                u32x4 w; w.x = cvt_pk_bf16(v[0], v[1]); w.y = cvt_pk_bf16(v[2], v[3]); w.z = cvt_pk_bf16(v[4], v[5]); w.w = cvt_pk_bf16(v[6], v[7]);
                *(PG8_GAS u32x4*)rowp = w; }
    }
};
struct EpiZ {
    static constexpr bool PERM = true, AFTER_DRAIN = false, MID = false, ROWSCALE = true;
    bf16_t* O; bf16_t* FAC; RowScale R; int ldc, sig_from, nfp, pad;
    __device__ __forceinline__ void operator()(const f32x4 (&acc)[2][2][4][2], const Unit& u, int wr, int wc, int fr, int fq, const float (&rsv)[2][4]) const {
        const int row0 = u.pm * BM + wr * 64 + fr;
        if (u.pn < sig_from) { const int col0 = u.pn * BM + wc * 32 + 8 * fq;
#pragma unroll
            for (int ai = 0; ai < 2; ++ai)
#pragma unroll
                for (int m = 0; m < 4; ++m) { bf16_t* rowp = O + (size_t)(row0 + ai * HALF + m * 16) * ldc + col0; const float rs = rsv[ai][m];
#pragma unroll
                    for (int bj = 0; bj < 2; ++bj) { const f32x4 v0 = acc[ai][bj][m][0] * rs, v1 = acc[ai][bj][m][1] * rs;
                        u32x4 w; w.x = cvt_pk_bf16(v0[0], v0[1]); w.y = cvt_pk_bf16(v0[2], v0[3]); w.z = cvt_pk_bf16(v1[0], v1[1]); w.w = cvt_pk_bf16(v1[2], v1[3]);
                        *(PG8_GAS u32x4*)(rowp + bj * HALF) = w; } }
        } else { const int j = u.pn - sig_from, oc = j * 64 + wc * 16 + 4 * fq; const int g0c = sig_from * BM;
            const bool blk = u.pm < nfp;
            bf16_t* const fb = FAC + ((size_t)(u.pm * 4 + (j >> 2)) << 18) + (size_t)((wr * 4 + ((j & 1) << 1) + (wc >> 1)) * 8192 + ((j >> 1) & 1) * 512 + (fq * 16 + fr) * 8 + (wc & 1) * 4);
#pragma unroll
            for (int ai = 0; ai < 2; ++ai)
#pragma unroll
                for (int m = 0; m < 4; ++m) { bf16_t* rowp = blk ? fb + (ai * 4 + m) * 1024 : O + (size_t)(row0 + ai * HALF + m * 16) * ldc + g0c + oc; const int qs = blk ? 65536 : 1024; const float rs = rsv[ai][m];
                    f32x4 e[4];
#pragma unroll
                    for (int b = 0; b < 4; ++b)
#pragma unroll
                        for (int i = 0; i < 4; ++i) e[b][i] = 1.0f + __expf(-acc[ai][b >> 1][m][b & 1][i] * rs);
#pragma unroll
                    for (int q = 0; q < 4; ++q) { f32x4 v;
#pragma unroll
                        for (int i = 0; i < 4; ++i) v[i] = (q < 3) ? e[q + 1 > 3 ? 3 : q + 1][i] * __builtin_amdgcn_rcpf(e[q][i]) : __builtin_amdgcn_rcpf(e[3][i]);
                        u32x2 w; w.x = cvt_pk_bf16(v[0], v[1]); w.y = cvt_pk_bf16(v[2], v[3]); *(PG8_GAS u32x2*)(rowp + q * qs) = w; } }
        }
    }
};
struct EpiMerged {
    static constexpr bool PERM = false, AFTER_DRAIN = false, MID = true, ROWSCALE = false;
    bf16_t* OUT; const bf16_t* F; int ldc, ldf;
    __device__ __forceinline__ void scale(f32x4 (&acc)[2][2][4][2], const Unit& u, int wr, int wc, int fr, int fq, int q) const {
        const bf16_t* fb = F + ((size_t)((u.pm * 4 + u.pn) * 4 + q) << 16) + (size_t)((wr * 4 + wc) * 8192 + (fq * 16 + fr) * 8);
        u32x4 gq[2][4][2];
#pragma unroll
        for (int ai = 0; ai < 2; ++ai)
#pragma unroll
            for (int m = 0; m < 4; ++m)
#pragma unroll
                for (int bj = 0; bj < 2; ++bj) gq[ai][m][bj] = *(const PG8_GAS u32x4*)(fb + ((ai * 4 + m) * 2 + bj) * 512);
#pragma unroll
        for (int ai = 0; ai < 2; ++ai)
#pragma unroll
            for (int m = 0; m < 4; ++m)
#pragma unroll
                for (int bj = 0; bj < 2; ++bj)
#pragma unroll
                    for (int n = 0; n < 2; ++n) { u32x2 w; w.x = n ? gq[ai][m][bj].z : gq[ai][m][bj].x; w.y = n ? gq[ai][m][bj].w : gq[ai][m][bj].y; f32x4 g; g[0] = __builtin_bit_cast(float, w.x << 16); g[1] = __builtin_bit_cast(float, w.x & 0xffff0000u); g[2] = __builtin_bit_cast(float, w.y << 16); g[3] = __builtin_bit_cast(float, w.y & 0xffff0000u);
                        acc[ai][bj][m][n] *= g; }
    }
    __device__ __forceinline__ void mid(f32x4 (&acc)[2][2][4][2], const Unit& u, int wr, int wc, int fr, int fq, int i) const { scale(acc, u, wr, wc, fr, fq, i); }
    __device__ __forceinline__ void operator()(f32x4 (&acc)[2][2][4][2], const Unit& u, int wr, int wc, int fr, int fq) const {
        scale(acc, u, wr, wc, fr, fq, 3);
        const int row0 = u.pm * BM + wr * 64 + fr, col0 = u.pn * BM + wc * 32 + 4 * fq;
#pragma unroll
        for (int ai = 0; ai < 2; ++ai)
#pragma unroll
            for (int m = 0; m < 4; ++m) { bf16_t* op = OUT + (size_t)(row0 + ai * HALF + m * 16) * ldc + col0;
#pragma unroll
                for (int bj = 0; bj < 2; ++bj)
#pragma unroll
                    for (int n = 0; n < 2; ++n) { const f32x4 v = acc[ai][bj][m][n]; u32x2 w; w.x = cvt_pk_bf16(v[0], v[1]); w.y = cvt_pk_bf16(v[2], v[3]); *(PG8_GAS u32x2*)(op + bj * HALF + n * 16) = w; } }
    }
};
struct EpiResid {
    static constexpr bool PERM = true, AFTER_DRAIN = false, MID = false, ROWSCALE = false;
    bf16_t* XB; float* SS4; float* Xout; PG8_LAS float* PS; int ldc; float s;
    __device__ __forceinline__ void operator()(const f32x4 (&acc)[2][2][4][2], const Unit& u, int wr, int wc, int fr, int fq) const {
        const int row0 = u.pm * BM + wr * 64 + fr, col0 = u.pn * BM + wc * 32 + 8 * fq; const int lane = fq * 16 + fr; const bool fin = Xout != nullptr;
#pragma unroll
        for (int ai = 0; ai < 2; ++ai)
#pragma unroll
            for (int m = 0; m < 4; ++m) { const size_t row = (size_t)(row0 + ai * HALF + m * 16); bf16_t* xb = XB + row * ldc + col0; float* xo = Xout + row * ldc + col0;
                u32x4 x[2];
#pragma unroll
                for (int bj = 0; bj < 2; ++bj) x[bj] = *(const PG8_GAS u32x4*)(xb + bj * HALF);
                float ss = 0.f;
#pragma unroll
                for (int bj = 0; bj < 2; ++bj) { f32x4 v0, v1;
                    v0[0] = __builtin_bit_cast(float, x[bj].x << 16); v0[1] = __builtin_bit_cast(float, x[bj].x & 0xffff0000u); v0[2] = __builtin_bit_cast(float, x[bj].y << 16); v0[3] = __builtin_bit_cast(float, x[bj].y & 0xffff0000u);
                    v1[0] = __builtin_bit_cast(float, x[bj].z << 16); v1[1] = __builtin_bit_cast(float, x[bj].z & 0xffff0000u); v1[2] = __builtin_bit_cast(float, x[bj].w << 16); v1[3] = __builtin_bit_cast(float, x[bj].w & 0xffff0000u);
                    v0 += acc[ai][bj][m][0] * s; v1 += acc[ai][bj][m][1] * s;
                    if (fin) { *(PG8_GAS f32x4*)(xo + bj * HALF) = v0; *(PG8_GAS f32x4*)(xo + bj * HALF + 4) = v1; }
                    else { u32x4 w; w.x = cvt_pk_bf16(v0[0], v0[1]); w.y = cvt_pk_bf16(v0[2], v0[3]); w.z = cvt_pk_bf16(v1[0], v1[1]); w.w = cvt_pk_bf16(v1[2], v1[3]); *(PG8_GAS u32x4*)(xb + bj * HALF) = w;
                        ss += ((v0[0] * v0[0] + v0[1] * v0[1]) + (v0[2] * v0[2] + v0[3] * v0[3])) + ((v1[0] * v1[0] + v1[1] * v1[1]) + (v1[2] * v1[2] + v1[3] * v1[3])); } }
                ss += __builtin_bit_cast(float, __builtin_amdgcn_ds_bpermute((lane ^ 16) << 2, __builtin_bit_cast(int, ss)));
                ss += __builtin_bit_cast(float, __builtin_amdgcn_ds_bpermute((lane ^ 32) << 2, __builtin_bit_cast(int, ss)));
                if (fq == 0) PS[(ai * HALF + wr * 64 + m * 16 + fr) * 4 + wc] = ss;
                if (m & 1) asm volatile("" ::: "memory"); }
        asm volatile("s_waitcnt lgkmcnt(0)" ::: "memory"); __builtin_amdgcn_s_barrier(); asm volatile("" ::: "memory");
        if (lane < 32 && !fin) { const int c8 = 2 * wc + (lane >> 4), rl = (c8 >> 2) * HALF + wr * 64 + (c8 & 3) * 16 + (lane & 15);
            const f32x4 q = *(const PG8_LAS f32x4*)(PS + rl * 4); ((PG8_GAS float*)SS4)[(size_t)(u.pm * BM + rl) * 4 + u.pn] = (q[0] + q[1]) + (q[2] + q[3]); }
    }
};
template <class Epi, class Sched, bool ALIGN_EPI = true>
__device__ __forceinline__ void gemm_phase(PG8_LAS unsigned char* lds_in, const Gemm g, const Sched& S, const Epi& E, int tid_in) {
    unsigned lb_ = (unsigned)(uintptr_t)lds_in; asm volatile("" : "+s"(lb_)); PG8_LAS unsigned char* lds = (PG8_LAS unsigned char*)(uintptr_t)lb_;
    int tid_ = tid_in; asm volatile("" : "+v"(tid_));
    const int tid = tid_, wid = __builtin_amdgcn_readfirstlane(tid >> 6), lane = tid & 63, wr = wid >> 2, wc = wid & 3, fr = lane & 15, fq = lane >> 4;
    const int K = g.K, nt = K / BK;
    unsigned voffA[2], voffB[2];
#pragma unroll
    for (int i = 0; i < 2; ++i) { int R, C; stage_rc(tid * 16 + i * 8192, R, C); const int Rb = Epi::PERM ? ((R & ~31) + perm32(R & 31)) : R;
        voffA[i] = (unsigned)(R * g.lda + C) * 2u; voffB[i] = (unsigned)(Rb * g.ldb + C) * 2u; }
    const size_t kstep = (size_t)(BK * 2);
    const size_t hA = (size_t)HALF * g.lda * 2, hB = (size_t)HALF * g.ldb * 2;
    const size_t tA = 2 * hA, tB = 2 * hB;
    const unsigned ldsw = (unsigned)wid * 1024u;
    const int aoff = lds_byte(wr * 64 + fr, fq * 8), boff = lds_byte(wc * 32 + fr, fq * 8);
#define PG8_SA(b, h) (((b) * 2 + (h)) * HTB)
#define PG8_SB(b, h) ((4 + (b) * 2 + (h)) * HTB)
#define PG8_STAGE(bufoff, gbase, voff) do { _Pragma("unroll") for (int _i = 0; _i < 2; ++_i) \
        __builtin_amdgcn_global_load_lds((const unsigned*)((const char*)(gbase) + (voff)[_i]), (PG8_LAS unsigned*)(lds + (bufoff) + ldsw + _i * 8192), 16, 0, 0); } while (0)
#define PG8_LDA(dst, b, h) do { _Pragma("unroll") for (int m = 0; m < 4; ++m) _Pragma("unroll") for (int k = 0; k < 2; ++k) dst[m][k] = *(const PG8_LAS bf16x8*)(lds + PG8_SA(b, h) + aoff + m * 2048 + k * 1024); } while (0)
#define PG8_LDB(dst, b, h) do { _Pragma("unroll") for (int n = 0; n < 2; ++n) _Pragma("unroll") for (int k = 0; k < 2; ++k) dst[n][k] = *(const PG8_LAS bf16x8*)(lds + PG8_SB(b, h) + boff + n * 2048 + k * 1024); } while (0)
#define PG8_MMA(ai, bj, At, Bt) do { __builtin_amdgcn_s_setprio(1); _Pragma("unroll") for (int m = 0; m < 4; ++m) _Pragma("unroll") for (int n = 0; n < 2; ++n) _Pragma("unroll") for (int k = 0; k < 2; ++k) \
        acc[ai][bj][m][n] = __builtin_amdgcn_mfma_f32_16x16x32_bf16(Bt[n][k], At[m][k], acc[ai][bj][m][n], 0, 0, 0); __builtin_amdgcn_s_setprio(0); } while (0)
#define PG8_WAIT_V(n) asm volatile("s_waitcnt vmcnt(" #n ")" ::: "memory")
#define PG8_WAIT_L(n) asm volatile("s_waitcnt lgkmcnt(" #n ")" ::: "memory")
#define PG8_BAR __builtin_amdgcn_s_barrier()
#define PG8_SCHED __builtin_amdgcn_sched_barrier(0)
    Unit cur, nxt; int ui = 0;
    float rsv[2][4]; int rs_pm = -1;
#pragma unroll
    for (int a = 0; a < 2; ++a)
#pragma unroll
        for (int m = 0; m < 4; ++m) rsv[a][m] = 0.f;
    if (!S.next(0, cur)) return;
    f32x4 acc[2][2][4][2];
#pragma unroll
    for (int a = 0; a < 2; ++a)
#pragma unroll
        for (int b = 0; b < 2; ++b)
#pragma unroll
            for (int m = 0; m < 4; ++m)
#pragma unroll
                for (int n = 0; n < 2; ++n) acc[a][b][m][n] = (f32x4){0.f, 0.f, 0.f, 0.f};
    bf16x8 At[4][2], B0[2][2], B1[2][2];
    const char* cA = (const char*)g.A + (size_t)cur.pm * tA; const char* cB = (const char*)g.Bt + (size_t)cur.pn * tB;
    S.a_ready(cur);
    PG8_STAGE(PG8_SB(0, 0), cB, voffB); PG8_STAGE(PG8_SB(0, 1), cB + hB, voffB); PG8_STAGE(PG8_SA(0, 0), cA, voffA); PG8_STAGE(PG8_SA(0, 1), cA + hA, voffA);
    if (wr == 1) PG8_BAR;
    PG8_WAIT_V(2); PG8_BAR;
    PG8_STAGE(PG8_SB(1, 0), cB + kstep, voffB); PG8_STAGE(PG8_SA(1, 0), cA + kstep, voffA); PG8_STAGE(PG8_SB(1, 1), cB + hB + kstep, voffB);
    PG8_WAIT_V(6); PG8_BAR;
    for (;;) {
        const bool has_next = S.next(ui + 1, nxt);
        const char* nA = has_next ? (const char*)g.A + (size_t)nxt.pm * tA : cA; const char* nB = has_next ? (const char*)g.Bt + (size_t)nxt.pn * tB : cB;
        for (int t = 0; t < nt; t += 2) {
            const bool last = (t == nt - 2);
            const char* a1 = cA + (size_t)(t + 1) * kstep;
            const char* a2 = last ? nA : cA + (size_t)(t + 2) * kstep; const char* b2 = last ? nB : cB + (size_t)(t + 2) * kstep;
            const char* a3 = a2 + kstep; const char* b3 = b2 + kstep;
            if (last && has_next) S.a_ready(nxt);
            PG8_LDB(B0, 0, 0); PG8_LDB(B1, 0, 1); PG8_SCHED; PG8_LDA(At, 0, 0); PG8_STAGE(PG8_SA(1, 1), a1 + hA, voffA);
            PG8_WAIT_V(8); PG8_WAIT_L(0); PG8_BAR; PG8_MMA(0, 0, At, B0); PG8_MMA(0, 1, At, B1); PG8_BAR; PG8_SCHED;
            PG8_LDA(At, 0, 1); PG8_STAGE(PG8_SB(0, 0), b2, voffB); PG8_STAGE(PG8_SB(0, 1), b2 + hB, voffB); PG8_STAGE(PG8_SA(0, 0), a2, voffA);
            PG8_WAIT_V(8); PG8_WAIT_L(0); PG8_BAR; PG8_MMA(1, 0, At, B0); PG8_MMA(1, 1, At, B1); PG8_BAR; PG8_SCHED;
            PG8_LDB(B0, 1, 0); PG8_LDB(B1, 1, 1); PG8_SCHED; PG8_LDA(At, 1, 0); PG8_STAGE(PG8_SA(0, 1), a2 + hA, voffA);
            PG8_WAIT_V(8); PG8_WAIT_L(0); PG8_BAR; PG8_MMA(0, 0, At, B0); PG8_MMA(0, 1, At, B1); PG8_BAR; PG8_SCHED;
            PG8_LDA(At, 1, 1); PG8_STAGE(PG8_SB(1, 0), b3, voffB); PG8_STAGE(PG8_SB(1, 1), b3 + hB, voffB); PG8_STAGE(PG8_SA(1, 0), a3, voffA);
            PG8_WAIT_V(8); PG8_WAIT_L(0); PG8_BAR; PG8_MMA(1, 0, At, B0); PG8_MMA(1, 1, At, B1); PG8_BAR; PG8_SCHED;
            if constexpr (Epi::MID) { const int tn = t + 2; if (tn <= 12 && (tn & 3) == 0) { E.mid(acc, cur, wr, wc, fr, fq, (tn >> 2) - 1); PG8_SCHED; } }
        }
        if constexpr (ALIGN_EPI) { if (wr == 0) PG8_BAR; }
        if constexpr (Epi::ROWSCALE) { if (cur.pm != rs_pm) { row_rscales(E.R, cur.pm * BM + wr * 64 + fr, rsv); rs_pm = cur.pm; }
            E(acc, cur, wr, wc, fr, fq, rsv); }
        else E(acc, cur, wr, wc, fr, fq);
        S.done(cur);
        if (!has_next) break;
#pragma unroll
        for (int a = 0; a < 2; ++a)
#pragma unroll
            for (int b = 0; b < 2; ++b)
#pragma unroll
                for (int m = 0; m < 4; ++m)
#pragma unroll
                    for (int n = 0; n < 2; ++n) acc[a][b][m][n] = (f32x4){0.f, 0.f, 0.f, 0.f};
        cur = nxt; cA = nA; cB = nB; ++ui;
        if constexpr (ALIGN_EPI) { if (wr == 1) PG8_BAR; }
    }
    PG8_WAIT_V(0);
    if constexpr (!ALIGN_EPI) { if (wr == 0) PG8_BAR; }
    PG8_BAR;
#undef PG8_SA
#undef PG8_SB
#undef PG8_STAGE
#undef PG8_LDA
#undef PG8_LDB
#undef PG8_MMA
#undef PG8_WAIT_V
#undef PG8_WAIT_L
#undef PG8_BAR
#undef PG8_SCHED
}
}
#include <cmath>
namespace attn_body {
using bf16=__hip_bfloat16;
using bf16x8=__attribute__((ext_vector_type(8)))short;
using s16x4=__attribute__((ext_vector_type(4)))short;
using f32x16=__attribute__((ext_vector_type(16)))float;
using u32x4=__attribute__((ext_vector_type(4)))unsigned;
constexpr int D=64,QKP=512,OP=1024;
constexpr int NW=8,QBLK=32,QB=QBLK*NW,KVBLK=64;
constexpr int ATTN_UNIT_ROWS=QB;
__device__ __forceinline__ int crow(int r,int hi){return (r&3)+8*(r>>2)+4*hi;}
#define SBAR() __builtin_amdgcn_sched_barrier(0)
__device__ __forceinline__ void cmask(f32x16&p0,f32x16&p1,int jb,int wid,int mode){
  const float NEG=-INFINITY;
  const bool m_all=(mode==0)?(jb>(wid>>1)):(jb==3);
  const bool m_hi=m_all||(mode!=0&&jb==2);
  #pragma unroll
  for(int r=0;r<16;++r){ p0[r]=((r>=8)?m_hi:m_all)?NEG:p0[r]; p1[r]=m_hi?NEG:p1[r]; }
}
constexpr int NSLOT=3, SLOTB=8192;
constexpr int LDS_K=0, LDS_V=NSLOT*SLOTB, LDS_WS=3*NSLOT*SLOTB, LDS_OST=0, LDS_BYTES=LDS_WS+NW*64*4;
constexpr float C2=0.125f*1.4426950408889634f;
__device__ __forceinline__ void glds16(const void*gsrc,unsigned lds_dst){unsigned keep;
  asm volatile("s_mov_b32 %0, m0\n\ts_mov_b32 m0, %2\n\ts_nop 0\n\tglobal_load_lds_dwordx4 %1, off\n\ts_mov_b32 m0, %0":"=&s"(keep):"v"(gsrc),"s"(lds_dst):"memory");}
__device__ __forceinline__ float max3f(float a,float b,float c){float r;asm("v_max3_f32 %0, %1, %2, %3":"=v"(r):"v"(a),"v"(b),"v"(c));return r;}
__device__ __forceinline__ float max2f(float a,float b){float r;asm("v_max_f32_e32 %0, %1, %2":"=v"(r):"v"(a),"v"(b));return r;}
__device__ __forceinline__ float fadd_s(float a,float b){float r;asm("v_add_f32_e32 %0, %1, %2":"=v"(r):"v"(a),"v"(b));return r;}
__device__ __forceinline__ float fsub_s(float a,float b){float r;asm("v_sub_f32_e32 %0, %1, %2":"=v"(r):"v"(a),"v"(b));return r;}
typedef float f32x2_t __attribute__((ext_vector_type(2))); typedef __bf16 bf16x2_t __attribute__((ext_vector_type(2)));
__device__ __forceinline__ unsigned cvtpk_s(float lo,float hi){f32x2_t v={lo,hi};bf16x2_t b=__builtin_convertvector(v,bf16x2_t);return __builtin_bit_cast(unsigned,b);}
#define WAIT_BAR(N) asm volatile("s_waitcnt vmcnt(" #N ") lgkmcnt(0)\n\ts_barrier":::"memory")

__device__ __forceinline__ void qkt(f32x16&p0,f32x16&p1,const char*Kslot,const bf16x8*qr,const f32x16&negm,int r32,int hi){
  const char*kb=Kslot+hi*1024+r32*16;
  #pragma unroll
  for(int d0=0;d0<4;++d0){
    const bf16x8 b0=*reinterpret_cast<const bf16x8*>(kb+d0*2048);
    const bf16x8 b1=*reinterpret_cast<const bf16x8*>(kb+d0*2048+512);
    if(d0==0){p0=__builtin_amdgcn_mfma_f32_32x32x16_bf16(b0,qr[0],negm,0,0,0);p1=__builtin_amdgcn_mfma_f32_32x32x16_bf16(b1,qr[0],negm,0,0,0);}
    else{p0=__builtin_amdgcn_mfma_f32_32x32x16_bf16(b0,qr[d0],p0,0,0,0);p1=__builtin_amdgcn_mfma_f32_32x32x16_bf16(b1,qr[d0],p1,0,0,0);}}
}
typedef __attribute__((address_space(3))) const char* lds_cptr;
typedef short v4i16_t __attribute__((ext_vector_type(4)));
__device__ __forceinline__ void kload8(bf16x8*kf,lds_cptr kp){
  kf[0]=*(const __attribute__((address_space(3))) bf16x8*)(kp);      kf[1]=*(const __attribute__((address_space(3))) bf16x8*)(kp+512);
  kf[2]=*(const __attribute__((address_space(3))) bf16x8*)(kp+2048); kf[3]=*(const __attribute__((address_space(3))) bf16x8*)(kp+2560);
  kf[4]=*(const __attribute__((address_space(3))) bf16x8*)(kp+4096); kf[5]=*(const __attribute__((address_space(3))) bf16x8*)(kp+4608);
  kf[6]=*(const __attribute__((address_space(3))) bf16x8*)(kp+6144); kf[7]=*(const __attribute__((address_space(3))) bf16x8*)(kp+6656);
}
__device__ __forceinline__ void kload2(bf16x8*kf,lds_cptr kp,int j){ kf[2*j]=*(const __attribute__((address_space(3))) bf16x8*)(kp+j*2048); kf[2*j+1]=*(const __attribute__((address_space(3))) bf16x8*)(kp+j*2048+512); }
__device__ __forceinline__ s16x4 vtr(lds_cptr p){ return __builtin_bit_cast(s16x4,__builtin_amdgcn_ds_read_tr16_b64_v4i16((__attribute__((address_space(3))) v4i16_t*)p)); }
__device__ __forceinline__ float rowmax(const f32x16&p0,const f32x16&p1){
  float a=max3f(p0[0],p0[1],p1[0]),b=max3f(p0[2],p0[3],p1[1]);a=max3f(a,p1[2],p1[3]);
  #pragma unroll
  for(int r=4;r<16;r+=4){a=max3f(a,p0[r],p0[r+1]);b=max3f(b,p0[r+2],p0[r+3]);a=max3f(a,p1[r],p1[r+1]);b=max3f(b,p1[r+2],p1[r+3]);}
  const float m=max2f(a,b);
  auto rr=__builtin_amdgcn_permlane32_swap(__float_as_uint(m),__float_as_uint(m),false,false);
  return max2f(__uint_as_float(rr[0]),__uint_as_float(rr[1]));
}
__device__ __forceinline__ void pv(f32x16*o,int vb,bf16x8 pa0,bf16x8 pa1,bf16x8 pa2,bf16x8 pa3){
  #pragma unroll
  for(int d0=0;d0<4;++d0){s16x4 lo[4],hi[4];
    #pragma unroll
    for(int ks=0;ks<4;++ks){
      asm volatile("ds_read_b64_tr_b16 %0,%1 offset:%c2":"=&v"(lo[ks]):"v"(vb),"i"(d0*4096+ks*1024):"memory");
      asm volatile("ds_read_b64_tr_b16 %0,%1 offset:%c2":"=&v"(hi[ks]):"v"(vb),"i"(d0*4096+ks*1024+512):"memory");}
    asm volatile("s_waitcnt lgkmcnt(0)":::"memory");SBAR();
    #define PK(k) (bf16x8){lo[k][0],lo[k][1],lo[k][2],lo[k][3],hi[k][0],hi[k][1],hi[k][2],hi[k][3]}
    o[d0]=__builtin_amdgcn_mfma_f32_32x32x16_bf16(pa0,PK(0),o[d0],0,0,0);
    o[d0]=__builtin_amdgcn_mfma_f32_32x32x16_bf16(pa1,PK(1),o[d0],0,0,0);
    o[d0]=__builtin_amdgcn_mfma_f32_32x32x16_bf16(pa2,PK(2),o[d0],0,0,0);
    o[d0]=__builtin_amdgcn_mfma_f32_32x32x16_bf16(pa3,PK(3),o[d0],0,0,0);
    #undef PK
  }
}

#ifndef ATTN_STORE16
#define ATTN_STORE16(p,v) (*(__attribute__((address_space(1))) u32x4*)(p)=(v))
#endif
template<int THRL> __device__ __forceinline__ void attn_unit(const bf16*Qw0,const bf16*__restrict__ Kh,const bf16*__restrict__ Vh,bf16*Ow0,const int NT,const int mode,char*shm,int tid_in){
  int tid_=tid_in; asm volatile("":"+v"(tid_)); const int tid=tid_,lane=tid&63,r32=lane&31,hi=lane>>5; const int wid=__builtin_amdgcn_readfirstlane(tid>>6);
  const bf16*Qw=Qw0+(long)wid*QBLK*QKP;
  const unsigned lds0=(unsigned)(uintptr_t)shm;
  float*wsf=(float*)(shm+LDS_WS)+wid*64;
  const bf16*ksrc=Kh+(long)lane*QKP+wid*8;
  const bf16*vsrc=Vh+(long)(16*(wid&3)+(lane>>2))*QKP+(wid>>2)*32+(lane&3)*8;
  const unsigned kdst=lds0+LDS_K+wid*1024, vdst=lds0+LDS_V+wid*1024;
  #define DMA_K(t,slot) glds16(ksrc+(long)(t)*KVBLK*QKP,(unsigned)__builtin_amdgcn_readfirstlane(kdst+(slot)))
  #define DMA_V(t,slot) do{ glds16(vsrc+(long)(t)*KVBLK*QKP,(unsigned)__builtin_amdgcn_readfirstlane(vdst+2*(slot))); glds16(vsrc+64+(long)(t)*KVBLK*QKP,(unsigned)__builtin_amdgcn_readfirstlane(vdst+2*(slot)+8192)); }while(0)
  const int vb0=(int)(lds0+LDS_V)+((lane>>4)&1)*32+(lane&3)*8+(4*hi+((lane&15)>>2))*64;
  const char*Kbase=shm+LDS_K; bf16x8 kf[8];
  const lds_cptr shm3=(lds_cptr)shm; const lds_cptr kp0=shm3+LDS_K+hi*1024+r32*16; const lds_cptr vp0=shm3+LDS_V+((lane>>4)&1)*32+(lane&3)*8+(4*hi+((lane&15)>>2))*64;
  DMA_K(0,0);DMA_V(0,0);DMA_K(1,SLOTB);
  bf16x8 qr[4];
  #pragma unroll
  for(int d0=0;d0<4;++d0)qr[d0]=*(const __attribute__((address_space(1))) bf16x8*)(&Qw[(long)r32*QKP+d0*16+hi*8]);
  float mhat=0.f,l_reg=0.f;f32x16 o[4];o[0]=f32x16{};o[1]=f32x16{};o[2]=f32x16{};o[3]=f32x16{};f32x16 negm=f32x16{};asm volatile("":"+v"(negm));
  #define CMASK(P0,P1,t) do{int jb_=(t)-(NT-4); if(jb_>=0)cmask(P0,P1,jb_,wid,mode);}while(0)
  bool resc=false;
  #define START(P0,P1) do{ const float rm=rowmax(P0,P1); resc=false; \
    { const float dl=rm; mhat=fadd_s(mhat,dl); \
      _Pragma("unroll") for(int r=0;r<16;++r){P0[r]=fsub_s(P0[r],dl);P1[r]=fsub_s(P1[r],dl);} \
      _Pragma("unroll") for(int r=0;r<16;++r)negm[r]=-mhat; asm volatile("":"+v"(negm)); } \
    _Pragma("unroll") for(int r=0;r<16;++r)P0[r]=__builtin_amdgcn_exp2f(P0[r]); }while(0)
  #define RESC() do{ if(resc){ asm volatile("s_waitcnt lgkmcnt(0)":::"memory"); \
      _Pragma("unroll") for(int d_=0;d_<4;++d_) _Pragma("unroll") for(int r=0;r<16;++r)o[d_][r]*=wsf[crow(r,hi)]; } }while(0)
  f32x16 pA0,pA1,pB0,pB1;
  int sl_prev=0,sl_cur=0,sl_next=SLOTB;
  #define ROT() do{sl_prev=sl_cur;sl_cur=sl_next;sl_next=(sl_next==(NSLOT-1)*SLOTB)?0:sl_next+SLOTB;}while(0)
  DMA_K(2,2*SLOTB);
  WAIT_BAR(3);
  qkt(pA0,pA1,Kbase,qr,negm,r32,hi);asm volatile("s_nop 15\n\ts_nop 7":"+v"(pA0),"+v"(pA1));CMASK(pA0,pA1,0);
  START(pA0,pA1);
  _Pragma("unroll") for(int r=0;r<16;++r)pA1[r]=__builtin_amdgcn_exp2f(pA1[r]);
  WAIT_BAR(0);
  DMA_K(3,0);DMA_V(1,SLOTB);
  ROT();
  kload8(kf,kp0+sl_cur);
  WAIT_BAR(3);
  s16x4 vlo[8],vhi[8]; u32x4 pw0,pw1,pw2,pw3;
  #define PKW(P,B) cvtpk_s(P[B],P[B+1])
  #define PAF(k) __builtin_bit_cast(bf16x8,pw##k)
  #define VFR(i) (bf16x8){vlo[i][0],vlo[i][1],vlo[i][2],vlo[i][3],vhi[i][0],vhi[i][1],vhi[i][2],vhi[i][3]}
  #define PIN(x) asm volatile("":"+v"(x))
  #define MX3(a,b,c) __builtin_fmaxf(__builtin_fmaxf((a),(b)),(c))
  #define GAPA(MF,A0,A1,A2,A3,W0,W1,PW) do{ MF; sacc+=A0; sacc+=A1; sacc+=A2; sacc+=A3; PIN(sacc); W0; W1; PIN(PW); SBAR(); }while(0)
  #define EX(v) __builtin_amdgcn_exp2f(v)
  #define GAPB(MF,X,B) do{ MF; X[B]=EX(X[B]); X[B+1]=EX(X[B+1]); X[B+2]=EX(X[B+2]); X[B+3]=EX(X[B+3]); PIN(X); SBAR(); }while(0)
  #define VRD(s,i) do{ vlo[s]=vtr(vp_+((i)*1024)); vhi[s]=vtr(vp_+((i)*1024+512)); }while(0)
  #define GAPB2(MF,X,B) do{ MF; X[B]=EX(X[B]); X[B+1]=EX(X[B+1]); PIN(X); SBAR(); }while(0)
  #define KRD(G,j) do{ if(G){ kload2(kf,kp0+sl_next,j); SBAR(); } }while(0)
  #define STEP(C0,C1,P0,P1,t,GK,GV,GL) do{ SBAR(); \
    const lds_cptr vp_=vp0+2*sl_prev; \
    VRD(0,0); SBAR(); float sacc=(P0[0]+P0[1]); \
    GAPA(C0=__builtin_amdgcn_mfma_f32_32x32x16_bf16(kf[0],qr[0],negm,0,0,0), P0[2],P0[3],P0[4],P0[5],     pw0[0]=PKW(P0,0), pw0[1]=PKW(P0,2), pw0); \
    VRD(1,4); SBAR(); GAPA(C1=__builtin_amdgcn_mfma_f32_32x32x16_bf16(kf[1],qr[0],negm,0,0,0), P0[6],P0[7],P0[8],P0[9],     pw0[2]=PKW(P0,4), pw0[3]=PKW(P0,6), pw0); \
    VRD(2,8); SBAR(); GAPA(C0=__builtin_amdgcn_mfma_f32_32x32x16_bf16(kf[2],qr[1],C0,0,0,0),   P0[10],P0[11],P0[12],P0[13], pw1[0]=PKW(P0,8), pw1[1]=PKW(P0,10), pw1); \
    VRD(3,12); SBAR(); GAPA(C1=__builtin_amdgcn_mfma_f32_32x32x16_bf16(kf[3],qr[1],C1,0,0,0),   P0[14],P0[15],P1[0],P1[1],   pw1[2]=PKW(P0,12),pw1[3]=PKW(P0,14), pw1); \
    VRD(4,1); SBAR(); GAPA(C0=__builtin_amdgcn_mfma_f32_32x32x16_bf16(kf[4],qr[2],C0,0,0,0),   P1[2],P1[3],P1[4],P1[5],     pw2[0]=PKW(P1,0), pw2[1]=PKW(P1,2), pw2); \
    VRD(5,5); SBAR(); GAPA(C1=__builtin_amdgcn_mfma_f32_32x32x16_bf16(kf[5],qr[2],C1,0,0,0),   P1[6],P1[7],P1[8],P1[9],     pw2[2]=PKW(P1,4), pw2[3]=PKW(P1,6), pw2); \
    VRD(6,9); SBAR(); GAPA(C0=__builtin_amdgcn_mfma_f32_32x32x16_bf16(kf[6],qr[3],C0,0,0,0),   P1[10],P1[11],P1[12],P1[13], pw3[0]=PKW(P1,8), pw3[1]=PKW(P1,10), pw3); \
    VRD(7,13); SBAR(); GAPA(C1=__builtin_amdgcn_mfma_f32_32x32x16_bf16(kf[7],qr[3],C1,0,0,0),   P1[14],P1[15],0.f,0.f,       pw3[2]=PKW(P1,12),pw3[3]=PKW(P1,14), pw3); \
    l_reg+=sacc; \
    if(GK){DMA_K((t)+3,sl_cur);} if(GV){DMA_V((t)+1,sl_next);} \
    CMASK(C0,C1,t); \
    { float a=MX3(C0[0],C0[1],C1[0]),b=MX3(C0[2],C0[3],C1[1]); a=MX3(a,C1[2],C1[3]); \
      _Pragma("unroll") for(int r=4;r<16;r+=4){a=MX3(a,C0[r],C0[r+1]);b=MX3(b,C0[r+2],C0[r+3]);a=MX3(a,C1[r],C1[r+1]);b=MX3(b,C1[r+2],C1[r+3]);} \
      float rm=__builtin_fmaxf(a,b); { auto rr=__builtin_amdgcn_permlane32_swap(__float_as_uint(rm),__float_as_uint(rm),false,false); rm=__builtin_fmaxf(__uint_as_float(rr[0]),__uint_as_float(rr[1])); } \
      resc=false; \
      if(__builtin_expect(__any(rm>(float)THRL),0)){ const float dl=__builtin_fmaxf(rm,0.f); mhat+=dl; \
        _Pragma("unroll") for(int r=0;r<16;++r){C0[r]-=dl;C1[r]-=dl;} \
        _Pragma("unroll") for(int r=0;r<16;++r)negm[r]=-mhat; asm volatile("":"+v"(negm)); \
        const float f=__builtin_amdgcn_exp2f(-dl); l_reg*=f; if(hi==0)wsf[r32]=f; resc=true; } } \
    SBAR(); \
    GAPB2(o[0]=__builtin_amdgcn_mfma_f32_32x32x16_bf16(PAF(0),VFR(0),o[0],0,0,0), C0,0); VRD(0,2); SBAR(); \
    GAPB2(o[1]=__builtin_amdgcn_mfma_f32_32x32x16_bf16(PAF(0),VFR(1),o[1],0,0,0), C0,2); VRD(1,6); SBAR(); \
    GAPB2(o[2]=__builtin_amdgcn_mfma_f32_32x32x16_bf16(PAF(0),VFR(2),o[2],0,0,0), C0,4); VRD(2,10); SBAR(); \
    GAPB2(o[3]=__builtin_amdgcn_mfma_f32_32x32x16_bf16(PAF(0),VFR(3),o[3],0,0,0), C0,6); VRD(3,14); SBAR(); \
    GAPB2(o[0]=__builtin_amdgcn_mfma_f32_32x32x16_bf16(PAF(1),VFR(4),o[0],0,0,0), C0,8); VRD(4,3); SBAR(); \
    GAPB2(o[1]=__builtin_amdgcn_mfma_f32_32x32x16_bf16(PAF(1),VFR(5),o[1],0,0,0), C0,10); VRD(5,7); SBAR(); \
    GAPB2(o[2]=__builtin_amdgcn_mfma_f32_32x32x16_bf16(PAF(1),VFR(6),o[2],0,0,0), C0,12); VRD(6,11); SBAR(); \
    GAPB2(o[3]=__builtin_amdgcn_mfma_f32_32x32x16_bf16(PAF(1),VFR(7),o[3],0,0,0), C0,14); VRD(7,15); SBAR(); \
    GAPB2(o[0]=__builtin_amdgcn_mfma_f32_32x32x16_bf16(PAF(2),VFR(0),o[0],0,0,0), C1,0); \
    GAPB2(o[1]=__builtin_amdgcn_mfma_f32_32x32x16_bf16(PAF(2),VFR(1),o[1],0,0,0), C1,2); \
    KRD(GL,0); GAPB2(o[2]=__builtin_amdgcn_mfma_f32_32x32x16_bf16(PAF(2),VFR(2),o[2],0,0,0), C1,4); \
    KRD(GL,1); GAPB2(o[3]=__builtin_amdgcn_mfma_f32_32x32x16_bf16(PAF(2),VFR(3),o[3],0,0,0), C1,6); \
    KRD(GL,2); GAPB2(o[0]=__builtin_amdgcn_mfma_f32_32x32x16_bf16(PAF(3),VFR(4),o[0],0,0,0), C1,8); \
    KRD(GL,3); GAPB2(o[1]=__builtin_amdgcn_mfma_f32_32x32x16_bf16(PAF(3),VFR(5),o[1],0,0,0), C1,10); \
    GAPB2(o[2]=__builtin_amdgcn_mfma_f32_32x32x16_bf16(PAF(3),VFR(6),o[2],0,0,0), C1,12); \
    GAPB2(o[3]=__builtin_amdgcn_mfma_f32_32x32x16_bf16(PAF(3),VFR(7),o[3],0,0,0), C1,14); \
    }while(0)
  int t=1;
  #undef CMASK
  #define CMASK(P0,P1,t) do{}while(0)
  for(;t+5<NT;t+=2){
    STEP(pB0,pB1,pA0,pA1,t,true,true,true);     WAIT_BAR(3); RESC(); ROT();
    STEP(pA0,pA1,pB0,pB1,t+1,true,true,true);   WAIT_BAR(3); RESC(); ROT();
  }
  #undef CMASK
  #define CMASK(P0,P1,t) do{int jb_=(t)-(NT-4); if(jb_>=0)cmask(P0,P1,jb_,wid,mode);}while(0)
  #define ENDW(tt) do{ if((tt)+3<NT){WAIT_BAR(3);} else if((tt)+2<NT){WAIT_BAR(2);} else {WAIT_BAR(0);} }while(0)
  for(;t+1<NT;t+=2){
    STEP(pB0,pB1,pA0,pA1,t,(t+3<NT),(t+1<NT),(t+1<NT));       ENDW(t);   RESC(); ROT();
    STEP(pA0,pA1,pB0,pB1,t+1,(t+4<NT),(t+2<NT),(t+2<NT));     ENDW(t+1); RESC(); ROT();
  }
  STEP(pB0,pB1,pA0,pA1,NT-1,false,false,false); RESC();
  { float sacc=pB0[0]+pB0[1]; _Pragma("unroll") for(int r=2;r<16;++r)sacc+=pB0[r]; _Pragma("unroll") for(int r=0;r<16;++r)sacc+=pB1[r]; l_reg+=sacc;
    pw0=(u32x4){PKW(pB0,0),PKW(pB0,2),PKW(pB0,4),PKW(pB0,6)};pw1=(u32x4){PKW(pB0,8),PKW(pB0,10),PKW(pB0,12),PKW(pB0,14)};pw2=(u32x4){PKW(pB1,0),PKW(pB1,2),PKW(pB1,4),PKW(pB1,6)};pw3=(u32x4){PKW(pB1,8),PKW(pB1,10),PKW(pB1,12),PKW(pB1,14)};
    SBAR(); pv(o,vb0+2*sl_cur,PAF(0),PAF(1),PAF(2),PAF(3)); }
  #undef PKW
  #undef PAF
  #undef VFR
  #undef PIN
  #undef MX3
  #undef GAPA
  #undef GAPB
  #undef EX
  #undef VRD
  #undef KRD
  #undef STEP
  #undef ENDW
  {auto rr=__builtin_amdgcn_permlane32_swap(__float_as_uint(l_reg),__float_as_uint(l_reg),false,false);l_reg=__uint_as_float(rr[0])+__uint_as_float(rr[1]);}
  if(hi==0)wsf[32+r32]=l_reg;asm volatile("s_waitcnt lgkmcnt(0)":::"memory");
  float rli[16];
  #pragma unroll
  for(int r=0;r<16;++r)rli[r]=__builtin_amdgcn_rcpf(wsf[32+crow(r,hi)]);
  bf16*Ow=Ow0+(long)wid*QBLK*OP;
  asm volatile("s_waitcnt lgkmcnt(0)\n\ts_barrier":::"memory");
  { bf16*stg=(bf16*)(shm+LDS_OST)+wid*4096;
    #pragma unroll
    for(int r=0;r<16;++r){const int orow=crow(r,hi);
      #pragma unroll
      for(int d0=0;d0<4;++d0)stg[orow*128+d0*32+r32]=__float2bfloat16(o[d0][r]*rli[r]);}
    asm volatile("s_waitcnt lgkmcnt(0)":::"memory");
    #pragma unroll
    for(int i=0;i<8;++i){const int row=i*4+(lane>>4),ch=lane&15; const u32x4 v=*(const u32x4*)(stg+row*128+ch*8); ATTN_STORE16(Ow+(long)row*OP+ch*8,v);} }
  asm volatile("s_waitcnt lgkmcnt(0)\n\ts_barrier":::"memory");
  #undef DMA_K
  #undef DMA_V
  #undef CMASK
  #undef START
  #undef RESC
  #undef ROT
}
constexpr int ATTN_LDS_BYTES=LDS_BYTES;
#undef SBAR
#undef WAIT_BAR
}
#ifndef CPU_TEST
namespace mixf {
typedef short bf16x8 __attribute__((ext_vector_type(8)));
typedef float f32x4 __attribute__((ext_vector_type(4)));
typedef unsigned u32x4 __attribute__((ext_vector_type(4)));
typedef unsigned u32x2 __attribute__((ext_vector_type(2)));
constexpr int DAB_LD = 264;
__device__ __forceinline__ float fsig(float x) { return __builtin_amdgcn_rcpf(1.0f + __expf(-x)); }
__device__ __forceinline__ float wsum(float v, int lane) {
#pragma unroll
    for (int o = 1; o < 64; o <<= 1) v += __builtin_bit_cast(float, __builtin_amdgcn_ds_bpermute((lane ^ o) << 2, __builtin_bit_cast(int, v)));
    return v;
}
__device__ __forceinline__ unsigned pk2f(float lo, float hi) { return f2bf(lo) | (f2bf(hi) << 16); }

__device__ __forceinline__ void unpack8(const u32x4 w, float* o) {
    o[0] = __builtin_bit_cast(float, w.x << 16); o[1] = __builtin_bit_cast(float, w.x & 0xffff0000u); o[2] = __builtin_bit_cast(float, w.y << 16); o[3] = __builtin_bit_cast(float, w.y & 0xffff0000u);
    o[4] = __builtin_bit_cast(float, w.z << 16); o[5] = __builtin_bit_cast(float, w.z & 0xffff0000u); o[6] = __builtin_bit_cast(float, w.w << 16); o[7] = __builtin_bit_cast(float, w.w & 0xffff0000u);
}
__device__ __forceinline__ u32x4 pack8(const float* v) { u32x4 w; w.x = pk2f(v[0], v[1]); w.y = pk2f(v[2], v[3]); w.z = pk2f(v[4], v[5]); w.w = pk2f(v[6], v[7]); return w; }
__device__ __forceinline__ void st8f(float* p, const float* v) { *(f32x4*)p = (f32x4){v[0], v[1], v[2], v[3]}; *(f32x4*)(p + 4) = (f32x4){v[4], v[5], v[6], v[7]}; }
__device__ __forceinline__ void ld8f(const float* p, float* v) { const f32x4 a = *(const f32x4*)p, c = *(const f32x4*)(p + 4); v[0] = a[0]; v[1] = a[1]; v[2] = a[2]; v[3] = a[3]; v[4] = c[0]; v[5] = c[1]; v[6] = c[2]; v[7] = c[3]; }
constexpr int TG_OFF = 0, TC_OFF = 62 * 512, TB_OFF = TC_OFF + 34 * 512, TU_OFF = TB_OFF + 32 * 512, DAB_OFF = TU_OFF + 47 * 512, MIX_LDS_END = DAB_OFF + 32 * DAB_LD * 2;
static_assert(MIX_LDS_END <= 131072 && (34 + 32) * 512 >= 32 * 1024, "mixer-prep LDS map");
template <int NR> __device__ __forceinline__ void item(const MixP& P, const MixItem& I, const bf16_t* __restrict__ WTg, int tid, LAS unsigned char* L) {
    constexpr int HR = NR / 2, RPT = NR / 16;
    LAS bf16_t* TG = (LAS bf16_t*)(L + TG_OFF); LAS bf16_t* TC = (LAS bf16_t*)(L + TC_OFF); LAS bf16_t* TB = (LAS bf16_t*)(L + TB_OFF); LAS bf16_t* TU = (LAS bf16_t*)(L + TU_OFF);
    LAS bf16_t* DAB = (LAS bf16_t*)(L + DAB_OFF); LAS float* cv = (LAS float*)(L + TC_OFF);
    const int ch = tid & 255, half = tid >> 8, lane = tid & 63, wid = tid >> 6, l = P.layer, b = I.b, t0 = I.t0;
    const int cg = tid & 31, rs = tid >> 5, ch0 = cg * 8;
    const bool smp = I.sample != 0;
    const size_t mb = smp ? (size_t)SEQ + (size_t)DECS * b : 0;
    const bf16_t* __restrict__ Z = P.Z;
    {
        u32x4 qa[4], qg[4], qc[3], qs[3], qu[3], qb[2];
        const u32x4 z4 = {0u, 0u, 0u, 0u};
#pragma unroll
        for (int k = 0; k < 4; ++k) { const int i = rs + 16 * k, t = t0 - 30 + i; qa[k] = z4; qg[k] = z4; if (i < NR + 30 && t >= 0) { const bf16_t* zr = Z + (mb + t) * ZW + ch0; qa[k] = *(const u32x4*)(zr + 1024); qg[k] = *(const u32x4*)(zr + 1280); } }
#pragma unroll
        for (int k = 0; k < 3; ++k) { const int i = rs + 16 * k, t = t0 - 2 + i; qc[k] = z4; qs[k] = z4; if (i < NR + 2 && t >= 0) { const bf16_t* zr = Z + (mb + t) * ZW + ch0; qc[k] = *(const u32x4*)(zr + 512); qs[k] = *(const u32x4*)(zr + 768); } }
#pragma unroll
        for (int k = 0; k < 3; ++k) { const int i = rs + 16 * k, t = t0 - 15 + i; qu[k] = z4; if (i < NR + 15 && t >= 0) qu[k] = *(const u32x4*)(Z + (mb + t) * ZW + ch0); }
#pragma unroll
        for (int k = 0; k < 2; ++k) { const int i = rs + 16 * k; qb[k] = z4; if (i < NR) qb[k] = *(const u32x4*)(Z + (mb + t0 + i) * ZW + 256 + ch0); }
#pragma unroll
        for (int k = 0; k < 4; ++k) { const int i = rs + 16 * k, t = t0 - 30 + i;
            if (i < NR + 30) { float v[8];
                if (t >= 0) { float a[8], g[8]; unpack8(qa[k], a); unpack8(qg[k], g);
#pragma unroll
                    for (int j = 0; j < 8; ++j) v[j] = a[j] * fsig(g[j]); }
                else if (smp) ld8f(P.st_cconv + ((size_t)b * 30 + (30 + t)) * 256 + ch0, v);
                else {
#pragma unroll
                    for (int j = 0; j < 8; ++j) v[j] = 0.f; }
                *(LAS u32x4*)(TG + i * 256 + ch0) = pack8(v);
                if (!smp) { if (t >= t0 && t >= SEQ - 30) st8f(P.out + O_CCP + ((size_t)l * 30 + (t - (SEQ - 30))) * 256 + ch0, v); }
                else { if (t + 14 >= 0) st8f(P.out + O_CCS + (((size_t)l * DECB + b) * 30 + (t + 14)) * 256 + ch0, v); } } }
#pragma unroll
        for (int k = 0; k < 3; ++k) { const int i = rs + 16 * k, t = t0 - 2 + i;
            if (i < NR + 2) { float v[8];
                if (t >= 0) { float a[8], g[8]; unpack8(qc[k], a); unpack8(qs[k], g);
#pragma unroll
                    for (int j = 0; j < 8; ++j) v[j] = a[j] * g[j]; }
                else if (smp) ld8f(P.st_sconv + ((size_t)b * 2 + (2 + t)) * 256 + ch0, v);
                else {
#pragma unroll
                    for (int j = 0; j < 8; ++j) v[j] = 0.f; }
                *(LAS u32x4*)(TC + i * 256 + ch0) = pack8(v);
                if (!smp) { if (t >= t0 && t >= SEQ - 2) st8f(P.out + O_SCP + ((size_t)l * 2 + (t - (SEQ - 2))) * 256 + ch0, v); }
                else { if (t >= DECS - 2) st8f(P.out + O_SCS + (((size_t)l * DECB + b) * 2 + (t - (DECS - 2))) * 256 + ch0, v); } } }
#pragma unroll
        for (int k = 0; k < 3; ++k) { const int i = rs + 16 * k, t = t0 - 15 + i;
            if (i < NR + 15) { float v[8];
                if (t >= 0) unpack8(qu[k], v);
                else if (smp) ld8f(P.st_pool + ((size_t)b * 15 + (15 + t)) * 256 + ch0, v);
                else {
#pragma unroll
                    for (int j = 0; j < 8; ++j) v[j] = 0.f; }
                *(LAS u32x4*)(TU + i * 256 + ch0) = (t >= 0) ? qu[k] : pack8(v);
                if (!smp) { if (t >= t0 && t >= SEQ - 15) st8f(P.out + O_POOLP + ((size_t)l * 15 + (t - (SEQ - 15))) * 256 + ch0, v); }
                else { if (t >= 1) st8f(P.out + O_POOLS + (((size_t)l * DECB + b) * 15 + (t - 1)) * 256 + ch0, v); } } }
#pragma unroll
        for (int k = 0; k < 2; ++k) { const int i = rs + 16 * k; if (i < NR) *(LAS u32x4*)(TB + i * 256 + ch0) = qb[k]; }
    }
    __syncthreads();
    {
        float w0[8], w1[8], w2[8]; ld8f(P.sconv_w + ch0, w0); ld8f(P.sconv_w + 256 + ch0, w1); ld8f(P.sconv_w + 512 + ch0, w2);
#pragma unroll
        for (int j = 0; j < RPT; ++j) { const int r = rs * RPT + j; float c0[8], c1[8], c2[8], zb[8], y[8];
            unpack8(*(const LAS u32x4*)(TC + r * 256 + ch0), c0); unpack8(*(const LAS u32x4*)(TC + (r + 1) * 256 + ch0), c1); unpack8(*(const LAS u32x4*)(TC + (r + 2) * 256 + ch0), c2);
            unpack8(*(const LAS u32x4*)(TB + r * 256 + ch0), zb);
#pragma unroll
            for (int q = 0; q < 8; ++q) y[q] = zb[q] * (w0[q] * c0[q] + w1[q] * c1[q] + w2[q] * c2[q]);
            *(u32x4*)(P.Y + (mb + t0 + r) * YW + 256 + ch0) = pack8(y); }
    }
    {
        float u[HR + 15];
#pragma unroll
        for (int i = 0; i < HR + 15; ++i) u[i] = bf2f(TU[(half * HR + i) * 256 + ch]);
        const int win = 2 << (ch >> 6);
#pragma unroll
        for (int r = 0; r < HR; ++r) { const int t = t0 + half * HR + r; float s = 0.f;
#pragma unroll
            for (int j = 0; j < 16; ++j) if (j < win) s += u[15 + r - j];
            const int pos = smp ? PAST + t : t; const int cnt = (pos + 1 < win) ? pos + 1 : win;
            DAB[(half * HR + r) * DAB_LD + ch] = (bf16_t)f2bf(s / (float)cnt - u[15 + r]); }
    }
    __syncthreads();
    {
        float g[HR + 30];
#pragma unroll
        for (int i = 0; i < HR + 30; ++i) g[i] = bf2f(TG[(half * HR + i) * 256 + ch]);
        float w[31];
#pragma unroll
        for (int j = 0; j < 31; ++j) w[j] = P.cconv_w[j * 256 + ch];
#pragma unroll
        for (int r = 0; r < HR; ++r) { float a = 0.f;
#pragma unroll
            for (int j = 0; j < 31; ++j) a += w[j] * g[r + j];
            cv[(half * HR + r) * 256 + ch] = a; }
    }
    {
        const int fr = lane & 15, fq = lane >> 4, g4 = wid >> 1, nt0 = (wid & 1) * 2;
        bf16x8 Bw[2][2], Ad[2][2];
#pragma unroll
        for (int nt = 0; nt < 2; ++nt)
#pragma unroll
            for (int ks = 0; ks < 2; ++ks) Bw[nt][ks] = *(const bf16x8*)(WTg + (size_t)(g4 * 64 + (nt0 + nt) * 16 + fr) * 64 + ks * 32 + fq * 8);
#pragma unroll
        for (int mt = 0; mt < NR / 16; ++mt)
#pragma unroll
            for (int ks = 0; ks < 2; ++ks) Ad[mt][ks] = *(const LAS bf16x8*)(DAB + (mt * 16 + fr) * DAB_LD + g4 * 64 + ks * 32 + fq * 8);
#pragma unroll
        for (int mt = 0; mt < NR / 16; ++mt)
#pragma unroll
            for (int nt = 0; nt < 2; ++nt) { f32x4 acc = {0.f, 0.f, 0.f, 0.f};
                acc = __builtin_amdgcn_mfma_f32_16x16x32_bf16(Bw[nt][0], Ad[mt][0], acc, 0, 0, 0);
                acc = __builtin_amdgcn_mfma_f32_16x16x32_bf16(Bw[nt][1], Ad[mt][1], acc, 0, 0, 0);
                const int col = g4 * 64 + (nt0 + nt) * 16 + 4 * fq; const f32x4 sc = *(const f32x4*)(P.pool_scale + col);
                u32x2 wv; wv.x = pk2f(acc[0] * sc[0], acc[1] * sc[1]); wv.y = pk2f(acc[2] * sc[2], acc[3] * sc[3]);
                *(u32x2*)(P.Y + (mb + t0 + mt * 16 + fr) * YW + col) = wv; }
    }
    __syncthreads();
    {
        const f32x4 bi = *(const f32x4*)(P.cconv_b + 4 * lane), lg = *(const f32x4*)(P.ln_g + 4 * lane), lb = *(const f32x4*)(P.ln_b + 4 * lane);
#pragma unroll
        for (int k = 0; k < NR / 8; ++k) { const int r = wid + 8 * k;
            f32x4 v = *(const LAS f32x4*)(cv + r * 256 + 4 * lane) + bi;
            const float mean = wsum((v[0] + v[1]) + (v[2] + v[3]), lane) * (1.f / 256.f);
            v = v - mean;
            const float rstd = 1.0f / sqrtf(wsum((v[0] * v[0] + v[1] * v[1]) + (v[2] * v[2] + v[3] * v[3]), lane) * (1.f / 256.f) + EPS);
            f32x4 y = v * rstd * lg + lb;
#pragma unroll
            for (int i = 0; i < 4; ++i) y[i] = y[i] * fsig(y[i]);
            u32x2 wv; wv.x = pk2f(y[0], y[1]); wv.y = pk2f(y[2], y[3]);
            *(u32x2*)(P.Y + (mb + t0 + r) * YW + 512 + 4 * lane) = wv; }
    }
    {
        const int map = lane >> 3, c8 = lane & 7, cm = c8 & 3;
        float gq[8], gk[8]; ld8f(P.qg + 8 * c8, gq); ld8f(P.kg + 8 * c8, gk);
        const float sgn = (c8 < 4) ? -1.0f : 1.0f;
#pragma unroll
        for (int k = 0; k < NR / 8; ++k) { const int rr = wid * (NR / 8) + k, t = t0 + rr; const int pos = smp ? PAST + t : t;
            float co[8], si[8]; ld8f(P.rope + (size_t)pos * 64 + 8 * cm, co); ld8f(P.rope + (size_t)pos * 64 + 32 + 8 * cm, si);
            const bf16_t* src = Z + (mb + t) * ZW + 1536 + lane * 8;
            const u32x4 wq = *(const u32x4*)src, wk = *(const u32x4*)(src + 512);
#pragma unroll
            for (int kind = 0; kind < 2; ++kind) { float v[8]; unpack8(kind ? wk : wq, v);
                float ss = 0.f;
#pragma unroll
                for (int j = 0; j < 8; ++j) ss += v[j] * v[j];
                ss += __builtin_bit_cast(float, __builtin_amdgcn_ds_bpermute((lane ^ 1) << 2, __builtin_bit_cast(int, ss)));
                ss += __builtin_bit_cast(float, __builtin_amdgcn_ds_bpermute((lane ^ 2) << 2, __builtin_bit_cast(int, ss)));
                ss += __builtin_bit_cast(float, __builtin_amdgcn_ds_bpermute((lane ^ 4) << 2, __builtin_bit_cast(int, ss)));
                const float rn = 1.0f / sqrtf(ss * (1.f / 64.f) + EPS);
                float a[8], o[8];
#pragma unroll
                for (int j = 0; j < 8; ++j) a[j] = v[j] * rn * (kind ? gk[j] : gq[j]);
#pragma unroll
                for (int j = 0; j < 8; ++j) { const float ap = __builtin_bit_cast(float, __builtin_amdgcn_ds_bpermute((lane ^ 4) << 2, __builtin_bit_cast(int, a[j])));
                    o[j] = a[j] * co[j] + sgn * ap * si[j]; }
                if (kind == 0) {
#pragma unroll
                    for (int j = 0; j < 8; ++j) o[j] *= C2;
                    bf16_t* dst = smp ? P.QS + ((size_t)b * QSROWS + t) * 512 + lane * 8 : P.Qp + (size_t)t * 512 + lane * 8;
                    *(u32x4*)dst = pack8(o);
                } else {
                    if (!smp) *(u32x4*)(P.Kp + (size_t)t * 512 + lane * 8) = pack8(o);
                    st8f(smp ? P.out + O_KS + (((size_t)l * DECB + b) * DECS + t) * 512 + lane * 8 : P.out + O_KP + ((size_t)l * SEQ + t) * 512 + lane * 8, o);
                }
            }
        }
#pragma unroll
        for (int k = 0; k < NR / 8; ++k) { const int idx = tid + 512 * k, r2 = idx >> 6, c8 = (idx & 63) * 8, t = t0 + r2;
            const u32x4 w = *(const u32x4*)(Z + (mb + t) * ZW + 2560 + c8);
            if (!smp) *(u32x4*)(P.Vp + (size_t)t * 512 + c8) = w;
            f32x4* od = (f32x4*)(smp ? P.out + O_VS + (((size_t)l * DECB + b) * DECS + t) * 512 + c8 : P.out + O_VP + ((size_t)l * SEQ + t) * 512 + c8);
            od[0] = (f32x4){__builtin_bit_cast(float, w.x << 16), __builtin_bit_cast(float, w.x & 0xffff0000u), __builtin_bit_cast(float, w.y << 16), __builtin_bit_cast(float, w.y & 0xffff0000u)};
            od[1] = (f32x4){__builtin_bit_cast(float, w.z << 16), __builtin_bit_cast(float, w.z & 0xffff0000u), __builtin_bit_cast(float, w.w << 16), __builtin_bit_cast(float, w.w & 0xffff0000u)}; }
    }
    __syncthreads();
}
}
#endif
#ifndef CPU_TEST_NEVER
namespace tailg {
#define TG_GAS __attribute__((address_space(1)))
typedef short bf16x8 __attribute__((ext_vector_type(8)));
typedef float f32x4 __attribute__((ext_vector_type(4)));
typedef unsigned u32x2 __attribute__((ext_vector_type(2)));
constexpr int TM = 32, TN = 64, NTILES = (MS / TM) * (D / TN);
template <int MODE> struct Tail {
    const bf16_t* A; const bf16_t* Bt;
    float* X; bf16_t* XB; float* SSP;
    bf16_t* OUT; const bf16_t* gate;
    int K, lda, ldb, ldg; float s; int pad;
};
template <int MODE> __device__ __forceinline__ void run(LAS unsigned char* lds, int tid, int bx, int G, const Tail<MODE>& t) {
    const int lane = tid & 63, w = __builtin_amdgcn_readfirstlane(tid >> 6), fr = lane & 15, fq = lane >> 4;
    LAS f32x4* RED = (LAS f32x4*)lds;
    const int nsteps = t.K / 32, per = nsteps / 8;
    for (int tile = bx; tile < NTILES; tile += G) {
        const int R0 = SEQ + (tile >> 4) * TM, C0 = (tile & 15) * TN;
        const bf16_t* ap = t.A + (size_t)(R0 + fr) * t.lda + fq * 8;
        const bf16_t* bp = t.Bt + (size_t)(C0 + fr) * t.ldb + fq * 8;
        f32x4 acc[2][4], tot[2][4];
#pragma unroll
        for (int m = 0; m < 2; ++m)
#pragma unroll
            for (int n = 0; n < 4; ++n) { acc[m][n] = (f32x4){0.f, 0.f, 0.f, 0.f}; tot[m][n] = (f32x4){0.f, 0.f, 0.f, 0.f}; }
        const int s0 = w * per;
        for (int sb = 0; sb < per; sb += 6) {
            bf16x8 af[6][2], bf[6][4];
#pragma unroll
            for (int j = 0; j < 6; ++j) if (sb + j < per) { const int k0 = (s0 + sb + j) * 32;
#pragma unroll
                for (int m = 0; m < 2; ++m) af[j][m] = *(const TG_GAS bf16x8*)(ap + (size_t)(m * 16) * t.lda + k0);
#pragma unroll
                for (int n = 0; n < 4; ++n) bf[j][n] = *(const TG_GAS bf16x8*)(bp + (size_t)(n * 16) * t.ldb + k0); }
#pragma unroll
            for (int j = 0; j < 6; ++j) if (sb + j < per) {
#pragma unroll
                for (int m = 0; m < 2; ++m)
#pragma unroll
                    for (int n = 0; n < 4; ++n) acc[m][n] = __builtin_amdgcn_mfma_f32_16x16x32_bf16(bf[j][n], af[j][m], acc[m][n], 0, 0, 0);
                if (MODE == 1) {
                    const int st = s0 + sb + j, br = st < 8 ? 0 : st < 16 ? 1 : st < 24 ? 2 : 3, nx = st + 1, brn = nx < 8 ? 0 : nx < 16 ? 1 : nx < 24 ? 2 : 3;
                    if (brn != br || sb + j + 1 == per) {
#pragma unroll
                        for (int m = 0; m < 2; ++m)
#pragma unroll
                            for (int n = 0; n < 4; ++n) { const bf16_t* fp = t.gate + (size_t)(R0 + m * 16 + fr) * t.ldg + C0 + n * 16 + 4 * fq;
                                f32x4 g = {1.f, 1.f, 1.f, 1.f};
#pragma unroll
                                for (int q = 3; q >= 0; --q) if (q >= br) { const u32x2 gw = *(const TG_GAS u32x2*)(fp + q * 1024);
                                    g[0] *= __builtin_bit_cast(float, gw.x << 16); g[1] *= __builtin_bit_cast(float, gw.x & 0xffff0000u); g[2] *= __builtin_bit_cast(float, gw.y << 16); g[3] *= __builtin_bit_cast(float, gw.y & 0xffff0000u); }
                                tot[m][n] += g * acc[m][n]; acc[m][n] = (f32x4){0.f, 0.f, 0.f, 0.f}; }
                    }
                }
            }
        }
#pragma unroll
        for (int m = 0; m < 2; ++m)
#pragma unroll
            for (int n = 0; n < 4; ++n) RED[(w * 8 + m * 4 + n) * 64 + lane] = (MODE == 1) ? tot[m][n] : acc[m][n];
        __syncthreads();
        f32x4 v = RED[(0 * 8 + w) * 64 + lane];
#pragma unroll
        for (int w2 = 1; w2 < 8; ++w2) v += RED[(w2 * 8 + w) * 64 + lane];
        const size_t row = (size_t)(R0 + (w >> 2) * 16 + fr); const int col = C0 + (w & 3) * 16 + 4 * fq;
        if (MODE == 0) { const u32x2 xw = *(const TG_GAS u32x2*)(t.XB + row * D + col);
            f32x4 xn; xn[0] = __builtin_bit_cast(float, xw.x << 16); xn[1] = __builtin_bit_cast(float, xw.x & 0xffff0000u); xn[2] = __builtin_bit_cast(float, xw.y << 16); xn[3] = __builtin_bit_cast(float, xw.y & 0xffff0000u);
            xn += v * t.s;
            if (t.X) *(TG_GAS f32x4*)(t.X + row * D + col) = xn;
            else { u32x2 o; o.x = f2bf(xn[0]) | (f2bf(xn[1]) << 16); o.y = f2bf(xn[2]) | (f2bf(xn[3]) << 16); *(TG_GAS u32x2*)(t.XB + row * D + col) = o; }
            float ss = (xn[0] * xn[0] + xn[1] * xn[1]) + (xn[2] * xn[2] + xn[3] * xn[3]);
            ss += __builtin_bit_cast(float, __builtin_amdgcn_ds_bpermute((lane ^ 16) << 2, __builtin_bit_cast(int, ss)));
            ss += __builtin_bit_cast(float, __builtin_amdgcn_ds_bpermute((lane ^ 32) << 2, __builtin_bit_cast(int, ss)));
            __syncthreads();
            LAS float* PS = (LAS float*)lds;
            if (fq == 0) PS[((w >> 2) * 16 + fr) * 4 + (w & 3)] = ss;
            __syncthreads();
            if (tid < TM) t.SSP[(size_t)(R0 - SEQ + tid) * 16 + (tile & 15)] = (PS[tid * 4] + PS[tid * 4 + 1]) + (PS[tid * 4 + 2] + PS[tid * 4 + 3]); }
        else { u32x2 o; o.x = f2bf(v[0]) | (f2bf(v[1]) << 16); o.y = f2bf(v[2]) | (f2bf(v[3]) << 16); *(TG_GAS u32x2*)(t.OUT + row * D + col) = o; }
        __syncthreads();
    }
}
}
#endif
#ifndef CPU_TEST
namespace sattn {
using attn_body::bf16x8; using attn_body::f32x16; using attn_body::s16x4; using attn_body::crow; using attn_body::vtr; using attn_body::lds_cptr; using attn_body::cvtpk_s;
typedef float f32x4 __attribute__((ext_vector_type(4)));
typedef float f32x2 __attribute__((ext_vector_type(2)));
typedef unsigned u32x4 __attribute__((ext_vector_type(4)));
#define SA_GAS __attribute__((address_space(1)))
constexpr int PART_LD = 132;
constexpr int N_ITEMS = DECB * 4 * 2;
__device__ __forceinline__ bf16x8 pack8f(const f32x4 a, const f32x4 c) { u32x4 w; w.x = cvtpk_s(a[0], a[1]); w.y = cvtpk_s(a[2], a[3]); w.z = cvtpk_s(c[0], c[1]); w.w = cvtpk_s(c[2], c[3]); return __builtin_bit_cast(bf16x8, w); }

__device__ __forceinline__ void item(int it, const float* __restrict__ ck, const float* __restrict__ cv, const float* __restrict__ knew, const float* __restrict__ vnew, const bf16_t* __restrict__ QS, float* PART,
                                     LAS unsigned char* lds, LAS float* ex, int tid) {
    const int lane = tid & 63, w = __builtin_amdgcn_readfirstlane(tid >> 6), r32 = lane & 31, hi = lane >> 5;
    const int b = it >> 3, h = (it >> 1) & 3, kh = it & 1;
    LAS float* EXM = ex; LAS float* wsf = ex + 512 + w * 32;
    bf16x8 qn[4]; const bool mp1 = (r32 >> 4) != 0;
    { const int q = r32 & 15, mp = r32 >> 4; const bf16_t* qrow = QS + ((size_t)b * QSROWS + q) * 512 + (2 * h + mp) * 64 + hi * 8;
#pragma unroll
      for (int j = 0; j < 4; ++j) qn[j] = *(const SA_GAS bf16x8*)(qrow + j * 16); }
    float m = -INFINITY, l = 0.f; f32x16 o[4];
#pragma unroll
    for (int d = 0; d < 4; ++d) o[d] = f32x16{};
    LAS unsigned char* vbuf = lds + w * 8192;
    const lds_cptr vp = (lds_cptr)vbuf + ((lane >> 4) & 1) * 32 + (lane & 3) * 8 + (4 * hi + ((lane & 15) >> 2)) * 64;
    const int nsteps = (kh == 1 && w == 7) ? 5 : 4;
    f32x4 ka[8], kc[8], va[2][4], vc[2][4];
#define SA_STEP_PTRS(ss, Kp_, Vp_, nv_) do { if ((ss) < 4) { const size_t k0_ = (size_t)b * PAST + 1024 * kh + 128 * w + 32 * (ss); Kp_ = ck + k0_ * 512 + h * 128; Vp_ = cv + k0_ * 512 + h * 128; nv_ = 32; } \
        else { Kp_ = knew + (size_t)b * DECS * 512 + h * 128; Vp_ = vnew + (size_t)b * DECS * 512 + h * 128; nv_ = DECS; } } while (0)
#define SA_LOAD_K(ss) do { const float* Kp_; const float* Vp_; int nv_; SA_STEP_PTRS(ss, Kp_, Vp_, nv_); (void)Vp_; int t_ = tid; asm volatile("" : "+v"(t_)); const int r_ = t_ & 31, h_ = (t_ >> 5) & 1; \
        const int krow_ = r_ < nv_ ? r_ : nv_ - 1; const SA_GAS f32x4* kp_ = (const SA_GAS f32x4*)(Kp_ + (size_t)krow_ * 512 + h_ * 8); \
        _Pragma("unroll") for (int j = 0; j < 8; ++j) { ka[j] = kp_[j * 4]; kc[j] = kp_[j * 4 + 1]; } } while (0)
#define SA_LOAD_V(ss) do { const float* Kp_; const float* Vp_; int nv_; SA_STEP_PTRS(ss, Kp_, Vp_, nv_); (void)Kp_; \
        int t_ = tid; asm volatile("" : "+v"(t_)); const int k16_ = (t_ & 63) >> 2, c4_ = t_ & 3; \
        _Pragma("unroll") for (int kq = 0; kq < 2; ++kq) { const int vr_ = kq * 16 + k16_, vrow_ = vr_ < nv_ ? vr_ : nv_ - 1; const SA_GAS f32x4* vpn_ = (const SA_GAS f32x4*)(Vp_ + (size_t)vrow_ * 512 + c4_ * 8); \
            _Pragma("unroll") for (int db = 0; db < 4; ++db) { va[kq][db] = vpn_[db * 8]; vc[kq][db] = vpn_[db * 8 + 1]; } } } while (0)
    SA_LOAD_K(0);
    for (int s = 0; s < nsteps; ++s) {
        const int nvalid = (s < 4) ? 32 : DECS;
        SA_LOAD_V(s);
        __builtin_amdgcn_sched_barrier(0);
        f32x16 S = f32x16{};
#pragma unroll
        for (int j = 0; j < 8; ++j) { const bf16x8 z8 = {0, 0, 0, 0, 0, 0, 0, 0}; const bf16x8 qb = ((j >= 4) == mp1) ? qn[j & 3] : z8; S = __builtin_amdgcn_mfma_f32_32x32x16_bf16(pack8f(ka[j], kc[j]), qb, S, 0, 0, 0); }
        if (nvalid < 32) {
#pragma unroll
            for (int r = 0; r < 16; ++r) if (crow(r, hi) >= nvalid) S[r] = -INFINITY; }
        float rm = S[0];
#pragma unroll
        for (int r = 1; r < 16; ++r) rm = fmaxf(rm, S[r]);
        { auto rr = __builtin_amdgcn_permlane32_swap(__float_as_uint(rm), __float_as_uint(rm), false, false); rm = fmaxf(__uint_as_float(rr[0]), __uint_as_float(rr[1])); }
        const float mn = fmaxf(m, rm), alpha = __builtin_amdgcn_exp2f(m - mn); m = mn;
        float ls = 0.f;
#pragma unroll
        for (int r = 0; r < 16; ++r) { S[r] = __builtin_amdgcn_exp2f(S[r] - mn); ls += S[r]; }
        l = l * alpha + ls;
        u32x4 pw0, pw1;
        pw0 = (u32x4){cvtpk_s(S[0], S[1]), cvtpk_s(S[2], S[3]), cvtpk_s(S[4], S[5]), cvtpk_s(S[6], S[7])};
        pw1 = (u32x4){cvtpk_s(S[8], S[9]), cvtpk_s(S[10], S[11]), cvtpk_s(S[12], S[13]), cvtpk_s(S[14], S[15])};
        if (hi == 0) wsf[r32] = alpha;
        __builtin_amdgcn_sched_barrier(0);
        if (s + 1 < nsteps) SA_LOAD_K(s + 1);
        __builtin_amdgcn_sched_barrier(0);
#pragma unroll
        for (int kq = 0; kq < 2; ++kq)
#pragma unroll
            for (int db = 0; db < 4; ++db) *(LAS bf16x8*)(vbuf + (db * 2 + kq) * 1024 + lane * 16) = pack8f(va[kq][db], vc[kq][db]);
        asm volatile("s_waitcnt lgkmcnt(0)" ::: "memory");
#pragma unroll
        for (int d = 0; d < 4; ++d)
#pragma unroll
            for (int r = 0; r < 16; ++r) o[d][r] *= wsf[crow(r, hi)];
#pragma unroll
        for (int kq = 0; kq < 2; ++kq)
#pragma unroll
            for (int db = 0; db < 4; ++db) { const s16x4 vlo = vtr(vp + (db * 2 + kq) * 1024), vhi = vtr(vp + (db * 2 + kq) * 1024 + 512);
                const bf16x8 vf = (bf16x8){vlo[0], vlo[1], vlo[2], vlo[3], vhi[0], vhi[1], vhi[2], vhi[3]};
                o[db] = __builtin_amdgcn_mfma_f32_32x32x16_bf16(__builtin_bit_cast(bf16x8, kq ? pw1 : pw0), vf, o[db], 0, 0, 0); }
        asm volatile("s_waitcnt lgkmcnt(0)" ::: "memory");
    }
#undef SA_STEP_PTRS
#undef SA_LOAD_K
#undef SA_LOAD_V
    int tidb = tid; asm volatile("" : "+v"(tidb)); const int laneb = tidb & 63, r32b = laneb & 31, hib = laneb >> 5;
    LAS float* wsfb = ex + 512 + w * 32;
    { auto rr = __builtin_amdgcn_permlane32_swap(__float_as_uint(l), __float_as_uint(l), false, false); l = __uint_as_float(rr[0]) + __uint_as_float(rr[1]); }
    if (hib == 0) { EXM[w * 64 + r32b] = m; EXM[w * 64 + 32 + r32b] = l; }
    __syncthreads();
    float Mx = EXM[r32b];
#pragma unroll
    for (int w2 = 1; w2 < 8; ++w2) Mx = fmaxf(Mx, EXM[w2 * 64 + r32b]);
    float Lx = 0.f;
#pragma unroll
    for (int w2 = 0; w2 < 8; ++w2) Lx += __builtin_amdgcn_exp2f(EXM[w2 * 64 + r32b] - Mx) * EXM[w2 * 64 + 32 + r32b];
    if (hib == 0) wsfb[r32b] = __builtin_amdgcn_exp2f(m - Mx);
    asm volatile("s_waitcnt lgkmcnt(0)" ::: "memory");
#pragma unroll
    for (int d = 0; d < 4; ++d)
#pragma unroll
        for (int r = 0; r < 16; ++r) o[d][r] *= wsfb[crow(r, hib)];
    __syncthreads();
    LAS float* OX = (LAS float*)lds;
#pragma unroll
    for (int d = 0; d < 4; ++d)
#pragma unroll
        for (int r = 0; r < 16; ++r) OX[(w * 32 + crow(r, hib)) * 128 + 32 * d + r32b] = o[d][r];
    __syncthreads();
#pragma unroll
    for (int k = 0; k < 4; ++k) { const int row = 4 * w + k; f32x2 acc = *(const LAS f32x2*)(OX + row * 128 + 2 * laneb);
#pragma unroll
        for (int w2 = 1; w2 < 8; ++w2) acc += *(const LAS f32x2*)(OX + (w2 * 32 + row) * 128 + 2 * laneb);
        *(SA_GAS f32x2*)(PART + ((size_t)it * 32 + row) * PART_LD + 2 * laneb) = acc; }
    if (hib == 0 && (r32b >> 2) == w) { SA_GAS float* pp = (SA_GAS float*)(PART + ((size_t)it * 32 + r32b) * PART_LD + 128); pp[0] = Mx; pp[1] = Lx; }
    __syncthreads();
}
__device__ __forceinline__ void post_sample(const float* PART, bf16_t* Ydst  , int b, int t, int h, float lam, float scale, const float* subln_g) {
    const SA_GAS float* p00 = (const SA_GAS float*)(PART + ((size_t)(((b * 4 + h) * 2 + 0) * 32) + t) * PART_LD);
    const SA_GAS float* p01 = p00 + 16 * PART_LD; const SA_GAS float* p10 = p00 + 32 * PART_LD; const SA_GAS float* p11 = p10 + 16 * PART_LD;
    float a0, a1, c0, c1;
    { const float M0 = p00[128], L0 = p00[129], M1 = p10[128], L1 = p10[129], Mx = fmaxf(M0, M1), f0 = __builtin_amdgcn_exp2f(M0 - Mx), f1 = __builtin_amdgcn_exp2f(M1 - Mx), inv = 1.0f / (f0 * L0 + f1 * L1); a0 = f0 * inv; a1 = f1 * inv; }
    { const float M0 = p01[128], L0 = p01[129], M1 = p11[128], L1 = p11[129], Mx = fmaxf(M0, M1), f0 = __builtin_amdgcn_exp2f(M0 - Mx), f1 = __builtin_amdgcn_exp2f(M1 - Mx), inv = 1.0f / (f0 * L0 + f1 * L1); c0 = f0 * inv; c1 = f1 * inv; }
    float ss = 0.f;
    for (int i = 0; i < 32; ++i) { const f32x4 x0 = *(const SA_GAS f32x4*)(p00 + 4 * i), x1 = *(const SA_GAS f32x4*)(p10 + 4 * i), y0 = *(const SA_GAS f32x4*)(p01 + 4 * i), y1 = *(const SA_GAS f32x4*)(p11 + 4 * i);
        const f32x4 ov = (x0 * a0 + x1 * a1) - lam * (y0 * c0 + y1 * c1); ss += (ov[0] * ov[0] + ov[1] * ov[1]) + (ov[2] * ov[2] + ov[3] * ov[3]); }
    const float rn = scale / sqrtf(ss * (1.f / 128.f) + EPS);
    for (int i = 0; i < 16; ++i) { float ob[8];
#pragma unroll
        for (int hh = 0; hh < 2; ++hh) { const int i4 = 2 * i + hh; const f32x4 x0 = *(const SA_GAS f32x4*)(p00 + 4 * i4), x1 = *(const SA_GAS f32x4*)(p10 + 4 * i4), y0 = *(const SA_GAS f32x4*)(p01 + 4 * i4), y1 = *(const SA_GAS f32x4*)(p11 + 4 * i4);
            const f32x4 ov = (x0 * a0 + x1 * a1) - lam * (y0 * c0 + y1 * c1);
#pragma unroll
            for (int j = 0; j < 4; ++j) ob[4 * hh + j] = ov[j] * rn * subln_g[8 * i + 4 * hh + j]; }
        st_bf16x8(Ydst + 8 * i, ob); }
}
__device__ __forceinline__ void post_sample_wave(const float* PART, bf16_t* Ydst  , int b, int t, int h, float lam, float scale, const float* subln_g, int lane) {
    const SA_GAS float* p00 = (const SA_GAS float*)(PART + ((size_t)(((b * 4 + h) * 2 + 0) * 32) + t) * PART_LD);
    const SA_GAS float* p01 = p00 + 16 * PART_LD; const SA_GAS float* p10 = p00 + 32 * PART_LD; const SA_GAS float* p11 = p10 + 16 * PART_LD;
    const f32x2 x0 = *(const SA_GAS f32x2*)(p00 + 2 * lane), x1 = *(const SA_GAS f32x2*)(p10 + 2 * lane), y0 = *(const SA_GAS f32x2*)(p01 + 2 * lane), y1 = *(const SA_GAS f32x2*)(p11 + 2 * lane);
    const f32x2 ml00 = *(const SA_GAS f32x2*)(p00 + 128), ml10 = *(const SA_GAS f32x2*)(p10 + 128), ml01 = *(const SA_GAS f32x2*)(p01 + 128), ml11 = *(const SA_GAS f32x2*)(p11 + 128);
    const f32x2 sg = *(const SA_GAS f32x2*)(subln_g + 2 * lane);
    float a0, a1, c0, c1;
    { const float Mx = fmaxf(ml00[0], ml10[0]), f0 = __builtin_amdgcn_exp2f(ml00[0] - Mx), f1 = __builtin_amdgcn_exp2f(ml10[0] - Mx), inv = 1.0f / (f0 * ml00[1] + f1 * ml10[1]); a0 = f0 * inv; a1 = f1 * inv; }
    { const float Mx = fmaxf(ml01[0], ml11[0]), f0 = __builtin_amdgcn_exp2f(ml01[0] - Mx), f1 = __builtin_amdgcn_exp2f(ml11[0] - Mx), inv = 1.0f / (f0 * ml01[1] + f1 * ml11[1]); c0 = f0 * inv; c1 = f1 * inv; }
    const f32x2 ov = (x0 * a0 + x1 * a1) - lam * (y0 * c0 + y1 * c1);
    const float ss = mixf::wsum(ov[0] * ov[0] + ov[1] * ov[1], lane);
    const float rn = scale / sqrtf(ss * (1.f / 128.f) + EPS);
    const unsigned w = f2bf(ov[0] * rn * sg[0]) | (f2bf(ov[1] * rn * sg[1]) << 16);
    *(SA_GAS unsigned*)(Ydst + 2 * lane) = w;
}
}
#endif
constexpr int NWAVES = 8;
static_assert(M % 256 == 0 && SEQ % 512 == 0 && PAST % 64 == 0 && KSROWS % 128 == 0, "shape assumptions of the GEMM / attention bodies");
constexpr size_t MiB = 1u << 20;
constexpr size_t alup(size_t x) { return (x + MiB - 1) / MiB * MiB; }
constexpr size_t LW_GU1 = 0, LW_D1 = LW_GU1 + (size_t)NGU * D * 2, LW_IN = LW_D1 + (size_t)D * FF * 2, LW_P = LW_IN + (size_t)ZW * D * 2, LW_O = LW_P + (size_t)D * YW * 2,
                 LW_GU2 = LW_O + (size_t)D * D * 2, LW_D2 = LW_GU2 + (size_t)NGU * D * 2, LW_BYTES = LW_D2 + (size_t)D * FF * 2;
constexpr size_t WS_CTL = 0, CTL_ZERO_BYTES = 1 * MiB;
constexpr size_t WS_ROPE = 1 * MiB;
constexpr size_t WS_PWT = alup(WS_ROPE + (size_t)ROPE_ROWS * 64 * 4);
constexpr size_t WS_W = alup(WS_PWT + (size_t)DEPTH * 256 * 64 * 2);
constexpr size_t WS_XN = alup(WS_W + (size_t)DEPTH * LW_BYTES);
constexpr size_t WS_ACT = alup(WS_XN + (size_t)M * D * 2);
constexpr size_t WS_Z = alup(WS_ACT + (size_t)M * FF * 2);
constexpr size_t WS_Y = alup(WS_Z + (size_t)M * ZW * 2);
constexpr size_t WS_QP = alup(WS_Y + (size_t)M * YW * 2);
constexpr size_t WS_KP = alup(WS_QP + (size_t)SEQ * 512 * 2);
constexpr size_t WS_VP = alup(WS_KP + (size_t)SEQ * 512 * 2);
constexpr size_t WS_OB = alup(WS_VP + (size_t)SEQ * 512 * 2);
constexpr size_t WS_QS = alup(WS_OB + (size_t)SEQ * 1024 * 2);
constexpr size_t WS_KS = alup(WS_QS + (size_t)DECB * QSROWS * 512 * 2);
constexpr size_t WS_VS = alup(WS_KS + (size_t)DECB * KSROWS * 512 * 2);
constexpr size_t WS_OS = alup(WS_VS + (size_t)DECB * KSROWS * 512 * 2);
constexpr size_t WS_MG = alup(WS_OS + (size_t)DECB * QSROWS * 1024 * 2);
constexpr size_t WS_MRG = alup(WS_MG + (size_t)M * D * 4);
constexpr size_t WS_SSP = alup(WS_MRG + (size_t)M * D * 2);
constexpr size_t WS_SS4 = alup(WS_SSP + (size_t)M * 16 * 4);
constexpr size_t WS_PART = alup(WS_SS4 + (size_t)SEQ * 4 * 4);
constexpr size_t WS_FAC = alup(WS_PART + (size_t)DECB * 8 * 32 * 132 * 4);
constexpr size_t WS_END = alup(WS_FAC + (size_t)(SEQ / 256) * 4 * 4 * 131072);
constexpr int CW_TMO = 0, CW_BAR = 4096;

constexpr int RING_OFF = 0, RING_BYTES = 131072;
constexpr int LDSCTL_OFF = RING_BYTES, MISC_OFF = LDSCTL_OFF + 320;
constexpr int LDS_BYTES = 147456;

typedef unsigned v4u __attribute__((ext_vector_type(4)));
typedef unsigned v2u __attribute__((ext_vector_type(2)));
typedef float f32x4 __attribute__((ext_vector_type(4)));
#define LDS_WAIT() asm volatile("s_waitcnt lgkmcnt(0)" ::: "memory")
#define VM_WAIT() asm volatile("s_waitcnt vmcnt(0)" ::: "memory")
__device__ __forceinline__ unsigned pk2(float lo, float hi) { return f2bf(lo) | (f2bf(hi) << 16); }

__device__ __forceinline__ int tid_now(int wv) { int z = 0; asm volatile("" : "+v"(z)); return wv * 64 + (int)__builtin_amdgcn_mbcnt_hi(~0u, __builtin_amdgcn_mbcnt_lo(~0u, (unsigned)z)); }
#define XB_TMO      128
#define XB_XCNT(j)  (256  + 64 * (j))
#define XB_XSUB(j)  (1280 + 64 * (j))
#define XB_XGEN(j)  (2304 + 64 * (j))
#define XB_TOP      3328
#define XB_TOPGEN   3392
#define XCD_BAR_WORDS 3456
#define XB_SPIN_CAP (1u << 18)
__device__ __forceinline__ unsigned xb_ld(unsigned* p)              { return __hip_atomic_load(p, __ATOMIC_RELAXED, __HIP_MEMORY_SCOPE_AGENT); }
__device__ __forceinline__ unsigned xb_add(unsigned* p, unsigned v) { return __hip_atomic_fetch_add(p, v, __ATOMIC_RELAXED, __HIP_MEMORY_SCOPE_AGENT); }
__device__ __forceinline__ unsigned xb_xcc_id() { return (unsigned)__builtin_amdgcn_s_getreg((3 << 11) | 20) & 0xFu; }
#define XB_SPIN(cond, bar) do { unsigned _sp = 0; while (cond) { __builtin_amdgcn_s_sleep(1); \
    if ((++_sp & 255u) == 0u) { if (xb_ld(&(bar)[XB_TMO])) break; if (_sp > XB_SPIN_CAP) { atomicAdd(&(bar)[XB_TMO], 1u); break; } } } } while (0)
struct XcdBarrier { unsigned* bar; unsigned x; volatile LAS unsigned* st; };
__device__ __forceinline__ XcdBarrier xcd_barrier_post(unsigned* bar, volatile LAS unsigned* st, int wv) {
    XcdBarrier b; b.bar = bar; b.x = xb_xcc_id(); b.st = st;
    if (tid_now(wv) == 0) (void)xb_add(&bar[XB_XCNT(b.x)], 1u);
    return b;
}
__device__ __forceinline__ void xcd_barrier_complete(unsigned* bar, unsigned x, unsigned& nloc, unsigned& nx) {
    const unsigned G = gridDim.x * gridDim.y * gridDim.z;
    unsigned sum, cnt, mine, sp = 0u;
    for (;;) {
        sum = 0u; cnt = 0u; mine = 0u;
#pragma unroll
        for (unsigned j = 0; j < 16; ++j) { const unsigned c = xb_ld(&bar[XB_XCNT(j)]); sum += c; cnt += (c > 0u) ? 1u : 0u; mine = (j == x) ? c : mine; }
        if (sum == G) break;
        __builtin_amdgcn_s_sleep(1);
        if ((++sp & 255u) == 0u) { if (xb_ld(&bar[XB_TMO])) break; if (sp > XB_SPIN_CAP) { atomicAdd(&bar[XB_TMO], 1u); break; } }
    }
    nloc = mine > 0u ? mine : 1u; nx = cnt > 0u ? cnt : 1u;
}
__device__ __forceinline__ void xcd_barrier(const XcdBarrier& b, int wv) {
    asm volatile("s_waitcnt vmcnt(0)" ::: "memory");
    __syncthreads();
    if (tid_now(wv) == 0) {
        unsigned* bar = b.bar; asm volatile("" : "+s"(bar));
        unsigned bx_ = b.x; asm volatile("" : "+s"(bx_));
        __builtin_amdgcn_s_waitcnt(0);
        unsigned nloc = b.st[0], nx = b.st[1];
        if (nloc == 0u) { xcd_barrier_complete(bar, bx_, nloc, nx); b.st[0] = nloc; b.st[1] = nx; }
        const unsigned old = xb_add(&bar[XB_XSUB(bx_)], 1u);
        const unsigned gen = old / nloc;
        if (old + 1u == (gen + 1u) * nloc) {
            __builtin_amdgcn_fence(__ATOMIC_RELEASE, "agent");
            asm volatile("s_waitcnt vmcnt(0)" ::: "memory");
            const unsigned og = xb_add(&bar[XB_TOP], 1u);
            const unsigned tg = og / nx;
            if (og + 1u == (tg + 1u) * nx) xb_add(&bar[XB_TOPGEN], 1u);
            else XB_SPIN(xb_ld(&bar[XB_TOPGEN]) == tg, bar);
            __builtin_amdgcn_fence(__ATOMIC_ACQUIRE, "agent");
            xb_add(&bar[XB_XGEN(bx_)], 1u);
            asm volatile("s_waitcnt vmcnt(0)" ::: "memory");
        } else {
            XB_SPIN(xb_ld(&bar[XB_XGEN(bx_)]) == gen, bar);
            __builtin_amdgcn_fence(__ATOMIC_ACQUIRE, "agent");
            asm volatile("s_waitcnt vmcnt(0)" ::: "memory");
        }
    }
    __syncthreads();
}

__device__ __forceinline__ float wave_sum(float v, int lane) {
#pragma unroll
    for (int o = 1; o < 64; o <<= 1) v += __builtin_bit_cast(float, __builtin_amdgcn_ds_bpermute((lane ^ o) << 2, __builtin_bit_cast(int, v)));
    return v;
}
__device__ __forceinline__ void transpose_item(const float* W, int K, int N, bf16_t* WT, int ldk, int koff, int mode, LAS float* scr, int item, int lane, const float* gk = nullptr) {
    const int nblk = N / 32, kb = item / nblk, nb = item % nblk, k0 = 64 * kb, n0 = 32 * nb;
    const int drow0 = (mode == 0 || mode == 3) ? n0 : ((n0 >> 7) * 256 + (mode - 1) * 128 + (n0 & 127));
    float wv_[32];
#pragma unroll
    for (int i = 0; i < 32; ++i) wv_[i] = W[(size_t)(k0 + 2 * i + (lane >> 5)) * N + n0 + (lane & 31)];
#pragma unroll
    for (int i = 0; i < 32; ++i) scr[(2 * i + (lane >> 5)) * 33 + (lane & 31)] = wv_[i];
    LDS_WAIT(); asm volatile("" ::: "memory");
    const int c = lane & 7;
    f32x4 ga = {1.f, 1.f, 1.f, 1.f}, gb = {1.f, 1.f, 1.f, 1.f}; if (gk) { ga = *(const f32x4*)(gk + k0 + 8 * c); gb = *(const f32x4*)(gk + k0 + 8 * c + 4); }
#pragma unroll
    for (int j = 0; j < 4; ++j) { const int n = (lane >> 3) + 8 * j; const LAS float* s = scr + (8 * c) * 33 + n;
        v4u o; o.x = pk2(s[0 * 33] * ga[0], s[1 * 33] * ga[1]); o.y = pk2(s[2 * 33] * ga[2], s[3 * 33] * ga[3]); o.z = pk2(s[4 * 33] * gb[0], s[5 * 33] * gb[1]); o.w = pk2(s[6 * 33] * gb[2], s[7 * 33] * gb[3]);
        int drow = drow0 + n;
        if (mode == 3 && n0 >= 3072) { const int gi = n0 + n - 3072, br = gi >> 10, oc = gi & 1023, r6 = oc & 63; drow = (12 + (oc >> 6)) * 256 + 128 * (br >> 1) + 32 * (r6 >> 4) + 8 * ((r6 & 15) >> 2) + 4 * (br & 1) + (oc & 3); }
        *(v4u*)(WT + (size_t)drow * ldk + koff + k0 + 8 * c) = o; }
    LDS_WAIT(); asm volatile("" ::: "memory");
}
__device__ __forceinline__ void sincos_d(double a, float& s_out, float& c_out) {
    const double k = rint(a * 0.63661977236758134308);
    double r = fma(-k, 1.57079632679489655800e+00, a); r = fma(-k, 6.12323399573676603587e-17, r);
    const double r2 = r * r;
    const double sp = r * (1.0 + r2 * (-1.0 / 6 + r2 * (1.0 / 120 + r2 * (-1.0 / 5040 + r2 * (1.0 / 362880 + r2 * (-1.0 / 39916800 + r2 * (1.0 / 6227020800.0)))))));
    const double cp = 1.0 + r2 * (-0.5 + r2 * (1.0 / 24 + r2 * (-1.0 / 720 + r2 * (1.0 / 40320 + r2 * (-1.0 / 3628800 + r2 * (1.0 / 479001600 + r2 * (-1.0 / 87178291200.0)))))));
    const int q = (int)((long long)k & 3);
    const double s = (q == 0) ? sp : (q == 1) ? cp : (q == 2) ? -sp : -cp;
    const double c = (q == 0) ? cp : (q == 1) ? -sp : (q == 2) ? -cp : sp;
    s_out = (float)s; c_out = (float)c;
}

struct Args { const float* in[36]; float* out; unsigned char* ws; float inv_freq[32]; float lam_init[4]; };

#define LAUNDER_V(x) asm volatile("" : "+v"(x))
#define LAUNDER_S(x) asm volatile("" : "+s"(x))
struct Ctx { LAS unsigned char* lds; int tid, lane, wave, bx, vcu, G, gtid, GT; };
__device__ __forceinline__ Ctx mkctx(LAS unsigned char* lds, int wv) {
    Ctx c; c.lds = lds; int tid = tid_now(wv); LAUNDER_V(tid); int bx = blockIdx.x; LAUNDER_S(bx); int G = gridDim.x; LAUNDER_S(G);
    c.tid = tid; c.lane = tid & 63; c.wave = __builtin_amdgcn_readfirstlane(tid >> 6); c.bx = bx; c.G = G; c.vcu = (G % 8 == 0) ? (bx % 8) * (G / 8) + bx / 8 : bx;
    c.gtid = bx * (NWAVES * 64) + tid; c.GT = G * NWAVES * 64; return c;
}
#define GAS __attribute__((address_space(1)))
template <class T> __device__ __forceinline__ T* lp(T* q) { asm volatile("" : "+s"(q)); return (T*)(GAS T*)q; }
__device__ __forceinline__ const float* inptr(LAS unsigned char* lds, int i) {
    int ii = i; LAUNDER_S(ii);
    const LAS unsigned* t = (const LAS unsigned*)(lds + LDSCTL_OFF) + 2 * ii; const unsigned lo = __builtin_amdgcn_readfirstlane(t[0]), hi = __builtin_amdgcn_readfirstlane(t[1]);
    return (const float*)(GAS const float*)(((unsigned long long)hi << 32) | lo);
}

__device__ __forceinline__ void norm_phase(LAS unsigned char* lds, int wv, const float* X, const float* g, bf16_t* XN) {
    const Ctx c = mkctx(lds, wv);
    const int gw = c.vcu * NWAVES + c.wave, NGW = c.G * NWAVES;
    f32x4 gv[4];
#pragma unroll
    for (int j = 0; j < 4; ++j) gv[j] = *((const f32x4*)g + c.lane + 64 * j);
    for (int m = gw; m < M; m += NGW) {
        const f32x4* xr = (const f32x4*)(X + (size_t)m * D) + c.lane;
        f32x4 v[4]; float s = 0.f;
#pragma unroll
        for (int j = 0; j < 4; ++j) { v[j] = xr[64 * j]; s += (v[j].x * v[j].x + v[j].y * v[j].y) + (v[j].z * v[j].z + v[j].w * v[j].w); }
        const float r = 1.0f / sqrtf(wave_sum(s, c.lane) * (1.f / D) + EPS);
        v2u* o8 = (v2u*)(XN + (size_t)m * D) + c.lane;
#pragma unroll
        for (int j = 0; j < 4; ++j) { v2u w; w.x = pk2(v[j].x * r * gv[j].x, v[j].y * r * gv[j].y); w.y = pk2(v[j].z * r * gv[j].z, v[j].w * r * gv[j].w); o8[64 * j] = w; }
    }
}

constexpr int I_G = (D / 64) * (FF / 32), I_D = (FF / 64) * (D / 32), I_IN = (D / 64) * (ZW / 32), I_PA = (256 / 64) * (D / 32), I_PD = (512 / 64) * (D / 32), I_O = (D / 64) * (D / 32);
constexpr int I_LAYER = 6 * I_G + I_IN + 3 * I_PA + I_PD + I_O; static_assert(I_G == I_D, "item counts");
__device__ __forceinline__ void weight_item(LAS unsigned char* lds, unsigned char* ws, LAS float* scr, int l, int r, int lane) {
    unsigned char* wl = ws + WS_W + (size_t)l * LW_BYTES;
    if (r < I_G) { transpose_item(inptr(lds, 8) + (size_t)l * D * FF, D, FF, (bf16_t*)(wl + LW_GU1), D, 0, 1, scr, r, lane, inptr(lds, 7) + (size_t)l * D); return; } r -= I_G;
    if (r < I_G) { transpose_item(inptr(lds, 9) + (size_t)l * D * FF, D, FF, (bf16_t*)(wl + LW_GU1), D, 0, 2, scr, r, lane, inptr(lds, 7) + (size_t)l * D); return; } r -= I_G;
    if (r < I_D) { transpose_item(inptr(lds, 10) + (size_t)l * FF * D, FF, D, (bf16_t*)(wl + LW_D1), FF, 0, 0, scr, r, lane); return; } r -= I_D;
    if (r < I_IN) { transpose_item(inptr(lds, 12) + (size_t)l * D * ZW, D, ZW, (bf16_t*)(wl + LW_IN), D, 0, 3, scr, r, lane, inptr(lds, 11) + (size_t)l * D); return; } r -= I_IN;
    if (r < I_PA) { transpose_item(inptr(lds, 27) + (size_t)l * 256 * D, 256, D, (bf16_t*)(wl + LW_P), YW, 0, 0, scr, r, lane); return; } r -= I_PA;
    if (r < I_PA) { transpose_item(inptr(lds, 28) + (size_t)l * 256 * D, 256, D, (bf16_t*)(wl + LW_P), YW, 256, 0, scr, r, lane); return; } r -= I_PA;
    if (r < I_PA) { transpose_item(inptr(lds, 29) + (size_t)l * 256 * D, 256, D, (bf16_t*)(wl + LW_P), YW, 512, 0, scr, r, lane); return; } r -= I_PA;
    if (r < I_PD) { transpose_item(inptr(lds, 30) + (size_t)l * 512 * D, 512, D, (bf16_t*)(wl + LW_P), YW, 768, 0, scr, r, lane); return; } r -= I_PD;
    if (r < I_O) { transpose_item(inptr(lds, 31) + (size_t)l * D * D, D, D, (bf16_t*)(wl + LW_O), D, 0, 0, scr, r, lane); return; } r -= I_O;
    if (r < I_G) { transpose_item(inptr(lds, 33) + (size_t)l * D * FF, D, FF, (bf16_t*)(wl + LW_GU2), D, 0, 1, scr, r, lane, inptr(lds, 32) + (size_t)l * D); return; } r -= I_G;
    if (r < I_G) { transpose_item(inptr(lds, 34) + (size_t)l * D * FF, D, FF, (bf16_t*)(wl + LW_GU2), D, 0, 2, scr, r, lane, inptr(lds, 32) + (size_t)l * D); return; } r -= I_G;
    transpose_item(inptr(lds, 35) + (size_t)l * FF * D, FF, D, (bf16_t*)(wl + LW_D2), FF, 0, 0, scr, r, lane);
}
constexpr int NU_GU = (M / 256) * (NGU / 256), NU_IN = (M / 256) * (ZW / 256);
constexpr int IDLE_GU = 256 - NU_GU % 256, IDLE_IN = 256 - NU_IN % 256, IDLE_ALL = 2 * IDLE_GU + IDLE_IN;
constexpr int WS1 = (int)((long)I_LAYER * IDLE_GU / IDLE_ALL), WS2 = WS1 + (int)((long)I_LAYER * IDLE_IN / IDLE_ALL);
static_assert(NU_GU % 256 != 0 && NU_IN % 256 != 0 && WS2 < I_LAYER, "idle-slot weight conversion needs idle workgroups in those phases");
__device__ __forceinline__ void weight_slice(LAS unsigned char* lds, int wv, unsigned char* ws, int l, int beg, int end, int nbusy) {
    const Ctx c = mkctx(lds, wv);
    if (c.G != 256 || l >= DEPTH || c.bx < nbusy) return;
    LAS float* scr = (LAS float*)(lds + RING_OFF + c.wave * 16384);
    const int nset = 256 - nbusy, iset = c.bx - nbusy;
    for (int it = beg + iset * NWAVES + c.wave; it < end; it += nset * NWAVES) weight_item(lds, ws, scr, l, it, c.lane);
}

__device__ __forceinline__ void prologue_phase(LAS unsigned char* lds, int wv, unsigned char* ws, float* X, const Args& args) {
    const Ctx c = mkctx(lds, wv);
    LAS float* scr = (LAS float*)(lds + RING_OFF + c.wave * 16384);
    const int gw = c.vcu * NWAVES + c.wave, NGW = c.G * NWAVES;
    { const int nl = (c.G == 256) ? 1 : DEPTH;
      for (int it = gw; it < nl * I_LAYER; it += NGW) weight_item(lds, ws, scr, it / I_LAYER, it % I_LAYER, c.lane); }
    { const float* s0 = inptr(lds, 0); const float* s1 = inptr(lds, 1); bf16_t* XB = (bf16_t*)(ws + WS_XN); float* SSP = (float*)(ws + WS_SSP); float* SS4 = (float*)(ws + WS_SS4);
      for (int m = gw; m < M; m += NGW) { const f32x4* xr = (const f32x4*)((m < SEQ) ? s0 + (size_t)m * D : s1 + (size_t)(m - SEQ) * D) + c.lane;
          v2u* o8 = (v2u*)(XB + (size_t)m * D) + c.lane; float ss = 0.f;
#pragma unroll
          for (int j = 0; j < 4; ++j) { const f32x4 v = xr[64 * j]; v2u w; w.x = pk2(v.x, v.y); w.y = pk2(v.z, v.w); o8[64 * j] = w; ss += (v.x * v.x + v.y * v.y) + (v.z * v.z + v.w * v.w); }
          ss = wave_sum(ss, c.lane);
          if (m < SEQ) { if (c.lane < 4) SS4[(size_t)m * 4 + c.lane] = (c.lane == 0) ? ss : 0.f; } else if (c.lane < 16) SSP[(size_t)(m - SEQ) * 16 + c.lane] = (c.lane == 0) ? ss : 0.f; } }
    { bf16_t* QS = (bf16_t*)(ws + WS_QS); v4u z = {0u, 0u, 0u, 0u};
      for (size_t i = c.gtid; i < (size_t)DECB * QSROWS * 512 / 8; i += c.GT) ((v4u*)QS)[i] = z;
    }
    { bf16_t* wt = (bf16_t*)(ws + WS_PWT); const float* pw = inptr(lds, 13);
      for (int i = c.gtid; i < DEPTH * 4 * 64 * 64; i += c.GT) { const int k = i & 63, n = (i >> 6) & 63, g = (i >> 12) & 3, l = i >> 14; wt[i] = (bf16_t)f2bf(pw[(((size_t)l * 4 + g) * 64 + k) * 64 + n]); } }
    { float* rope = (float*)(ws + WS_ROPE);
      for (int i = c.gtid; i < ROPE_ROWS * 32; i += c.GT) { const int p = i >> 5, j = i & 31; const float ang = (float)p * args.inv_freq[j]; float s, co; sincos_d((double)ang, s, co); rope[(size_t)p * 64 + j] = co; rope[(size_t)p * 64 + 32 + j] = s; } }
}

__device__ __forceinline__ void mix_phase(LAS unsigned char* lds, int wv, unsigned char* ws, float* out, int l) {
    const Ctx c = mkctx(lds, wv);
    MixP P; P.Z = (const bf16_t*)(ws + WS_Z); P.Y = (bf16_t*)(ws + WS_Y); P.Qp = (bf16_t*)(ws + WS_QP); P.Kp = (bf16_t*)(ws + WS_KP); P.Vp = (bf16_t*)(ws + WS_VP);
    P.QS = (bf16_t*)(ws + WS_QS); P.KS = (bf16_t*)(ws + WS_KS); P.VS = (bf16_t*)(ws + WS_VS); P.out = out;
    P.st_pool = inptr(lds, 4) + (size_t)l * DECB * 15 * 256; P.st_sconv = inptr(lds, 5) + (size_t)l * DECB * 2 * 256; P.st_cconv = inptr(lds, 6) + (size_t)l * DECB * 30 * 256;
    P.pool_w = inptr(lds, 13) + (size_t)l * 4 * 64 * 64; P.pool_scale = inptr(lds, 14) + (size_t)l * 256; P.sconv_w = inptr(lds, 15) + (size_t)l * 3 * 256; P.cconv_w = inptr(lds, 16) + (size_t)l * 31 * 256;
    P.cconv_b = inptr(lds, 17) + (size_t)l * 256; P.ln_g = inptr(lds, 18) + (size_t)l * 256; P.ln_b = inptr(lds, 19) + (size_t)l * 256; P.qg = inptr(lds, 20) + (size_t)l * 64; P.kg = inptr(lds, 21) + (size_t)l * 64;
    P.rope = (const float*)(ws + WS_ROPE); P.layer = l;
    const bf16_t* WTg = (const bf16_t*)(ws + WS_PWT) + (size_t)l * 256 * 64;
    for (int it = c.bx; it < N_MIX_ITEMS; it += c.G) { const MixItem I = mix_item(it);
        int tl = c.tid; LAUNDER_V(tl);
        if (I.nrows == 32) mixf::item<32>(P, I, WTg, tl, lds + RING_OFF); else mixf::item<16>(P, I, WTg, tl, lds + RING_OFF); }
}

__device__ __forceinline__ void attn_phase(unsigned char* lds_generic, LAS unsigned char* lds, int wv, unsigned char* ws, float* out, int l) {
    const Ctx c = mkctx(lds, wv);
    typedef attn_body::bf16 abf;
    constexpr int NQB = SEQ / 256, NPAIR = 8 * (NQB / 2);
    const abf* QP = (const abf*)(ws + WS_QP); const abf* KP = (const abf*)(ws + WS_KP); const abf* VP = (const abf*)(ws + WS_VP); abf* OB = (abf*)(ws + WS_OB);
    int p = c.vcu, half = 0;
    while (p < NPAIR) { const int map = p / (NQB / 2), s = p % (NQB / 2), qb = half ? NQB - 1 - s : s;
        attn_body::attn_unit<8>(QP + (size_t)qb * 256 * 512 + map * 64, KP + map * 64, VP + (map >> 1) * 128, OB + (size_t)qb * 256 * 1024 + map * 128, 4 * qb + 4, 0, (char*)lds_generic + RING_OFF, c.tid);
        if (half) { p += c.G; half = 0; } else half = 1; }
    const float* ck = inptr(lds, 2) + (size_t)l * DECB * PAST * 512; const float* cv = inptr(lds, 3) + (size_t)l * DECB * PAST * 512;
    const float* knew = out + O_KS + (size_t)l * MS * 512; const float* vnew = out + O_VS + (size_t)l * MS * 512;
    for (int it = c.vcu; it < sattn::N_ITEMS; it += c.G)
        sattn::item(it, ck, cv, knew, vnew, (const bf16_t*)(ws + WS_QS), (float*)(ws + WS_PART), lds + RING_OFF, (LAS float*)(lds + LDSCTL_OFF + 1024), c.tid);
}

__device__ __forceinline__ void post_phase(LAS unsigned char* lds, int wv, unsigned char* ws, int l) {
    const Ctx c = mkctx(lds, wv);
    const LAS float* LAMF = (const LAS float*)(lds + MISC_OFF + 64);
    const float lam = LAMF[l], sc = LAMF[4 + l]; const float* sg = inptr(lds, 26) + (size_t)l * 128;
    const bf16_t* OB = (const bf16_t*)(ws + WS_OB); bf16_t* Y = (bf16_t*)(ws + WS_Y);
    { const int gw = c.vcu * NWAVES + c.wave, NGW = c.G * NWAVES, lane = c.lane, odd = (lane >> 3) & 1, hh = lane >> 4, eo = 16 * (lane & 7) + 8 * odd;
      const f32x4 ga = *(const GAS f32x4*)(sg + eo), gb = *(const GAS f32x4*)(sg + eo + 4);
      constexpr int PB = 8;
      for (int m0 = gw; m0 < SEQ; m0 += NGW * PB) { v4u wa[PB], wb[PB];
#pragma unroll
        for (int r = 0; r < PB; ++r) { const int m = m0 + r * NGW; if (m < SEQ) { const GAS v4u* src = (const GAS v4u*)(OB + (size_t)m * 1024) + 2 * lane; wa[r] = src[0]; wb[r] = src[1]; } }
#pragma unroll
        for (int r = 0; r < PB; ++r) { const int m = m0 + r * NGW; if (m >= SEQ) break; const v4u w0 = wa[r], w1 = wb[r];
          float v[16];
          v[0] = __builtin_bit_cast(float, w0.x << 16); v[1] = __builtin_bit_cast(float, w0.x & 0xffff0000u); v[2] = __builtin_bit_cast(float, w0.y << 16); v[3] = __builtin_bit_cast(float, w0.y & 0xffff0000u);
          v[4] = __builtin_bit_cast(float, w0.z << 16); v[5] = __builtin_bit_cast(float, w0.z & 0xffff0000u); v[6] = __builtin_bit_cast(float, w0.w << 16); v[7] = __builtin_bit_cast(float, w0.w & 0xffff0000u);
          v[8] = __builtin_bit_cast(float, w1.x << 16); v[9] = __builtin_bit_cast(float, w1.x & 0xffff0000u); v[10] = __builtin_bit_cast(float, w1.y << 16); v[11] = __builtin_bit_cast(float, w1.y & 0xffff0000u);
          v[12] = __builtin_bit_cast(float, w1.z << 16); v[13] = __builtin_bit_cast(float, w1.z & 0xffff0000u); v[14] = __builtin_bit_cast(float, w1.w << 16); v[15] = __builtin_bit_cast(float, w1.w & 0xffff0000u);
          float o[8], ss = 0.f;
#pragma unroll
          for (int j = 0; j < 8; ++j) { const float send = odd ? v[j] : v[8 + j];
              const float recv = __builtin_bit_cast(float, __builtin_amdgcn_ds_bpermute((lane ^ 8) << 2, __builtin_bit_cast(int, send)));
              o[j] = odd ? (recv - lam * v[8 + j]) : (v[j] - lam * recv); ss += o[j] * o[j]; }
#pragma unroll
          for (int x = 1; x < 16; x <<= 1) ss += __builtin_bit_cast(float, __builtin_amdgcn_ds_bpermute((lane ^ x) << 2, __builtin_bit_cast(int, ss)));
          const float rn = sc / sqrtf(ss * (1.f / 128.f) + EPS);
          v4u wo; wo.x = pk2(o[0] * rn * ga[0], o[1] * rn * ga[1]); wo.y = pk2(o[2] * rn * ga[2], o[3] * rn * ga[3]); wo.z = pk2(o[4] * rn * gb[0], o[5] * rn * gb[1]); wo.w = pk2(o[6] * rn * gb[2], o[7] * rn * gb[3]);
          *(GAS v4u*)(Y + (size_t)m * YW + 768 + hh * 128 + eo) = wo; } } }
    for (int idx = c.vcu * NWAVES + c.wave; idx < MS * 4; idx += c.G * NWAVES) { const int ms = idx >> 2, h = idx & 3;
        sattn::post_sample_wave((const float*)(ws + WS_PART), Y + (size_t)(SEQ + ms) * YW + 768 + h * 128, ms / DECS, ms % DECS, h, lam, sc, sg, c.lane); }
}

template <class Epi> __device__ __forceinline__ void gemm_call(LAS unsigned char* lds, int wv, int Mrows, const bf16_t* A, const bf16_t* Bt, int N, int K, int lda, int ldb, const Epi& E) {
    int bx = blockIdx.x; LAUNDER_S(bx); int G = gridDim.x; LAUNDER_S(G);
    pg8::Gemm g{A, Bt, Mrows, N, K, lda, ldb}; pg8::StaticOrder S; S.init(Mrows, N, G, bx);
    pg8::gemm_phase<Epi, pg8::StaticOrder>(lds + RING_OFF, g, S, E, tid_now(wv));
}
template <int MODE> __device__ __forceinline__ void tail_call(LAS unsigned char* lds, int wv, const tailg::Tail<MODE>& t) {
    int bx = blockIdx.x; LAUNDER_S(bx); int G = gridDim.x; LAUNDER_S(G); int tid = tid_now(wv); LAUNDER_V(tid);
    tailg::run<MODE>(lds + RING_OFF, tid, bx, G, t);
}

__global__ void __launch_bounds__(NWAVES * 64, 2) enc_fwd(Args args) {
    extern __shared__ __attribute__((aligned(16))) unsigned char lds_raw[];
    LAS unsigned char* lds = (LAS unsigned char*)lds_raw;
    unsigned char* const ws = args.ws;
    float* const X = args.out;
    int wv;
    {
        const int tid = threadIdx.x;
        wv = __builtin_amdgcn_readfirstlane(tid >> 6);
        for (int u = tid; u < (LDS_BYTES - LDSCTL_OFF) / 4; u += NWAVES * 64) ((LAS unsigned*)(lds + LDSCTL_OFF))[u] = 0u;
        __syncthreads();
        if (tid < 36) ((LAS unsigned long long*)(lds + LDSCTL_OFF))[tid] = (unsigned long long)args.in[tid];
        LAS float* LAMF = (LAS float*)(lds + MISC_OFF + 64);
        if (tid >= 64 && tid < 64 * (1 + DEPTH)) { const int l = (tid >> 6) - 1, i = tid & 63;
            float d1 = args.in[22][l * 64 + i] * args.in[23][l * 64 + i], d2 = args.in[24][l * 64 + i] * args.in[25][l * 64 + i];
#pragma unroll
            for (int o = 1; o < 64; o <<= 1) { d1 += __builtin_bit_cast(float, __builtin_amdgcn_ds_bpermute((i ^ o) << 2, __builtin_bit_cast(int, d1))); d2 += __builtin_bit_cast(float, __builtin_amdgcn_ds_bpermute((i ^ o) << 2, __builtin_bit_cast(int, d2))); }
            if (i == 0) { LAMF[l] = expf(d1) - expf(d2) + args.lam_init[l]; LAMF[4 + l] = 1.0f - args.lam_init[l]; } }
        __syncthreads();
    }
    XcdBarrier bar = xcd_barrier_post((unsigned*)(ws + WS_CTL) + CW_BAR, (volatile LAS unsigned*)(lds + MISC_OFF) + 8, wv);
#define GRID_BAR() xcd_barrier(bar, wv)
    asm volatile("; MARK P0");
    prologue_phase(lds, wv, ws, X, args);
    GRID_BAR();

    for (int l = 0; l < DEPTH; ++l) {
#define WSP(T, off) ((T*)(lp(ws) + (off)))
#define WLP(off) ((const bf16_t*)(lp(ws) + WS_W + (size_t)l * LW_BYTES + (off)))
        asm volatile("; MARK FFN1");
        gemm_call(lds, wv, M, WSP(bf16_t, WS_XN), WLP(LW_GU1), NGU, D, D, D, pg8::EpiSwiGLU{WSP(bf16_t, WS_ACT), pg8::RowScale{WSP(float, WS_SS4), WSP(float, WS_SSP), SEQ}, FF, 0});
        weight_slice(lds, wv, lp(ws), l + 1, 0, WS1, NU_GU % 256); GRID_BAR();
        gemm_call(lds, wv, SEQ, WSP(bf16_t, WS_ACT), WLP(LW_D1), D, FF, FF, FF, pg8::EpiResid{WSP(bf16_t, WS_XN), WSP(float, WS_SS4), (l == DEPTH - 1 && false) ? lp(X) : nullptr, (LAS float*)(lds + LDSCTL_OFF + 1024), D, 0.5f});
        tail_call<0>(lds, wv, tailg::Tail<0>{WSP(bf16_t, WS_ACT), WLP(LW_D1), nullptr, WSP(bf16_t, WS_XN), WSP(float, WS_SSP), nullptr, nullptr, FF, FF, FF, 0, 0.5f, 0}); GRID_BAR();
        asm volatile("; MARK NORM2");
        gemm_call(lds, wv, M, WSP(bf16_t, WS_XN), WLP(LW_IN), ZW, D, D, D, pg8::EpiZ{WSP(bf16_t, WS_Z), WSP(bf16_t, WS_FAC), pg8::RowScale{WSP(float, WS_SS4), WSP(float, WS_SSP), SEQ}, ZW, 12, SEQ / 256, 0});
        weight_slice(lds, wv, lp(ws), l + 1, WS1, WS2, NU_IN % 256); GRID_BAR();
        asm volatile("; MARK MIX");
        mix_phase(lds, wv, lp(ws), lp(X), l); GRID_BAR();
        asm volatile("; MARK ATTN");
        attn_phase(lds_raw, lds, wv, lp(ws), lp(X), l); GRID_BAR();
        asm volatile("; MARK POST");
        post_phase(lds, wv, lp(ws), l); GRID_BAR();
        asm volatile("; MARK MERGE");
        gemm_call(lds, wv, SEQ, WSP(bf16_t, WS_Y), WLP(LW_P), D, YW, YW, YW, pg8::EpiMerged{WSP(bf16_t, WS_MRG), WSP(bf16_t, WS_FAC), D, ZW});
        tail_call<1>(lds, wv, tailg::Tail<1>{WSP(bf16_t, WS_Y), WLP(LW_P), nullptr, nullptr, nullptr, WSP(bf16_t, WS_MRG), WSP(bf16_t, WS_Z) + 3072, YW, YW, YW, ZW, 0.f, 0}); GRID_BAR();
        gemm_call(lds, wv, SEQ, WSP(bf16_t, WS_MRG), WLP(LW_O), D, D, D, D, pg8::EpiResid{WSP(bf16_t, WS_XN), WSP(float, WS_SS4), nullptr, (LAS float*)(lds + LDSCTL_OFF + 1024), D, 1.0f});
        tail_call<0>(lds, wv, tailg::Tail<0>{WSP(bf16_t, WS_MRG), WLP(LW_O), nullptr, WSP(bf16_t, WS_XN), WSP(float, WS_SSP), nullptr, nullptr, D, D, D, 0, 1.0f, 0}); GRID_BAR();
        asm volatile("; MARK FFN2");
        gemm_call(lds, wv, M, WSP(bf16_t, WS_XN), WLP(LW_GU2), NGU, D, D, D, pg8::EpiSwiGLU{WSP(bf16_t, WS_ACT), pg8::RowScale{WSP(float, WS_SS4), WSP(float, WS_SSP), SEQ}, FF, 0});
        weight_slice(lds, wv, lp(ws), l + 1, WS2, I_LAYER, NU_GU % 256); GRID_BAR();
        gemm_call(lds, wv, SEQ, WSP(bf16_t, WS_ACT), WLP(LW_D2), D, FF, FF, FF, pg8::EpiResid{WSP(bf16_t, WS_XN), WSP(float, WS_SS4), (l == DEPTH - 1 && true) ? lp(X) : nullptr, (LAS float*)(lds + LDSCTL_OFF + 1024), D, 0.5f});
        tail_call<0>(lds, wv, tailg::Tail<0>{WSP(bf16_t, WS_ACT), WLP(LW_D2), (l == DEPTH - 1) ? lp(X) : nullptr, WSP(bf16_t, WS_XN), WSP(float, WS_SSP), nullptr, nullptr, FF, FF, FF, 0, 0.5f, 0}); GRID_BAR();
#undef WSP
#undef WLP
    }
#undef GRID_BAR
}

extern "C" void kernel_launch(void* const* d_in, const int* in_sizes, int n_in, void* d_out, int out_size, void* d_ws, size_t ws_size, hipStream_t stream) {
    static int grid = 0;
    if (grid == 0) {
        if (n_in != 36 || in_sizes[0] != SEQ * D || (size_t)out_size != O_END || ws_size < WS_END) { fprintf(stderr, "kernel_launch: unexpected shapes (n_in %d, in0 %d, out %d, ws %zu need %zu)\n", n_in, n_in > 0 ? in_sizes[0] : -1, out_size, ws_size, (size_t)WS_END); grid = -1; return; }
        int dev = 0, cus = 0, per_cu = 0;
        if (hipGetDevice(&dev) != hipSuccess || hipDeviceGetAttribute(&cus, hipDeviceAttributeMultiprocessorCount, dev) != hipSuccess) { grid = -1; return; }
        if (hipFuncSetAttribute((const void*)enc_fwd, hipFuncAttributeMaxDynamicSharedMemorySize, LDS_BYTES) != hipSuccess) { fprintf(stderr, "kernel_launch: hipFuncSetAttribute failed\n"); grid = -1; return; }
        if (hipOccupancyMaxActiveBlocksPerMultiprocessor(&per_cu, (const void*)enc_fwd, NWAVES * 64, LDS_BYTES) != hipSuccess || per_cu < 1) fprintf(stderr, "kernel_launch: occupancy query reports %d\n", per_cu);
        (void)hipGetLastError();
        grid = cus;
    }
    if (grid < 0) return;
    if (hipMemsetAsync((char*)d_ws + WS_CTL, 0, CTL_ZERO_BYTES, stream) != hipSuccess) return;
    Args a; memset(&a, 0, sizeof(a));
    for (int i = 0; i < 36; ++i) a.in[i] = (const float*)d_in[i];
    a.out = (float*)d_out; a.ws = (unsigned char*)d_ws;
    for (int i = 0; i < 32; ++i) a.inv_freq[i] = (float)pow(10000.0, -(double)i / 32.0);
    for (int l = 0; l < 4; ++l) a.lam_init[l] = (float)(0.8 - 0.6 * exp(-0.3 * l));
    hipLaunchKernelGGL(enc_fwd, dim3(grid), dim3(NWAVES * 64), LDS_BYTES, stream, a);
    const hipError_t le = hipPeekAtLastError();
    if (le != hipSuccess) fprintf(stderr, "kernel_launch: launch failed: %s\n", hipGetErrorName(le));
}
#endif
```

```cpp
#ifndef CPU_TEST
#include <hip/hip_runtime.h>
#include <hip/hip_bf16.h>
#endif
#include <cstdio>
#include <cstdint>
#include <cmath>
#include <cstring>

#ifndef CFG_SEQ
#define CFG_SEQ 16384
#endif
#ifndef CFG_DEPTH
#define CFG_DEPTH 4
#endif
#ifndef CFG_DECB
#define CFG_DECB 32
#endif
#ifndef CFG_PAST
#define CFG_PAST 2048
#endif
constexpr int D = 1024, SEQ = CFG_SEQ, DEPTH = CFG_DEPTH, DECB = CFG_DECB, DECS = 16, PAST = CFG_PAST;
constexpr int MS = DECB * DECS, M = SEQ + MS;
constexpr int FF = 2816, NGU = 2 * FF, ZW = 7168, YW = 1280;
constexpr int KSROWS = PAST + 128;
constexpr int QSROWS = 256;
constexpr int ROPE_ROWS = (SEQ > PAST + DECS) ? SEQ : (PAST + DECS);
constexpr float EPS = 1e-6f;
constexpr float C2 = 0.125f * 1.4426950408889634f;

constexpr size_t O_YP = 0, O_YS = O_YP + (size_t)SEQ * D, O_KP = O_YS + (size_t)MS * D, O_VP = O_KP + (size_t)DEPTH * SEQ * 512,
                 O_POOLP = O_VP + (size_t)DEPTH * SEQ * 512, O_SCP = O_POOLP + (size_t)DEPTH * 15 * 256, O_CCP = O_SCP + (size_t)DEPTH * 2 * 256,
                 O_KS = O_CCP + (size_t)DEPTH * 30 * 256, O_VS = O_KS + (size_t)DEPTH * MS * 512, O_POOLS = O_VS + (size_t)DEPTH * MS * 512,
                 O_SCS = O_POOLS + (size_t)DEPTH * DECB * 15 * 256, O_CCS = O_SCS + (size_t)DEPTH * DECB * 2 * 256, O_END = O_CCS + (size_t)DEPTH * DECB * 30 * 256;

typedef unsigned short bf16_t;
#ifdef CPU_TEST
#define HD inline
#define LDSF float*
#else
#define HD __device__ __forceinline__
#define LAS __attribute__((address_space(3)))
#define LDSF LAS float*
#endif
#ifdef CPU_TEST
#define CBAR()
#else
#define CBAR() asm volatile("" ::: "memory")
#endif
HD unsigned f2bf(float f) { unsigned u = __builtin_bit_cast(unsigned, f); return (u + 0x7fffu + ((u >> 16) & 1u)) >> 16; }
HD float bf2f(bf16_t b) { return __builtin_bit_cast(float, (unsigned)b << 16); }
HD float sigmoid_f(float x) { return 1.0f / (1.0f + expf(-x)); }

HD void ld_bf16x8(const bf16_t* p, float* o) {
#ifdef CPU_TEST
    for (int i = 0; i < 8; ++i) o[i] = bf2f(p[i]);
#else
    typedef unsigned u4 __attribute__((ext_vector_type(4)));
    const u4 w = *(const u4*)p;
    o[0] = __builtin_bit_cast(float, w.x << 16); o[1] = __builtin_bit_cast(float, w.x & 0xffff0000u);
    o[2] = __builtin_bit_cast(float, w.y << 16); o[3] = __builtin_bit_cast(float, w.y & 0xffff0000u);
    o[4] = __builtin_bit_cast(float, w.z << 16); o[5] = __builtin_bit_cast(float, w.z & 0xffff0000u);
    o[6] = __builtin_bit_cast(float, w.w << 16); o[7] = __builtin_bit_cast(float, w.w & 0xffff0000u);
#endif
}
HD void st_bf16x8(bf16_t* p, const float* v) {
#ifdef CPU_TEST
    for (int i = 0; i < 8; ++i) p[i] = (bf16_t)f2bf(v[i]);
#else
    typedef unsigned u4 __attribute__((ext_vector_type(4)));
    u4 w; w.x = f2bf(v[0]) | (f2bf(v[1]) << 16); w.y = f2bf(v[2]) | (f2bf(v[3]) << 16); w.z = f2bf(v[4]) | (f2bf(v[5]) << 16); w.w = f2bf(v[6]) | (f2bf(v[7]) << 16);
    *(u4*)p = w;
#endif
}

struct MixP {
    const bf16_t* Z; bf16_t* Y;
    bf16_t *Qp, *Kp, *Vp;
    bf16_t *QS, *KS, *VS;
    float* out;
    const float *st_pool, *st_sconv, *st_cconv;
    const float *pool_w, *pool_scale, *sconv_w, *cconv_w, *cconv_b, *ln_g, *ln_b, *qg, *kg;
    const float* rope;
    int layer;
};
struct MixItem { int sample, b, t0, nrows; };
constexpr int MIX_PROWS = 32, N_MIX_PROMPT = SEQ / MIX_PROWS, N_MIX_ITEMS = N_MIX_PROMPT + DECB;
HD MixItem mix_item(int it) { MixItem I; if (it < N_MIX_PROMPT) { I.sample = 0; I.b = 0; I.t0 = it * MIX_PROWS; I.nrows = MIX_PROWS; } else { I.sample = 1; I.b = it - N_MIX_PROMPT; I.t0 = 0; I.nrows = DECS; } return I; }

HD void mix_c_fill(const MixP& P, const MixItem& I, int tid, LDSF T) {
    const int ch = tid & 255, half = tid >> 8, l = P.layer, b = I.b; const size_t mb = I.sample ? (size_t)SEQ + (size_t)DECS * b : 0;
    for (int i = half; i < I.nrows + 30; i += 2) { const int t = I.t0 - 30 + i; float v;
        if (t >= 0) { const bf16_t* zr = P.Z + (mb + t) * ZW; v = bf2f(zr[1024 + ch]) * sigmoid_f(bf2f(zr[1280 + ch])); }
        else v = I.sample ? P.st_cconv[((size_t)b * 30 + (30 + t)) * 256 + ch] : 0.f;
        T[i * 256 + ch] = v;
        if (!I.sample) { if (t >= I.t0 && t >= SEQ - 30) P.out[O_CCP + ((size_t)l * 30 + (t - (SEQ - 30))) * 256 + ch] = v; }
        else { if (t + 14 >= 0) P.out[O_CCS + (((size_t)l * DECB + b) * 30 + (t + 14)) * 256 + ch] = v; } }
}
HD void mix_c_conv(const MixP& P, const MixItem& I, int tid, LDSF T, LDSF cv) {
    const int ch = tid & 255, half = tid >> 8;
    float w[31];
#pragma unroll
    for (int j = 0; j < 31; ++j) w[j] = P.cconv_w[j * 256 + ch];
    for (int r = half; r < I.nrows; r += 2) { float a = 0.f;
#pragma unroll
        for (int j = 0; j < 31; ++j) a += w[j] * T[(r + j) * 256 + ch];
        cv[r * 256 + ch] = a; }
}
HD void mix_b_fill(const MixP& P, const MixItem& I, int tid, LDSF T) {
    const int ch = tid & 255, half = tid >> 8, l = P.layer, b = I.b; const size_t mb = I.sample ? (size_t)SEQ + (size_t)DECS * b : 0;
    for (int i = half; i < I.nrows + 2; i += 2) { const int t = I.t0 - 2 + i; float v;
        if (t >= 0) { const bf16_t* zr = P.Z + (mb + t) * ZW; v = bf2f(zr[512 + ch]) * bf2f(zr[768 + ch]); }
        else v = I.sample ? P.st_sconv[((size_t)b * 2 + (2 + t)) * 256 + ch] : 0.f;
        T[i * 256 + ch] = v;
        if (!I.sample) { if (t >= I.t0 && t >= SEQ - 2) P.out[O_SCP + ((size_t)l * 2 + (t - (SEQ - 2))) * 256 + ch] = v; }
        else { if (t >= DECS - 2) P.out[O_SCS + (((size_t)l * DECB + b) * 2 + (t - (DECS - 2))) * 256 + ch] = v; } }
}
HD void mix_b_conv(const MixP& P, const MixItem& I, int tid, LDSF T) {
    const int ch = tid & 255, half = tid >> 8; const size_t mb = I.sample ? (size_t)SEQ + (size_t)DECS * I.b : 0;
    const float w0 = P.sconv_w[ch], w1 = P.sconv_w[256 + ch], w2 = P.sconv_w[512 + ch];
    for (int r = half; r < I.nrows; r += 2) { const int t = I.t0 + r; const float y = w0 * T[r * 256 + ch] + w1 * T[(r + 1) * 256 + ch] + w2 * T[(r + 2) * 256 + ch];
        const float zb = bf2f(P.Z[(mb + t) * ZW + 256 + ch]);
        P.Y[(mb + t) * YW + 256 + ch] = (bf16_t)f2bf(zb * y); }
}
HD void mix_a_fill(const MixP& P, const MixItem& I, int tid, LDSF T) {
    const int ch = tid & 255, half = tid >> 8, l = P.layer, b = I.b; const size_t mb = I.sample ? (size_t)SEQ + (size_t)DECS * b : 0;
    for (int i = half; i < I.nrows + 15; i += 2) { const int t = I.t0 - 15 + i;
        const float v = (t >= 0) ? bf2f(P.Z[(mb + t) * ZW + ch]) : (I.sample ? P.st_pool[((size_t)b * 15 + (15 + t)) * 256 + ch] : 0.f);
        T[i * 256 + ch] = v;
        if (!I.sample) { if (t >= I.t0 && t >= SEQ - 15) P.out[O_POOLP + ((size_t)l * 15 + (t - (SEQ - 15))) * 256 + ch] = v; }
        else { if (t >= 1) P.out[O_POOLS + (((size_t)l * DECB + b) * 15 + (t - 1)) * 256 + ch] = v; } }
}
HD void mix_a_pool(const MixP& P, const MixItem& I, int tid, LDSF T, LDSF dA) {
    const int ch = tid & 255, half = tid >> 8; const int win = 2 << (ch >> 6);
    for (int r = half; r < I.nrows; r += 2) { const int t = I.t0 + r; float s = 0.f;
        for (int j = 0; j < win; ++j) s += T[(15 + r - j) * 256 + ch];
        const int pos = I.sample ? PAST + t : t; const int cnt = (pos + 1 < win) ? pos + 1 : win;
        dA[r * 256 + ch] = s / (float)cnt - T[(15 + r) * 256 + ch]; }
}
HD void mix_s2(const MixP& P, const MixItem& I, int tid, LDSF cv, LDSF dA, LDSF st) {
    const int ch = tid & 255, half = tid >> 8, g = ch >> 6, dd = ch & 63;
    const size_t mb = I.sample ? (size_t)SEQ + (size_t)DECS * I.b : 0;
    float acc[16];
#pragma unroll
    for (int k = 0; k < 16; ++k) acc[k] = 0.f;
    for (int c = 0; c < 64; ++c) { const float w = P.pool_w[(g * 64 + c) * 64 + dd];
#pragma unroll
        for (int k = 0; k < 16; ++k) acc[k] += dA[(half + 2 * k) * 256 + g * 64 + c] * w; }
    const float sc = P.pool_scale[ch];
#pragma unroll
    for (int k = 0; k < 16; ++k) { const int r = half + 2 * k; if (r < I.nrows) P.Y[(mb + I.t0 + r) * YW + ch] = (bf16_t)f2bf(acc[k] * sc); }
    if (tid < I.nrows) { float s = 0.f;
        for (int c = 0; c < 256; ++c) s += cv[tid * 256 + c] + P.cconv_b[c];
        const float mean = s * (1.f / 256.f); float q = 0.f;
        for (int c = 0; c < 256; ++c) { const float d = cv[tid * 256 + c] + P.cconv_b[c] - mean; q += d * d; }
        st[2 * tid] = mean; st[2 * tid + 1] = 1.0f / sqrtf(q * (1.f / 256.f) + EPS); }
}
HD void mix_s3(const MixP& P, const MixItem& I, int tid, LDSF cv, LDSF st) {
    const int ch = tid & 255, half = tid >> 8;
    const size_t mb = I.sample ? (size_t)SEQ + (size_t)DECS * I.b : 0;
    const float bi = P.cconv_b[ch], lg = P.ln_g[ch], lb = P.ln_b[ch];
    for (int r = half; r < I.nrows; r += 2) { const float v = (cv[r * 256 + ch] + bi - st[2 * r]) * st[2 * r + 1] * lg + lb;
        P.Y[(mb + I.t0 + r) * YW + 512 + ch] = (bf16_t)f2bf(v * sigmoid_f(v)); }
}
HD void mix_s4(const MixP& P, const MixItem& I, int tid) {
    const int kind = tid >> 8, rr = (tid >> 3) & 31, map = tid & 7, l = P.layer, b = I.b;
    const size_t mb = I.sample ? (size_t)SEQ + (size_t)DECS * b : 0;
    if (rr < I.nrows) {
        const int t = I.t0 + rr; const bf16_t* src = P.Z + (mb + t) * ZW + 1536 + kind * 512 + map * 64;
        float v[64];
#pragma unroll
        for (int i = 0; i < 8; ++i) ld_bf16x8(src + 8 * i, v + 8 * i);
        float ss = 0.f;
#pragma unroll
        for (int i = 0; i < 64; ++i) ss += v[i] * v[i];
        const float rn = 1.0f / sqrtf(ss * (1.f / 64.f) + EPS);
        const float* gp = kind ? P.kg : P.qg;
        const int pos = I.sample ? PAST + t : t; const float* rp = P.rope + (size_t)pos * 64;
        float o[64];
#pragma unroll
        for (int i = 0; i < 32; ++i) { const float a = v[i] * rn * gp[i], c = v[i + 32] * rn * gp[i + 32], co = rp[i], si = rp[32 + i];
            o[i] = a * co - c * si; o[i + 32] = c * co + a * si; }
        if (kind == 0) {
            bf16_t* dst = I.sample ? P.QS + ((size_t)b * QSROWS + t) * 512 + map * 64 : P.Qp + (size_t)t * 512 + map * 64;
#pragma unroll
            for (int i = 0; i < 64; ++i) o[i] *= C2;
#pragma unroll
            for (int i = 0; i < 8; ++i) st_bf16x8(dst + 8 * i, o + 8 * i);
        } else {
            bf16_t* dst = I.sample ? P.KS + ((size_t)b * KSROWS + PAST + t) * 512 + map * 64 : P.Kp + (size_t)t * 512 + map * 64;
#pragma unroll
            for (int i = 0; i < 8; ++i) st_bf16x8(dst + 8 * i, o + 8 * i);
            float* od = I.sample ? P.out + O_KS + (((size_t)l * DECB + b) * DECS + t) * 512 + map * 64 : P.out + O_KP + ((size_t)l * SEQ + t) * 512 + map * 64;
#pragma unroll
            for (int i = 0; i < 64; ++i) od[i] = o[i];
        }
    }
    for (int idx = tid; idx < I.nrows * 512; idx += 512) { const int r2 = idx >> 9, c = idx & 511, t = I.t0 + r2;
        const bf16_t val = P.Z[(mb + t) * ZW + 2560 + c];
        if (I.sample) { P.VS[((size_t)b * KSROWS + PAST + t) * 512 + c] = val; P.out[O_VS + (((size_t)l * DECB + b) * DECS + t) * 512 + c] = bf2f(val); }
        else { P.Vp[(size_t)t * 512 + c] = val; P.out[O_VP + ((size_t)l * SEQ + t) * 512 + c] = bf2f(val); } }
}
HD void post_thread(const bf16_t* Orow  , bf16_t* Ydst  , int h, float lam, float scale, const float* subln_g) {
    const bf16_t* a = Orow + (2 * h) * 128; const bf16_t* c = a + 128; float ss = 0.f;
    for (int i = 0; i < 16; ++i) { float x[8], y[8]; ld_bf16x8(a + 8 * i, x); ld_bf16x8(c + 8 * i, y);
#pragma unroll
        for (int j = 0; j < 8; ++j) { const float o = x[j] - lam * y[j]; ss += o * o; } }
    const float rn = scale / sqrtf(ss * (1.f / 128.f) + EPS);
    for (int i = 0; i < 16; ++i) { float x[8], y[8], o[8]; ld_bf16x8(a + 8 * i, x); ld_bf16x8(c + 8 * i, y);
#pragma unroll
        for (int j = 0; j < 8; ++j) o[j] = (x[j] - lam * y[j]) * rn * subln_g[8 * i + j];
        st_bf16x8(Ydst + h * 128 + 8 * i, o); }
}
#ifndef CPU_TEST
namespace pg8 {
#define PG8_LAS __attribute__((address_space(3)))
#define PG8_GAS __attribute__((address_space(1)))
typedef short bf16x8 __attribute__((ext_vector_type(8)));
typedef float f32x4 __attribute__((ext_vector_type(4)));
typedef float f32x2 __attribute__((ext_vector_type(2)));
typedef unsigned u32x4 __attribute__((ext_vector_type(4)));
typedef unsigned u32x2 __attribute__((ext_vector_type(2)));
constexpr int BM = 256, BK = 64, HALF = 128, HTB = HALF * BK * 2  , STAGE_BYTES = 8 * HTB, NXCD = 8, WGM = 8;

__host__ __device__ __forceinline__ int lds_byte(int r, int c) { const int st = (r >> 4) * 2 + (c >> 5), rr = r & 15, cc = c & 31, ob = rr * 64 + cc * 2; return st * 1024 + (ob ^ (((ob >> 9) & 1) << 5)); }
__host__ __device__ __forceinline__ void stage_rc(int b, int& R, int& C) { const int st = b / 1024, sb = b % 1024, swz = sb ^ (((sb >> 9) & 1) << 5); R = (st >> 1) * 16 + swz / 64; C = (st & 1) * 32 + (swz % 64) / 2; }
__host__ __device__ __forceinline__ int perm32(int rho) { const int n = rho >> 4, i = rho & 15; return 8 * (i >> 2) + 4 * n + (i & 3); }

struct Unit { int pm, pn; };
struct Gemm { const bf16_t* A; const bf16_t* Bt; int M, N, K, lda, ldb; };

struct StaticOrder {
    int nM, nN, nwg, G, c;
    __host__ __device__ void init(int M_, int N_, int G_, int c_) { nM = M_ / BM; nN = N_ / BM; nwg = nM * nN; G = G_; c = c_; }
    __host__ __device__ bool next(int i, Unit& u) const {
        const long L = (long)i * G + c; if (L >= nwg) return false;
        int wgid = (int)L; { const int q = nwg / NXCD, r = nwg % NXCD, xcd = wgid % NXCD, off = wgid / NXCD; wgid = (xcd < r ? xcd * (q + 1) : r * (q + 1) + (xcd - r) * q) + off; }
        const int nig = WGM * nN, gid = wgid / nig, fm = gid * WGM, gsz = (nM - fm) < WGM ? (nM - fm) : WGM;
        u.pm = fm + ((wgid % nig) % gsz); u.pn = (wgid % nig) / gsz; return true;
    }
    __device__ __forceinline__ void a_ready(const Unit&) const {}
    __device__ __forceinline__ void done(const Unit&) const {}
};

typedef __bf16 bf16x2_v __attribute__((ext_vector_type(2)));
__device__ __forceinline__ unsigned cvt_pk_bf16(float lo, float hi) { f32x2 v = {lo, hi}; const bf16x2_v b = __builtin_convertvector(v, bf16x2_v); return __builtin_bit_cast(unsigned, b); }
__device__ __forceinline__ float fast_sigmoid(float x) { return __builtin_amdgcn_rcpf(1.0f + __expf(-x)); }

struct RowScale { const float* SS4; const float* SS16; int nfast; };
__device__ __forceinline__ void row_rscales(const RowScale& R, int row0, float (&rs)[2][4]) {
    if (row0 < R.nfast) { f32x4 q[2][4];
#pragma unroll
        for (int ai = 0; ai < 2; ++ai)
#pragma unroll
            for (int m = 0; m < 4; ++m) q[ai][m] = *(const PG8_GAS f32x4*)(R.SS4 + (size_t)(row0 + ai * HALF + m * 16) * 4);
#pragma unroll
        for (int ai = 0; ai < 2; ++ai)
#pragma unroll
            for (int m = 0; m < 4; ++m) rs[ai][m] = 1.0f / sqrtf(((q[ai][m][0] + q[ai][m][1]) + (q[ai][m][2] + q[ai][m][3])) * (1.0f / 1024.0f) + 1e-6f);
    } else {
#pragma unroll
        for (int ai = 0; ai < 2; ++ai)
#pragma unroll
            for (int m = 0; m < 4; ++m) { const PG8_GAS f32x4* p = (const PG8_GAS f32x4*)(R.SS16 + (size_t)(row0 + ai * HALF + m * 16 - R.nfast) * 16); const f32x4 a = p[0], b = p[1], c = p[2], d = p[3];
                const float ss = ((a[0] + a[1]) + (a[2] + a[3])) + ((b[0] + b[1]) + (b[2] + b[3])) + ((c[0] + c[1]) + (c[2] + c[3])) + ((d[0] + d[1]) + (d[2] + d[3]));
                rs[ai][m] = 1.0f / sqrtf(ss * (1.0f / 1024.0f) + 1e-6f); }
    }
}
struct EpiSwiGLU {
    static constexpr bool PERM = true, AFTER_DRAIN = false, MID = false, ROWSCALE = true;
    bf16_t* O; RowScale R; int ldc, pad;
    __device__ __forceinline__ void operator()(const f32x4 (&acc)[2][2][4][2], const Unit& u, int wr, int wc, int fr, int fq, const float (&rsv)[2][4]) const {
        const int row0 = u.pm * BM + wr * 64 + fr, col0 = u.pn * HALF + wc * 32 + 8 * fq;
#pragma unroll
        for (int ai = 0; ai < 2; ++ai)
#pragma unroll
            for (int m = 0; m < 4; ++m) { bf16_t* rowp = O + (size_t)(row0 + ai * HALF + m * 16) * ldc + col0; const float rs = rsv[ai][m];
                float v[8];
#pragma unroll
                for (int n = 0; n < 2; ++n)
#pragma unroll
                    for (int i = 0; i < 4; ++i) { const float g = acc[ai][0][m][n][i] * rs, up = acc[ai][1][m][n][i] * rs; v[4 * n + i] = g * fast_sigmoid(g) * up; }
                u32x4 w; w.x = cvt_pk_bf16(v[0], v[1]); w.y = cvt_pk_bf16(v[2], v[3]); w.z = cvt_pk_bf16(v[4], v[5]); w.w = cvt_pk_bf16(v[6], v[7]);
                *(PG8_GAS u32x4*)rowp = w; }
    }
};
struct EpiZ {
    static constexpr bool PERM = true, AFTER_DRAIN = false, MID = false, ROWSCALE = true;
    bf16_t* O; bf16_t* FAC; RowScale R; int ldc, sig_from, nfp, pad;
    __device__ __forceinline__ void operator()(const f32x4 (&acc)[2][2][4][2], const Unit& u, int wr, int wc, int fr, int fq, const float (&rsv)[2][4]) const {
        const int row0 = u.pm * BM + wr * 64 + fr;
        if (u.pn < sig_from) { const int col0 = u.pn * BM + wc * 32 + 8 * fq;
#pragma unroll
            for (int ai = 0; ai < 2; ++ai)
#pragma unroll
                for (int m = 0; m < 4; ++m) { bf16_t* rowp = O + (size_t)(row0 + ai * HALF + m * 16) * ldc + col0; const float rs = rsv[ai][m];
#pragma unroll
                    for (int bj = 0; bj < 2; ++bj) { const f32x4 v0 = acc[ai][bj][m][0] * rs, v1 = acc[ai][bj][m][1] * rs;
                        u32x4 w; w.x = cvt_pk_bf16(v0[0], v0[1]); w.y = cvt_pk_bf16(v0[2], v0[3]); w.z = cvt_pk_bf16(v1[0], v1[1]); w.w = cvt_pk_bf16(v1[2], v1[3]);
                        *(PG8_GAS u32x4*)(rowp + bj * HALF) = w; } }
        } else { const int j = u.pn - sig_from, oc = j * 64 + wc * 16 + 4 * fq; const int g0c = sig_from * BM;
            const bool blk = u.pm < nfp;
            bf16_t* const fb = FAC + ((size_t)(u.pm * 4 + (j >> 2)) << 18) + (size_t)((wr * 4 + ((j & 1) << 1) + (wc >> 1)) * 8192 + ((j >> 1) & 1) * 512 + (fq * 16 + fr) * 8 + (wc & 1) * 4);
#pragma unroll
            for (int ai = 0; ai < 2; ++ai)
#pragma unroll
                for (int m = 0; m < 4; ++m) { bf16_t* rowp = blk ? fb + (ai * 4 + m) * 1024 : O + (size_t)(row0 + ai * HALF + m * 16) * ldc + g0c + oc; const int qs = blk ? 65536 : 1024; const float rs = rsv[ai][m];
                    f32x4 e[4];
#pragma unroll
                    for (int b = 0; b < 4; ++b)
#pragma unroll
                        for (int i = 0; i < 4; ++i) e[b][i] = 1.0f + __expf(-acc[ai][b >> 1][m][b & 1][i] * rs);
#pragma unroll
                    for (int q = 0; q < 4; ++q) { f32x4 v;
#pragma unroll
                        for (int i = 0; i < 4; ++i) { const float rq = __builtin_amdgcn_rcpf(e[q][i]); v[i] = (q < 3 && blk) ? e[q + 1 > 3 ? 3 : q + 1][i] * rq : rq; }
                        u32x2 w; w.x = cvt_pk_bf16(v[0], v[1]); w.y = cvt_pk_bf16(v[2], v[3]); *(PG8_GAS u32x2*)(rowp + q * qs) = w; } }
        }
    }
};
struct EpiMerged {
    static constexpr bool PERM = false, AFTER_DRAIN = false, MID = true, ROWSCALE = false;
    bf16_t* OUT; const bf16_t* F; int ldc, ldf;
    __device__ __forceinline__ void scale(f32x4 (&acc)[2][2][4][2], const Unit& u, int wr, int wc, int fr, int fq, int q) const {
        const bf16_t* fb = F + ((size_t)((u.pm * 4 + u.pn) * 4 + q) << 16) + (size_t)((wr * 4 + wc) * 8192 + (fq * 16 + fr) * 8);
        u32x4 gq[2][4][2];
#pragma unroll
        for (int ai = 0; ai < 2; ++ai)
#pragma unroll
            for (int m = 0; m < 4; ++m)
#pragma unroll
                for (int bj = 0; bj < 2; ++bj) gq[ai][m][bj] = *(const PG8_GAS u32x4*)(fb + ((ai * 4 + m) * 2 + bj) * 512);
#pragma unroll
        for (int ai = 0; ai < 2; ++ai)
#pragma unroll
            for (int m = 0; m < 4; ++m)
#pragma unroll
                for (int bj = 0; bj < 2; ++bj)
#pragma unroll
                    for (int n = 0; n < 2; ++n) { u32x2 w; w.x = n ? gq[ai][m][bj].z : gq[ai][m][bj].x; w.y = n ? gq[ai][m][bj].w : gq[ai][m][bj].y; f32x4 g; g[0] = __builtin_bit_cast(float, w.x << 16); g[1] = __builtin_bit_cast(float, w.x & 0xffff0000u); g[2] = __builtin_bit_cast(float, w.y << 16); g[3] = __builtin_bit_cast(float, w.y & 0xffff0000u);
                        acc[ai][bj][m][n] *= g; }
    }
    __device__ __forceinline__ void mid(f32x4 (&acc)[2][2][4][2], const Unit& u, int wr, int wc, int fr, int fq, int i) const { scale(acc, u, wr, wc, fr, fq, i); }
    __device__ __forceinline__ void operator()(f32x4 (&acc)[2][2][4][2], const Unit& u, int wr, int wc, int fr, int fq) const {
        scale(acc, u, wr, wc, fr, fq, 3);
        const int row0 = u.pm * BM + wr * 64 + fr, col0 = u.pn * BM + wc * 32 + 4 * fq;
#pragma unroll
        for (int ai = 0; ai < 2; ++ai)
#pragma unroll
            for (int m = 0; m < 4; ++m) { bf16_t* op = OUT + (size_t)(row0 + ai * HALF + m * 16) * ldc + col0;
#pragma unroll
                for (int bj = 0; bj < 2; ++bj)
#pragma unroll
                    for (int n = 0; n < 2; ++n) { const f32x4 v = acc[ai][bj][m][n]; u32x2 w; w.x = cvt_pk_bf16(v[0], v[1]); w.y = cvt_pk_bf16(v[2], v[3]); *(PG8_GAS u32x2*)(op + bj * HALF + n * 16) = w; } }
    }
};
struct EpiResid {
    static constexpr bool PERM = true, AFTER_DRAIN = false, MID = false, ROWSCALE = false;
    bf16_t* XB; float* SS4; float* Xout; PG8_LAS float* PS; int ldc; float s;
    __device__ __forceinline__ void operator()(const f32x4 (&acc)[2][2][4][2], const Unit& u, int wr, int wc, int fr, int fq) const {
        const int row0 = u.pm * BM + wr * 64 + fr, col0 = u.pn * BM + wc * 32 + 8 * fq; const int lane = fq * 16 + fr; const bool fin = Xout != nullptr;
#pragma unroll
        for (int ai = 0; ai < 2; ++ai)
#pragma unroll
            for (int m = 0; m < 4; ++m) { const size_t row = (size_t)(row0 + ai * HALF + m * 16); bf16_t* xb = XB + row * ldc + col0; float* xo = Xout + row * ldc + col0;
                u32x4 x[2];
#pragma unroll
                for (int bj = 0; bj < 2; ++bj) x[bj] = *(const PG8_GAS u32x4*)(xb + bj * HALF);
                float ss = 0.f;
#pragma unroll
                for (int bj = 0; bj < 2; ++bj) { f32x4 v0, v1;
                    v0[0] = __builtin_bit_cast(float, x[bj].x << 16); v0[1] = __builtin_bit_cast(float, x[bj].x & 0xffff0000u); v0[2] = __builtin_bit_cast(float, x[bj].y << 16); v0[3] = __builtin_bit_cast(float, x[bj].y & 0xffff0000u);
                    v1[0] = __builtin_bit_cast(float, x[bj].z << 16); v1[1] = __builtin_bit_cast(float, x[bj].z & 0xffff0000u); v1[2] = __builtin_bit_cast(float, x[bj].w << 16); v1[3] = __builtin_bit_cast(float, x[bj].w & 0xffff0000u);
                    v0 += acc[ai][bj][m][0] * s; v1 += acc[ai][bj][m][1] * s;
                    if (fin) { *(PG8_GAS f32x4*)(xo + bj * HALF) = v0; *(PG8_GAS f32x4*)(xo + bj * HALF + 4) = v1; }
                    else { u32x4 w; w.x = cvt_pk_bf16(v0[0], v0[1]); w.y = cvt_pk_bf16(v0[2], v0[3]); w.z = cvt_pk_bf16(v1[0], v1[1]); w.w = cvt_pk_bf16(v1[2], v1[3]); *(PG8_GAS u32x4*)(xb + bj * HALF) = w;
                        ss += ((v0[0] * v0[0] + v0[1] * v0[1]) + (v0[2] * v0[2] + v0[3] * v0[3])) + ((v1[0] * v1[0] + v1[1] * v1[1]) + (v1[2] * v1[2] + v1[3] * v1[3])); } }
                ss += __builtin_bit_cast(float, __builtin_amdgcn_ds_bpermute((lane ^ 16) << 2, __builtin_bit_cast(int, ss)));
                ss += __builtin_bit_cast(float, __builtin_amdgcn_ds_bpermute((lane ^ 32) << 2, __builtin_bit_cast(int, ss)));
                if (fq == 0) PS[(ai * HALF + wr * 64 + m * 16 + fr) * 4 + wc] = ss;
                if (m & 1) asm volatile("" ::: "memory"); }
        asm volatile("s_waitcnt lgkmcnt(0)" ::: "memory"); __builtin_amdgcn_s_barrier(); asm volatile("" ::: "memory");
        if (lane < 32 && !fin) { const int c8 = 2 * wc + (lane >> 4), rl = (c8 >> 2) * HALF + wr * 64 + (c8 & 3) * 16 + (lane & 15);
            const f32x4 q = *(const PG8_LAS f32x4*)(PS + rl * 4); ((PG8_GAS float*)SS4)[(size_t)(u.pm * BM + rl) * 4 + u.pn] = (q[0] + q[1]) + (q[2] + q[3]); }
    }
};
template <class Epi, class Sched, bool ALIGN_EPI = true>
__device__ __forceinline__ void gemm_phase(PG8_LAS unsigned char* lds_in, const Gemm g, const Sched& S, const Epi& E, int tid_in) {
    unsigned lb_ = (unsigned)(uintptr_t)lds_in; asm volatile("" : "+s"(lb_)); PG8_LAS unsigned char* lds = (PG8_LAS unsigned char*)(uintptr_t)lb_;
    int tid_ = tid_in; asm volatile("" : "+v"(tid_));
    const int tid = tid_, wid = __builtin_amdgcn_readfirstlane(tid >> 6), lane = tid & 63, wr = wid >> 2, wc = wid & 3, fr = lane & 15, fq = lane >> 4;
    const int K = g.K, nt = K / BK;
    unsigned voffA[2], voffB[2];
#pragma unroll
    for (int i = 0; i < 2; ++i) { int R, C; stage_rc(tid * 16 + i * 8192, R, C); const int Rb = Epi::PERM ? ((R & ~31) + perm32(R & 31)) : R;
        voffA[i] = (unsigned)(R * g.lda + C) * 2u; voffB[i] = (unsigned)(Rb * g.ldb + C) * 2u; }
    const size_t kstep = (size_t)(BK * 2);
    const size_t hA = (size_t)HALF * g.lda * 2, hB = (size_t)HALF * g.ldb * 2;
    const size_t tA = 2 * hA, tB = 2 * hB;
    const unsigned ldsw = (unsigned)wid * 1024u;
    const int aoff = lds_byte(wr * 64 + fr, fq * 8), boff = lds_byte(wc * 32 + fr, fq * 8);
#define PG8_SA(b, h) (((b) * 2 + (h)) * HTB)
#define PG8_SB(b, h) ((4 + (b) * 2 + (h)) * HTB)
#define PG8_STAGE(bufoff, gbase, voff) do { _Pragma("unroll") for (int _i = 0; _i < 2; ++_i) \
        __builtin_amdgcn_global_load_lds((const unsigned*)((const char*)(gbase) + (voff)[_i]), (PG8_LAS unsigned*)(lds + (bufoff) + ldsw + _i * 8192), 16, 0, 0); } while (0)
#define PG8_LDA(dst, b, h) do { _Pragma("unroll") for (int m = 0; m < 4; ++m) _Pragma("unroll") for (int k = 0; k < 2; ++k) dst[m][k] = *(const PG8_LAS bf16x8*)(lds + PG8_SA(b, h) + aoff + m * 2048 + k * 1024); } while (0)
#define PG8_LDB(dst, b, h) do { _Pragma("unroll") for (int n = 0; n < 2; ++n) _Pragma("unroll") for (int k = 0; k < 2; ++k) dst[n][k] = *(const PG8_LAS bf16x8*)(lds + PG8_SB(b, h) + boff + n * 2048 + k * 1024); } while (0)
#define PG8_MMA(ai, bj, At, Bt) do { __builtin_amdgcn_s_setprio(1); _Pragma("unroll") for (int m = 0; m < 4; ++m) _Pragma("unroll") for (int n = 0; n < 2; ++n) _Pragma("unroll") for (int k = 0; k < 2; ++k) \
        acc[ai][bj][m][n] = __builtin_amdgcn_mfma_f32_16x16x32_bf16(Bt[n][k], At[m][k], acc[ai][bj][m][n], 0, 0, 0); __builtin_amdgcn_s_setprio(0); } while (0)
#define PG8_WAIT_V(n) asm volatile("s_waitcnt vmcnt(" #n ")" ::: "memory")
#define PG8_WAIT_L(n) asm volatile("s_waitcnt lgkmcnt(" #n ")" ::: "memory")
#define PG8_BAR __builtin_amdgcn_s_barrier()
#define PG8_SCHED __builtin_amdgcn_sched_barrier(0)
    Unit cur, nxt; int ui = 0;
    float rsv[2][4]; int rs_pm = -1;
#pragma unroll
    for (int a = 0; a < 2; ++a)
#pragma unroll
        for (int m = 0; m < 4; ++m) rsv[a][m] = 0.f;
    if (!S.next(0, cur)) return;
    f32x4 acc[2][2][4][2];
#pragma unroll
    for (int a = 0; a < 2; ++a)
#pragma unroll
        for (int b = 0; b < 2; ++b)
#pragma unroll
            for (int m = 0; m < 4; ++m)
#pragma unroll
                for (int n = 0; n < 2; ++n) acc[a][b][m][n] = (f32x4){0.f, 0.f, 0.f, 0.f};
    bf16x8 At[4][2], B0[2][2], B1[2][2];
    const char* cA = (const char*)g.A + (size_t)cur.pm * tA; const char* cB = (const char*)g.Bt + (size_t)cur.pn * tB;
    S.a_ready(cur);
    PG8_STAGE(PG8_SB(0, 0), cB, voffB); PG8_STAGE(PG8_SB(0, 1), cB + hB, voffB); PG8_STAGE(PG8_SA(0, 0), cA, voffA); PG8_STAGE(PG8_SA(0, 1), cA + hA, voffA);
    if (wr == 1) PG8_BAR;
    PG8_WAIT_V(2); PG8_BAR;
    PG8_STAGE(PG8_SB(1, 0), cB + kstep, voffB); PG8_STAGE(PG8_SA(1, 0), cA + kstep, voffA); PG8_STAGE(PG8_SB(1, 1), cB + hB + kstep, voffB);
    PG8_WAIT_V(6); PG8_BAR;
    for (;;) {
        const bool has_next = S.next(ui + 1, nxt);
        const char* nA = has_next ? (const char*)g.A + (size_t)nxt.pm * tA : cA; const char* nB = has_next ? (const char*)g.Bt + (size_t)nxt.pn * tB : cB;
        for (int t = 0; t < nt; t += 2) {
            const bool last = (t == nt - 2);
            const char* a1 = cA + (size_t)(t + 1) * kstep;
            const char* a2 = last ? nA : cA + (size_t)(t + 2) * kstep; const char* b2 = last ? nB : cB + (size_t)(t + 2) * kstep;
            const char* a3 = a2 + kstep; const char* b3 = b2 + kstep;
            if (last && has_next) S.a_ready(nxt);
            PG8_LDB(B0, 0, 0); PG8_LDB(B1, 0, 1); PG8_SCHED; PG8_LDA(At, 0, 0); PG8_STAGE(PG8_SA(1, 1), a1 + hA, voffA);
            PG8_WAIT_V(8); PG8_WAIT_L(0); PG8_BAR; PG8_MMA(0, 0, At, B0); PG8_MMA(0, 1, At, B1); PG8_BAR; PG8_SCHED;
            PG8_LDA(At, 0, 1); PG8_STAGE(PG8_SB(0, 0), b2, voffB); PG8_STAGE(PG8_SB(0, 1), b2 + hB, voffB); PG8_STAGE(PG8_SA(0, 0), a2, voffA);
            PG8_WAIT_V(8); PG8_WAIT_L(0); PG8_BAR; PG8_MMA(1, 0, At, B0); PG8_MMA(1, 1, At, B1); PG8_BAR; PG8_SCHED;
            PG8_LDB(B0, 1, 0); PG8_LDB(B1, 1, 1); PG8_SCHED; PG8_LDA(At, 1, 0); PG8_STAGE(PG8_SA(0, 1), a2 + hA, voffA);
            PG8_WAIT_V(8); PG8_WAIT_L(0); PG8_BAR; PG8_MMA(0, 0, At, B0); PG8_MMA(0, 1, At, B1); PG8_BAR; PG8_SCHED;
            PG8_LDA(At, 1, 1); PG8_STAGE(PG8_SB(1, 0), b3, voffB); PG8_STAGE(PG8_SB(1, 1), b3 + hB, voffB); PG8_STAGE(PG8_SA(1, 0), a3, voffA);
            PG8_WAIT_V(8); PG8_WAIT_L(0); PG8_BAR; PG8_MMA(1, 0, At, B0); PG8_MMA(1, 1, At, B1); PG8_BAR; PG8_SCHED;
            if constexpr (Epi::MID) { const int tn = t + 2; if (tn <= 12 && (tn & 3) == 0) { E.mid(acc, cur, wr, wc, fr, fq, (tn >> 2) - 1); PG8_SCHED; } }
        }
        if constexpr (ALIGN_EPI) { if (wr == 0) PG8_BAR; }
        if constexpr (Epi::ROWSCALE) { if (cur.pm != rs_pm) { row_rscales(E.R, cur.pm * BM + wr * 64 + fr, rsv); rs_pm = cur.pm; }
            E(acc, cur, wr, wc, fr, fq, rsv); }
        else E(acc, cur, wr, wc, fr, fq);
        S.done(cur);
        if (!has_next) break;
#pragma unroll
        for (int a = 0; a < 2; ++a)
#pragma unroll
            for (int b = 0; b < 2; ++b)
#pragma unroll
                for (int m = 0; m < 4; ++m)
#pragma unroll
                    for (int n = 0; n < 2; ++n) acc[a][b][m][n] = (f32x4){0.f, 0.f, 0.f, 0.f};
        cur = nxt; cA = nA; cB = nB; ++ui;
        if constexpr (ALIGN_EPI) { if (wr == 1) PG8_BAR; }
    }
    PG8_WAIT_V(0);
    if constexpr (!ALIGN_EPI) { if (wr == 0) PG8_BAR; }
    PG8_BAR;
#undef PG8_SA
#undef PG8_SB
#undef PG8_STAGE
#undef PG8_LDA
#undef PG8_LDB
#undef PG8_MMA
#undef PG8_WAIT_V
#undef PG8_WAIT_L
#undef PG8_BAR
#undef PG8_SCHED
}
}
#include <cmath>
namespace attn_body {
using bf16=__hip_bfloat16;
using bf16x8=__attribute__((ext_vector_type(8)))short;
using s16x4=__attribute__((ext_vector_type(4)))short;
using f32x16=__attribute__((ext_vector_type(16)))float;
using u32x4=__attribute__((ext_vector_type(4)))unsigned;
constexpr int D=64,QKP=512,OP=1024;
constexpr int NW=8,QBLK=32,QB=QBLK*NW,KVBLK=64;
constexpr int ATTN_UNIT_ROWS=QB;
__device__ __forceinline__ int crow(int r,int hi){return (r&3)+8*(r>>2)+4*hi;}
#define SBAR() __builtin_amdgcn_sched_barrier(0)
__device__ __forceinline__ void cmask(f32x16&p0,f32x16&p1,int jb,int wid,int mode){
  const float NEG=-INFINITY;
  const bool m_all=(mode==0)?(jb>(wid>>1)):(jb==3);
  const bool m_hi=m_all||(mode!=0&&jb==2);
  #pragma unroll
  for(int r=0;r<16;++r){ p0[r]=((r>=8)?m_hi:m_all)?NEG:p0[r]; p1[r]=m_hi?NEG:p1[r]; }
}
constexpr int NSLOT=3, SLOTB=8192;
constexpr int LDS_K=0, LDS_V=NSLOT*SLOTB, LDS_WS=3*NSLOT*SLOTB, LDS_OST=0, LDS_BYTES=LDS_WS+NW*64*4;
constexpr float C2=0.125f*1.4426950408889634f;
__device__ __forceinline__ void glds16(const void*gsrc,unsigned lds_dst){unsigned keep;
  asm volatile("s_mov_b32 %0, m0\n\ts_mov_b32 m0, %2\n\ts_nop 0\n\tglobal_load_lds_dwordx4 %1, off\n\ts_mov_b32 m0, %0":"=&s"(keep):"v"(gsrc),"s"(lds_dst):"memory");}
__device__ __forceinline__ float max3f(float a,float b,float c){float r;asm("v_max3_f32 %0, %1, %2, %3":"=v"(r):"v"(a),"v"(b),"v"(c));return r;}
__device__ __forceinline__ float max2f(float a,float b){float r;asm("v_max_f32_e32 %0, %1, %2":"=v"(r):"v"(a),"v"(b));return r;}
__device__ __forceinline__ float fadd_s(float a,float b){float r;asm("v_add_f32_e32 %0, %1, %2":"=v"(r):"v"(a),"v"(b));return r;}
__device__ __forceinline__ float fsub_s(float a,float b){float r;asm("v_sub_f32_e32 %0, %1, %2":"=v"(r):"v"(a),"v"(b));return r;}
typedef float f32x2_t __attribute__((ext_vector_type(2))); typedef __bf16 bf16x2_t __attribute__((ext_vector_type(2)));
__device__ __forceinline__ unsigned cvtpk_s(float lo,float hi){f32x2_t v={lo,hi};bf16x2_t b=__builtin_convertvector(v,bf16x2_t);return __builtin_bit_cast(unsigned,b);}
#define WAIT_BAR(N) asm volatile("s_waitcnt vmcnt(" #N ") lgkmcnt(0)\n\ts_barrier":::"memory")

__device__ __forceinline__ void qkt(f32x16&p0,f32x16&p1,const char*Kslot,const bf16x8*qr,const f32x16&negm,int r32,int hi){
  const char*kb=Kslot+hi*1024+r32*16;
  #pragma unroll
  for(int d0=0;d0<4;++d0){
    const bf16x8 b0=*reinterpret_cast<const bf16x8*>(kb+d0*2048);
    const bf16x8 b1=*reinterpret_cast<const bf16x8*>(kb+d0*2048+512);
    if(d0==0){p0=__builtin_amdgcn_mfma_f32_32x32x16_bf16(b0,qr[0],negm,0,0,0);p1=__builtin_amdgcn_mfma_f32_32x32x16_bf16(b1,qr[0],negm,0,0,0);}
    else{p0=__builtin_amdgcn_mfma_f32_32x32x16_bf16(b0,qr[d0],p0,0,0,0);p1=__builtin_amdgcn_mfma_f32_32x32x16_bf16(b1,qr[d0],p1,0,0,0);}}
}
typedef __attribute__((address_space(3))) const char* lds_cptr;
typedef short v4i16_t __attribute__((ext_vector_type(4)));
__device__ __forceinline__ void kload8(bf16x8*kf,lds_cptr kp){
  kf[0]=*(const __attribute__((address_space(3))) bf16x8*)(kp);      kf[1]=*(const __attribute__((address_space(3))) bf16x8*)(kp+512);
  kf[2]=*(const __attribute__((address_space(3))) bf16x8*)(kp+2048); kf[3]=*(const __attribute__((address_space(3))) bf16x8*)(kp+2560);
  kf[4]=*(const __attribute__((address_space(3))) bf16x8*)(kp+4096); kf[5]=*(const __attribute__((address_space(3))) bf16x8*)(kp+4608);
  kf[6]=*(const __attribute__((address_space(3))) bf16x8*)(kp+6144); kf[7]=*(const __attribute__((address_space(3))) bf16x8*)(kp+6656);
}
__device__ __forceinline__ void kload2(bf16x8*kf,lds_cptr kp,int j){ kf[2*j]=*(const __attribute__((address_space(3))) bf16x8*)(kp+j*2048); kf[2*j+1]=*(const __attribute__((address_space(3))) bf16x8*)(kp+j*2048+512); }
__device__ __forceinline__ s16x4 vtr(lds_cptr p){ return __builtin_bit_cast(s16x4,__builtin_amdgcn_ds_read_tr16_b64_v4i16((__attribute__((address_space(3))) v4i16_t*)p)); }
__device__ __forceinline__ float rowmax(const f32x16&p0,const f32x16&p1){
  float a=max3f(p0[0],p0[1],p1[0]),b=max3f(p0[2],p0[3],p1[1]);a=max3f(a,p1[2],p1[3]);
  #pragma unroll
  for(int r=4;r<16;r+=4){a=max3f(a,p0[r],p0[r+1]);b=max3f(b,p0[r+2],p0[r+3]);a=max3f(a,p1[r],p1[r+1]);b=max3f(b,p1[r+2],p1[r+3]);}
  const float m=max2f(a,b);
  auto rr=__builtin_amdgcn_permlane32_swap(__float_as_uint(m),__float_as_uint(m),false,false);
  return max2f(__uint_as_float(rr[0]),__uint_as_float(rr[1]));
}
__device__ __forceinline__ void pv(f32x16*o,int vb,bf16x8 pa0,bf16x8 pa1,bf16x8 pa2,bf16x8 pa3){
  #pragma unroll
  for(int d0=0;d0<4;++d0){s16x4 lo[4],hi[4];
    #pragma unroll
    for(int ks=0;ks<4;++ks){
      asm volatile("ds_read_b64_tr_b16 %0,%1 offset:%c2":"=&v"(lo[ks]):"v"(vb),"i"(d0*4096+ks*1024):"memory");
      asm volatile("ds_read_b64_tr_b16 %0,%1 offset:%c2":"=&v"(hi[ks]):"v"(vb),"i"(d0*4096+ks*1024+512):"memory");}
    asm volatile("s_waitcnt lgkmcnt(0)":::"memory");SBAR();
    #define PK(k) (bf16x8){lo[k][0],lo[k][1],lo[k][2],lo[k][3],hi[k][0],hi[k][1],hi[k][2],hi[k][3]}
    o[d0]=__builtin_amdgcn_mfma_f32_32x32x16_bf16(pa0,PK(0),o[d0],0,0,0);
    o[d0]=__builtin_amdgcn_mfma_f32_32x32x16_bf16(pa1,PK(1),o[d0],0,0,0);
    o[d0]=__builtin_amdgcn_mfma_f32_32x32x16_bf16(pa2,PK(2),o[d0],0,0,0);
    o[d0]=__builtin_amdgcn_mfma_f32_32x32x16_bf16(pa3,PK(3),o[d0],0,0,0);
    #undef PK
  }
}

#ifndef ATTN_STORE16
#define ATTN_STORE16(p,v) (*(__attribute__((address_space(1))) u32x4*)(p)=(v))
#endif
template<int THRL> __device__ __forceinline__ void attn_unit(const bf16*Qw0,const bf16*__restrict__ Kh,const bf16*__restrict__ Vh,bf16*Ow0,const int NT,const int mode,char*shm,int tid_in){
  int tid_=tid_in; asm volatile("":"+v"(tid_)); const int tid=tid_,lane=tid&63,r32=lane&31,hi=lane>>5; const int wid=__builtin_amdgcn_readfirstlane(tid>>6);
  const bf16*Qw=Qw0+(long)wid*QBLK*QKP;
  const unsigned lds0=(unsigned)(uintptr_t)shm;
  float*wsf=(float*)(shm+LDS_WS)+wid*64;
  const bf16*ksrc=Kh+(long)lane*QKP+wid*8;
  const bf16*vsrc=Vh+(long)(16*(wid&3)+(lane>>2))*QKP+(wid>>2)*32+(lane&3)*8;
  const unsigned kdst=lds0+LDS_K+wid*1024, vdst=lds0+LDS_V+wid*1024;
  #define DMA_K(t,slot) glds16(ksrc+(long)(t)*KVBLK*QKP,(unsigned)__builtin_amdgcn_readfirstlane(kdst+(slot)))
  #define DMA_V(t,slot) do{ glds16(vsrc+(long)(t)*KVBLK*QKP,(unsigned)__builtin_amdgcn_readfirstlane(vdst+2*(slot))); glds16(vsrc+64+(long)(t)*KVBLK*QKP,(unsigned)__builtin_amdgcn_readfirstlane(vdst+2*(slot)+8192)); }while(0)
  const int vb0=(int)(lds0+LDS_V)+((lane>>4)&1)*32+(lane&3)*8+(4*hi+((lane&15)>>2))*64;
  const char*Kbase=shm+LDS_K; bf16x8 kf[8];
  const lds_cptr shm3=(lds_cptr)shm; const lds_cptr kp0=shm3+LDS_K+hi*1024+r32*16; const lds_cptr vp0=shm3+LDS_V+((lane>>4)&1)*32+(lane&3)*8+(4*hi+((lane&15)>>2))*64;
  DMA_K(0,0);DMA_V(0,0);DMA_K(1,SLOTB);
  bf16x8 qr[4];
  #pragma unroll
  for(int d0=0;d0<4;++d0)qr[d0]=*(const __attribute__((address_space(1))) bf16x8*)(&Qw[(long)r32*QKP+d0*16+hi*8]);
  float mhat=0.f,l_reg=0.f;f32x16 o[4];o[0]=f32x16{};o[1]=f32x16{};o[2]=f32x16{};o[3]=f32x16{};f32x16 negm=f32x16{};asm volatile("":"+v"(negm));
  #define CMASK(P0,P1,t) do{int jb_=(t)-(NT-4); if(jb_>=0)cmask(P0,P1,jb_,wid,mode);}while(0)
  bool resc=false;
  #define START(P0,P1) do{ const float rm=rowmax(P0,P1); resc=false; \
    { const float dl=rm; mhat=fadd_s(mhat,dl); \
      _Pragma("unroll") for(int r=0;r<16;++r){P0[r]=fsub_s(P0[r],dl);P1[r]=fsub_s(P1[r],dl);} \
      _Pragma("unroll") for(int r=0;r<16;++r)negm[r]=-mhat; asm volatile("":"+v"(negm)); } \
    _Pragma("unroll") for(int r=0;r<16;++r)P0[r]=__builtin_amdgcn_exp2f(P0[r]); }while(0)
  #define RESC() do{ if(resc){ asm volatile("s_waitcnt lgkmcnt(0)":::"memory"); \
      _Pragma("unroll") for(int d_=0;d_<4;++d_) _Pragma("unroll") for(int r=0;r<16;++r)o[d_][r]*=wsf[crow(r,hi)]; } }while(0)
  f32x16 pA0,pA1,pB0,pB1;
  int sl_prev=0,sl_cur=0,sl_next=SLOTB;
  #define ROT() do{sl_prev=sl_cur;sl_cur=sl_next;sl_next=(sl_next==(NSLOT-1)*SLOTB)?0:sl_next+SLOTB;}while(0)
  DMA_K(2,2*SLOTB);
  WAIT_BAR(3);
  qkt(pA0,pA1,Kbase,qr,negm,r32,hi);asm volatile("s_nop 15\n\ts_nop 7":"+v"(pA0),"+v"(pA1));CMASK(pA0,pA1,0);
  START(pA0,pA1);
  _Pragma("unroll") for(int r=0;r<16;++r)pA1[r]=__builtin_amdgcn_exp2f(pA1[r]);
  WAIT_BAR(0);
  DMA_K(3,0);DMA_V(1,SLOTB);
  ROT();
  kload8(kf,kp0+sl_cur);
  WAIT_BAR(3);
  s16x4 vlo[8],vhi[8]; u32x4 pw0,pw1,pw2,pw3;
  #define PKW(P,B) cvtpk_s(P[B],P[B+1])
  #define PAF(k) __builtin_bit_cast(bf16x8,pw##k)
  #define VFR(i) (bf16x8){vlo[i][0],vlo[i][1],vlo[i][2],vlo[i][3],vhi[i][0],vhi[i][1],vhi[i][2],vhi[i][3]}
  #define PIN(x) asm volatile("":"+v"(x))
  #define MX3(a,b,c) __builtin_fmaxf(__builtin_fmaxf((a),(b)),(c))
  #define GAPA(MF,A0,A1,A2,A3,W0,W1,PW) do{ MF; sacc+=A0; sacc+=A1; sacc+=A2; sacc+=A3; PIN(sacc); W0; W1; PIN(PW); SBAR(); }while(0)
  #define EX(v) __builtin_amdgcn_exp2f(v)
  #define GAPB(MF,X,B) do{ MF; X[B]=EX(X[B]); X[B+1]=EX(X[B+1]); X[B+2]=EX(X[B+2]); X[B+3]=EX(X[B+3]); PIN(X); SBAR(); }while(0)
  #define VRD(s,i) do{ vlo[s]=vtr(vp_+((i)*1024)); vhi[s]=vtr(vp_+((i)*1024+512)); }while(0)
  #define GAPB2(MF,X,B) do{ MF; X[B]=EX(X[B]); X[B+1]=EX(X[B+1]); PIN(X); SBAR(); }while(0)
  #define KRD(G,j) do{ if(G){ kload2(kf,kp0+sl_next,j); SBAR(); } }while(0)
  #define STEP(C0,C1,P0,P1,t,GK,GV,GL) do{ SBAR(); \
    const lds_cptr vp_=vp0+2*sl_prev; \
    VRD(0,0); SBAR(); float sacc=(P0[0]+P0[1]); \
    GAPA(C0=__builtin_amdgcn_mfma_f32_32x32x16_bf16(kf[0],qr[0],negm,0,0,0), P0[2],P0[3],P0[4],P0[5],     pw0[0]=PKW(P0,0), pw0[1]=PKW(P0,2), pw0); \
    VRD(1,4); SBAR(); GAPA(C1=__builtin_amdgcn_mfma_f32_32x32x16_bf16(kf[1],qr[0],negm,0,0,0), P0[6],P0[7],P0[8],P0[9],     pw0[2]=PKW(P0,4), pw0[3]=PKW(P0,6), pw0); \
    VRD(2,8); SBAR(); GAPA(C0=__builtin_amdgcn_mfma_f32_32x32x16_bf16(kf[2],qr[1],C0,0,0,0),   P0[10],P0[11],P0[12],P0[13], pw1[0]=PKW(P0,8), pw1[1]=PKW(P0,10), pw1); \
    VRD(3,12); SBAR(); GAPA(C1=__builtin_amdgcn_mfma_f32_32x32x16_bf16(kf[3],qr[1],C1,0,0,0),   P0[14],P0[15],P1[0],P1[1],   pw1[2]=PKW(P0,12),pw1[3]=PKW(P0,14), pw1); \
    VRD(4,1); SBAR(); GAPA(C0=__builtin_amdgcn_mfma_f32_32x32x16_bf16(kf[4],qr[2],C0,0,0,0),   P1[2],P1[3],P1[4],P1[5],     pw2[0]=PKW(P1,0), pw2[1]=PKW(P1,2), pw2); \
    VRD(5,5); SBAR(); GAPA(C1=__builtin_amdgcn_mfma_f32_32x32x16_bf16(kf[5],qr[2],C1,0,0,0),   P1[6],P1[7],P1[8],P1[9],     pw2[2]=PKW(P1,4), pw2[3]=PKW(P1,6), pw2); \
    VRD(6,9); SBAR(); GAPA(C0=__builtin_amdgcn_mfma_f32_32x32x16_bf16(kf[6],qr[3],C0,0,0,0),   P1[10],P1[11],P1[12],P1[13], pw3[0]=PKW(P1,8), pw3[1]=PKW(P1,10), pw3); \
    VRD(7,13); SBAR(); GAPA(C1=__builtin_amdgcn_mfma_f32_32x32x16_bf16(kf[7],qr[3],C1,0,0,0),   P1[14],P1[15],0.f,0.f,       pw3[2]=PKW(P1,12),pw3[3]=PKW(P1,14), pw3); \
    l_reg+=sacc; \
    if(GK){DMA_K((t)+3,sl_cur);} if(GV){DMA_V((t)+1,sl_next);} \
    CMASK(C0,C1,t); \
    { float a=MX3(C0[0],C0[1],C1[0]),b=MX3(C0[2],C0[3],C1[1]); a=MX3(a,C1[2],C1[3]); \
      _Pragma("unroll") for(int r=4;r<16;r+=4){a=MX3(a,C0[r],C0[r+1]);b=MX3(b,C0[r+2],C0[r+3]);a=MX3(a,C1[r],C1[r+1]);b=MX3(b,C1[r+2],C1[r+3]);} \
      float rm=__builtin_fmaxf(a,b); { auto rr=__builtin_amdgcn_permlane32_swap(__float_as_uint(rm),__float_as_uint(rm),false,false); rm=__builtin_fmaxf(__uint_as_float(rr[0]),__uint_as_float(rr[1])); } \
      resc=false; \
      if(__builtin_expect(__any(rm>(float)THRL),0)){ const float dl=__builtin_fmaxf(rm,0.f); mhat+=dl; \
        _Pragma("unroll") for(int r=0;r<16;++r){C0[r]-=dl;C1[r]-=dl;} \
        _Pragma("unroll") for(int r=0;r<16;++r)negm[r]=-mhat; asm volatile("":"+v"(negm)); \
        const float f=__builtin_amdgcn_exp2f(-dl); l_reg*=f; if(hi==0)wsf[r32]=f; resc=true; } } \
    SBAR(); \
    GAPB2(o[0]=__builtin_amdgcn_mfma_f32_32x32x16_bf16(PAF(0),VFR(0),o[0],0,0,0), C0,0); VRD(0,2); SBAR(); \
    GAPB2(o[1]=__builtin_amdgcn_mfma_f32_32x32x16_bf16(PAF(0),VFR(1),o[1],0,0,0), C0,2); VRD(1,6); SBAR(); \
    GAPB2(o[2]=__builtin_amdgcn_mfma_f32_32x32x16_bf16(PAF(0),VFR(2),o[2],0,0,0), C0,4); VRD(2,10); SBAR(); \
    GAPB2(o[3]=__builtin_amdgcn_mfma_f32_32x32x16_bf16(PAF(0),VFR(3),o[3],0,0,0), C0,6); VRD(3,14); SBAR(); \
    GAPB2(o[0]=__builtin_amdgcn_mfma_f32_32x32x16_bf16(PAF(1),VFR(4),o[0],0,0,0), C0,8); VRD(4,3); SBAR(); \
    GAPB2(o[1]=__builtin_amdgcn_mfma_f32_32x32x16_bf16(PAF(1),VFR(5),o[1],0,0,0), C0,10); VRD(5,7); SBAR(); \
    GAPB2(o[2]=__builtin_amdgcn_mfma_f32_32x32x16_bf16(PAF(1),VFR(6),o[2],0,0,0), C0,12); VRD(6,11); SBAR(); \
    GAPB2(o[3]=__builtin_amdgcn_mfma_f32_32x32x16_bf16(PAF(1),VFR(7),o[3],0,0,0), C0,14); VRD(7,15); SBAR(); \
    GAPB2(o[0]=__builtin_amdgcn_mfma_f32_32x32x16_bf16(PAF(2),VFR(0),o[0],0,0,0), C1,0); \
    GAPB2(o[1]=__builtin_amdgcn_mfma_f32_32x32x16_bf16(PAF(2),VFR(1),o[1],0,0,0), C1,2); \
    KRD(GL,0); GAPB2(o[2]=__builtin_amdgcn_mfma_f32_32x32x16_bf16(PAF(2),VFR(2),o[2],0,0,0), C1,4); \
    KRD(GL,1); GAPB2(o[3]=__builtin_amdgcn_mfma_f32_32x32x16_bf16(PAF(2),VFR(3),o[3],0,0,0), C1,6); \
    KRD(GL,2); GAPB2(o[0]=__builtin_amdgcn_mfma_f32_32x32x16_bf16(PAF(3),VFR(4),o[0],0,0,0), C1,8); \
    KRD(GL,3); GAPB2(o[1]=__builtin_amdgcn_mfma_f32_32x32x16_bf16(PAF(3),VFR(5),o[1],0,0,0), C1,10); \
    GAPB2(o[2]=__builtin_amdgcn_mfma_f32_32x32x16_bf16(PAF(3),VFR(6),o[2],0,0,0), C1,12); \
    GAPB2(o[3]=__builtin_amdgcn_mfma_f32_32x32x16_bf16(PAF(3),VFR(7),o[3],0,0,0), C1,14); \
    }while(0)
  int t=1;
  #undef CMASK
  #define CMASK(P0,P1,t) do{}while(0)
  for(;t+5<NT;t+=2){
    STEP(pB0,pB1,pA0,pA1,t,true,true,true);     WAIT_BAR(3); RESC(); ROT();
    STEP(pA0,pA1,pB0,pB1,t+1,true,true,true);   WAIT_BAR(3); RESC(); ROT();
  }
  #undef CMASK
  #define CMASK(P0,P1,t) do{int jb_=(t)-(NT-4); if(jb_>=0)cmask(P0,P1,jb_,wid,mode);}while(0)
  #define ENDW(tt) do{ if((tt)+3<NT){WAIT_BAR(3);} else if((tt)+2<NT){WAIT_BAR(2);} else {WAIT_BAR(0);} }while(0)
  for(;t+1<NT;t+=2){
    STEP(pB0,pB1,pA0,pA1,t,(t+3<NT),(t+1<NT),(t+1<NT));       ENDW(t);   RESC(); ROT();
    STEP(pA0,pA1,pB0,pB1,t+1,(t+4<NT),(t+2<NT),(t+2<NT));     ENDW(t+1); RESC(); ROT();
  }
  STEP(pB0,pB1,pA0,pA1,NT-1,false,false,false); RESC();
  { float sacc=pB0[0]+pB0[1]; _Pragma("unroll") for(int r=2;r<16;++r)sacc+=pB0[r]; _Pragma("unroll") for(int r=0;r<16;++r)sacc+=pB1[r]; l_reg+=sacc;
    pw0=(u32x4){PKW(pB0,0),PKW(pB0,2),PKW(pB0,4),PKW(pB0,6)};pw1=(u32x4){PKW(pB0,8),PKW(pB0,10),PKW(pB0,12),PKW(pB0,14)};pw2=(u32x4){PKW(pB1,0),PKW(pB1,2),PKW(pB1,4),PKW(pB1,6)};pw3=(u32x4){PKW(pB1,8),PKW(pB1,10),PKW(pB1,12),PKW(pB1,14)};
    SBAR(); pv(o,vb0+2*sl_cur,PAF(0),PAF(1),PAF(2),PAF(3)); }
  #undef PKW
  #undef PAF
  #undef VFR
  #undef PIN
  #undef MX3
  #undef GAPA
  #undef GAPB
  #undef EX
  #undef VRD
  #undef KRD
  #undef STEP
  #undef ENDW
  {auto rr=__builtin_amdgcn_permlane32_swap(__float_as_uint(l_reg),__float_as_uint(l_reg),false,false);l_reg=__uint_as_float(rr[0])+__uint_as_float(rr[1]);}
  if(hi==0)wsf[32+r32]=l_reg;asm volatile("s_waitcnt lgkmcnt(0)":::"memory");
  float rli[16];
  #pragma unroll
  for(int r=0;r<16;++r)rli[r]=__builtin_amdgcn_rcpf(wsf[32+crow(r,hi)]);
  bf16*Ow=Ow0+(long)wid*QBLK*OP;
  asm volatile("s_waitcnt lgkmcnt(0)\n\ts_barrier":::"memory");
  { bf16*stg=(bf16*)(shm+LDS_OST)+wid*4096;
    #pragma unroll
    for(int r=0;r<16;++r){const int orow=crow(r,hi);
      #pragma unroll
      for(int d0=0;d0<4;++d0)stg[orow*128+d0*32+r32]=__float2bfloat16(o[d0][r]*rli[r]);}
    asm volatile("s_waitcnt lgkmcnt(0)":::"memory");
    #pragma unroll
    for(int i=0;i<8;++i){const int row=i*4+(lane>>4),ch=lane&15; const u32x4 v=*(const u32x4*)(stg+row*128+ch*8); ATTN_STORE16(Ow+(long)row*OP+ch*8,v);} }
  asm volatile("s_waitcnt lgkmcnt(0)\n\ts_barrier":::"memory");
  #undef DMA_K
  #undef DMA_V
  #undef CMASK
  #undef START
  #undef RESC
  #undef ROT
}
constexpr int ATTN_LDS_BYTES=LDS_BYTES;
#undef SBAR
#undef WAIT_BAR
}
#ifndef CPU_TEST
namespace mixf {
typedef short bf16x8 __attribute__((ext_vector_type(8)));
typedef float f32x4 __attribute__((ext_vector_type(4)));
typedef unsigned u32x4 __attribute__((ext_vector_type(4)));
typedef unsigned u32x2 __attribute__((ext_vector_type(2)));
constexpr int DAB_LD = 264;
__device__ __forceinline__ float fsig(float x) { return __builtin_amdgcn_rcpf(1.0f + __expf(-x)); }
__device__ __forceinline__ float wsum(float v, int lane) {
#pragma unroll
    for (int o = 1; o < 64; o <<= 1) v += __builtin_bit_cast(float, __builtin_amdgcn_ds_bpermute((lane ^ o) << 2, __builtin_bit_cast(int, v)));
    return v;
}
__device__ __forceinline__ unsigned pk2f(float lo, float hi) { return f2bf(lo) | (f2bf(hi) << 16); }

__device__ __forceinline__ void unpack8(const u32x4 w, float* o) {
    o[0] = __builtin_bit_cast(float, w.x << 16); o[1] = __builtin_bit_cast(float, w.x & 0xffff0000u); o[2] = __builtin_bit_cast(float, w.y << 16); o[3] = __builtin_bit_cast(float, w.y & 0xffff0000u);
    o[4] = __builtin_bit_cast(float, w.z << 16); o[5] = __builtin_bit_cast(float, w.z & 0xffff0000u); o[6] = __builtin_bit_cast(float, w.w << 16); o[7] = __builtin_bit_cast(float, w.w & 0xffff0000u);
}
__device__ __forceinline__ u32x4 pack8(const float* v) { u32x4 w; w.x = pk2f(v[0], v[1]); w.y = pk2f(v[2], v[3]); w.z = pk2f(v[4], v[5]); w.w = pk2f(v[6], v[7]); return w; }
__device__ __forceinline__ void st8f(float* p, const float* v) { *(f32x4*)p = (f32x4){v[0], v[1], v[2], v[3]}; *(f32x4*)(p + 4) = (f32x4){v[4], v[5], v[6], v[7]}; }
__device__ __forceinline__ void ld8f(const float* p, float* v) { const f32x4 a = *(const f32x4*)p, c = *(const f32x4*)(p + 4); v[0] = a[0]; v[1] = a[1]; v[2] = a[2]; v[3] = a[3]; v[4] = c[0]; v[5] = c[1]; v[6] = c[2]; v[7] = c[3]; }
constexpr int TG_OFF = 0, TC_OFF = 62 * 512, TB_OFF = TC_OFF + 34 * 512, TU_OFF = TB_OFF + 32 * 512, DAB_OFF = TU_OFF + 47 * 512, MIX_LDS_END = DAB_OFF + 32 * DAB_LD * 2;
static_assert(MIX_LDS_END <= 131072 && (34 + 32) * 512 >= 32 * 1024, "mixer-prep LDS map");
template <int NR> __device__ __forceinline__ void item(const MixP& P, const MixItem& I, const bf16_t* __restrict__ WTg, int tid, LAS unsigned char* L) {
    constexpr int HR = NR / 2, RPT = NR / 16;
    LAS bf16_t* TG = (LAS bf16_t*)(L + TG_OFF); LAS bf16_t* TC = (LAS bf16_t*)(L + TC_OFF); LAS bf16_t* TB = (LAS bf16_t*)(L + TB_OFF); LAS bf16_t* TU = (LAS bf16_t*)(L + TU_OFF);
    LAS bf16_t* DAB = (LAS bf16_t*)(L + DAB_OFF); LAS float* cv = (LAS float*)(L + TC_OFF);
    const int ch = tid & 255, half = tid >> 8, lane = tid & 63, wid = tid >> 6, l = P.layer, b = I.b, t0 = I.t0;
    const int cg = tid & 31, rs = tid >> 5, ch0 = cg * 8;
    const bool smp = I.sample != 0;
    const size_t mb = smp ? (size_t)SEQ + (size_t)DECS * b : 0;
    const bf16_t* __restrict__ Z = P.Z;
    {
        u32x4 qa[4], qg[4], qc[3], qs[3], qu[3], qb[2];
        const u32x4 z4 = {0u, 0u, 0u, 0u};
#pragma unroll
        for (int k = 0; k < 4; ++k) { const int i = rs + 16 * k, t = t0 - 30 + i; qa[k] = z4; qg[k] = z4; if (i < NR + 30 && t >= 0) { const bf16_t* zr = Z + (mb + t) * ZW + ch0; qa[k] = *(const u32x4*)(zr + 1024); qg[k] = *(const u32x4*)(zr + 1280); } }
#pragma unroll
        for (int k = 0; k < 3; ++k) { const int i = rs + 16 * k, t = t0 - 2 + i; qc[k] = z4; qs[k] = z4; if (i < NR + 2 && t >= 0) { const bf16_t* zr = Z + (mb + t) * ZW + ch0; qc[k] = *(const u32x4*)(zr + 512); qs[k] = *(const u32x4*)(zr + 768); } }
#pragma unroll
        for (int k = 0; k < 3; ++k) { const int i = rs + 16 * k, t = t0 - 15 + i; qu[k] = z4; if (i < NR + 15 && t >= 0) qu[k] = *(const u32x4*)(Z + (mb + t) * ZW + ch0); }
#pragma unroll
        for (int k = 0; k < 2; ++k) { const int i = rs + 16 * k; qb[k] = z4; if (i < NR) qb[k] = *(const u32x4*)(Z + (mb + t0 + i) * ZW + 256 + ch0); }
#pragma unroll
        for (int k = 0; k < 4; ++k) { const int i = rs + 16 * k, t = t0 - 30 + i;
            if (i < NR + 30) { float v[8];
                if (t >= 0) { float a[8], g[8]; unpack8(qa[k], a); unpack8(qg[k], g);
#pragma unroll
                    for (int j = 0; j < 8; ++j) v[j] = a[j] * fsig(g[j]); }
                else if (smp) ld8f(P.st_cconv + ((size_t)b * 30 + (30 + t)) * 256 + ch0, v);
                else {
#pragma unroll
                    for (int j = 0; j < 8; ++j) v[j] = 0.f; }
                *(LAS u32x4*)(TG + i * 256 + ch0) = pack8(v);
                if (!smp) { if (t >= t0 && t >= SEQ - 30) st8f(P.out + O_CCP + ((size_t)l * 30 + (t - (SEQ - 30))) * 256 + ch0, v); }
                else { if (t + 14 >= 0) st8f(P.out + O_CCS + (((size_t)l * DECB + b) * 30 + (t + 14)) * 256 + ch0, v); } } }
#pragma unroll
        for (int k = 0; k < 3; ++k) { const int i = rs + 16 * k, t = t0 - 2 + i;
            if (i < NR + 2) { float v[8];
                if (t >= 0) { float a[8], g[8]; unpack8(qc[k], a); unpack8(qs[k], g);
#pragma unroll
                    for (int j = 0; j < 8; ++j) v[j] = a[j] * g[j]; }
                else if (smp) ld8f(P.st_sconv + ((size_t)b * 2 + (2 + t)) * 256 + ch0, v);
                else {
#pragma unroll
                    for (int j = 0; j < 8; ++j) v[j] = 0.f; }
                *(LAS u32x4*)(TC + i * 256 + ch0) = pack8(v);
                if (!smp) { if (t >= t0 && t >= SEQ - 2) st8f(P.out + O_SCP + ((size_t)l * 2 + (t - (SEQ - 2))) * 256 + ch0, v); }
                else { if (t >= DECS - 2) st8f(P.out + O_SCS + (((size_t)l * DECB + b) * 2 + (t - (DECS - 2))) * 256 + ch0, v); } } }
#pragma unroll
        for (int k = 0; k < 3; ++k) { const int i = rs + 16 * k, t = t0 - 15 + i;
            if (i < NR + 15) { float v[8];
                if (t >= 0) unpack8(qu[k], v);
                else if (smp) ld8f(P.st_pool + ((size_t)b * 15 + (15 + t)) * 256 + ch0, v);
                else {
#pragma unroll
                    for (int j = 0; j < 8; ++j) v[j] = 0.f; }
                *(LAS u32x4*)(TU + i * 256 + ch0) = (t >= 0) ? qu[k] : pack8(v);
                if (!smp) { if (t >= t0 && t >= SEQ - 15) st8f(P.out + O_POOLP + ((size_t)l * 15 + (t - (SEQ - 15))) * 256 + ch0, v); }
                else { if (t >= 1) st8f(P.out + O_POOLS + (((size_t)l * DECB + b) * 15 + (t - 1)) * 256 + ch0, v); } } }
#pragma unroll
        for (int k = 0; k < 2; ++k) { const int i = rs + 16 * k; if (i < NR) *(LAS u32x4*)(TB + i * 256 + ch0) = qb[k]; }
    }
    __syncthreads();
    {
        float w0[8], w1[8], w2[8]; ld8f(P.sconv_w + ch0, w0); ld8f(P.sconv_w + 256 + ch0, w1); ld8f(P.sconv_w + 512 + ch0, w2);
#pragma unroll
        for (int j = 0; j < RPT; ++j) { const int r = rs * RPT + j; float c0[8], c1[8], c2[8], zb[8], y[8];
            unpack8(*(const LAS u32x4*)(TC + r * 256 + ch0), c0); unpack8(*(const LAS u32x4*)(TC + (r + 1) * 256 + ch0), c1); unpack8(*(const LAS u32x4*)(TC + (r + 2) * 256 + ch0), c2);
            unpack8(*(const LAS u32x4*)(TB + r * 256 + ch0), zb);
#pragma unroll
            for (int q = 0; q < 8; ++q) y[q] = zb[q] * (w0[q] * c0[q] + w1[q] * c1[q] + w2[q] * c2[q]);
            *(u32x4*)(P.Y + (mb + t0 + r) * YW + 256 + ch0) = pack8(y); }
    }
    {
        float u[HR + 15];
#pragma unroll
        for (int i = 0; i < HR + 15; ++i) u[i] = bf2f(TU[(half * HR + i) * 256 + ch]);
        const int win = 2 << (ch >> 6);
#pragma unroll
        for (int r = 0; r < HR; ++r) { const int t = t0 + half * HR + r; float s = 0.f;
#pragma unroll
            for (int j = 0; j < 16; ++j) if (j < win) s += u[15 + r - j];
            const int pos = smp ? PAST + t : t; const int cnt = (pos + 1 < win) ? pos + 1 : win;
            DAB[(half * HR + r) * DAB_LD + ch] = (bf16_t)f2bf(s / (float)cnt - u[15 + r]); }
    }
    __syncthreads();
    {
        float g[HR + 30];
#pragma unroll
        for (int i = 0; i < HR + 30; ++i) g[i] = bf2f(TG[(half * HR + i) * 256 + ch]);
        float w[31];
#pragma unroll
        for (int j = 0; j < 31; ++j) w[j] = P.cconv_w[j * 256 + ch];
#pragma unroll
        for (int r = 0; r < HR; ++r) { float a = 0.f;
#pragma unroll
            for (int j = 0; j < 31; ++j) a += w[j] * g[r + j];
            cv[(half * HR + r) * 256 + ch] = a; }
    }
    {
        const int fr = lane & 15, fq = lane >> 4, g4 = wid >> 1, nt0 = (wid & 1) * 2;
        bf16x8 Bw[2][2], Ad[2][2];
#pragma unroll
        for (int nt = 0; nt < 2; ++nt)
#pragma unroll
            for (int ks = 0; ks < 2; ++ks) Bw[nt][ks] = *(const bf16x8*)(WTg + (size_t)(g4 * 64 + (nt0 + nt) * 16 + fr) * 64 + ks * 32 + fq * 8);
#pragma unroll
        for (int mt = 0; mt < NR / 16; ++mt)
#pragma unroll
            for (int ks = 0; ks < 2; ++ks) Ad[mt][ks] = *(const LAS bf16x8*)(DAB + (mt * 16 + fr) * DAB_LD + g4 * 64 + ks * 32 + fq * 8);
#pragma unroll
        for (int mt = 0; mt < NR / 16; ++mt)
#pragma unroll
            for (int nt = 0; nt < 2; ++nt) { f32x4 acc = {0.f, 0.f, 0.f, 0.f};
                acc = __builtin_amdgcn_mfma_f32_16x16x32_bf16(Bw[nt][0], Ad[mt][0], acc, 0, 0, 0);
                acc = __builtin_amdgcn_mfma_f32_16x16x32_bf16(Bw[nt][1], Ad[mt][1], acc, 0, 0, 0);
                const int col = g4 * 64 + (nt0 + nt) * 16 + 4 * fq; const f32x4 sc = *(const f32x4*)(P.pool_scale + col);
                u32x2 wv; wv.x = pk2f(acc[0] * sc[0], acc[1] * sc[1]); wv.y = pk2f(acc[2] * sc[2], acc[3] * sc[3]);
                *(u32x2*)(P.Y + (mb + t0 + mt * 16 + fr) * YW + col) = wv; }
    }
    __syncthreads();
    {
        const f32x4 bi = *(const f32x4*)(P.cconv_b + 4 * lane), lg = *(const f32x4*)(P.ln_g + 4 * lane), lb = *(const f32x4*)(P.ln_b + 4 * lane);
#pragma unroll
        for (int k = 0; k < NR / 8; ++k) { const int r = wid + 8 * k;
            f32x4 v = *(const LAS f32x4*)(cv + r * 256 + 4 * lane) + bi;
            const float mean = wsum((v[0] + v[1]) + (v[2] + v[3]), lane) * (1.f / 256.f);
            v = v - mean;
            const float rstd = 1.0f / sqrtf(wsum((v[0] * v[0] + v[1] * v[1]) + (v[2] * v[2] + v[3] * v[3]), lane) * (1.f / 256.f) + EPS);
            f32x4 y = v * rstd * lg + lb;
#pragma unroll
            for (int i = 0; i < 4; ++i) y[i] = y[i] * fsig(y[i]);
            u32x2 wv; wv.x = pk2f(y[0], y[1]); wv.y = pk2f(y[2], y[3]);
            *(u32x2*)(P.Y + (mb + t0 + r) * YW + 512 + 4 * lane) = wv; }
    }
    {
        const int map = lane >> 3, c8 = lane & 7, cm = c8 & 3;
        float gq[8], gk[8]; ld8f(P.qg + 8 * c8, gq); ld8f(P.kg + 8 * c8, gk);
        const float sgn = (c8 < 4) ? -1.0f : 1.0f;
#pragma unroll
        for (int k = 0; k < NR / 8; ++k) { const int rr = wid * (NR / 8) + k, t = t0 + rr; const int pos = smp ? PAST + t : t;
            float co[8], si[8]; ld8f(P.rope + (size_t)pos * 64 + 8 * cm, co); ld8f(P.rope + (size_t)pos * 64 + 32 + 8 * cm, si);
            const bf16_t* src = Z + (mb + t) * ZW + 1536 + lane * 8;
            const u32x4 wq = *(const u32x4*)src, wk = *(const u32x4*)(src + 512);
#pragma unroll
            for (int kind = 0; kind < 2; ++kind) { float v[8]; unpack8(kind ? wk : wq, v);
                float ss = 0.f;
#pragma unroll
                for (int j = 0; j < 8; ++j) ss += v[j] * v[j];
                ss += __builtin_bit_cast(float, __builtin_amdgcn_ds_bpermute((lane ^ 1) << 2, __builtin_bit_cast(int, ss)));
                ss += __builtin_bit_cast(float, __builtin_amdgcn_ds_bpermute((lane ^ 2) << 2, __builtin_bit_cast(int, ss)));
                ss += __builtin_bit_cast(float, __builtin_amdgcn_ds_bpermute((lane ^ 4) << 2, __builtin_bit_cast(int, ss)));
                const float rn = 1.0f / sqrtf(ss * (1.f / 64.f) + EPS);
                float a[8], o[8];
#pragma unroll
                for (int j = 0; j < 8; ++j) a[j] = v[j] * rn * (kind ? gk[j] : gq[j]);
#pragma unroll
                for (int j = 0; j < 8; ++j) { const float ap = __builtin_bit_cast(float, __builtin_amdgcn_ds_bpermute((lane ^ 4) << 2, __builtin_bit_cast(int, a[j])));
                    o[j] = a[j] * co[j] + sgn * ap * si[j]; }
                if (kind == 0) {
#pragma unroll
                    for (int j = 0; j < 8; ++j) o[j] *= C2;
                    bf16_t* dst = smp ? P.QS + ((size_t)b * QSROWS + t) * 512 + lane * 8 : P.Qp + (size_t)t * 512 + lane * 8;
                    *(u32x4*)dst = pack8(o);
                } else {
                    if (!smp) *(u32x4*)(P.Kp + (size_t)t * 512 + lane * 8) = pack8(o);
                    st8f(smp ? P.out + O_KS + (((size_t)l * DECB + b) * DECS + t) * 512 + lane * 8 : P.out + O_KP + ((size_t)l * SEQ + t) * 512 + lane * 8, o);
                }
            }
        }
#pragma unroll
        for (int k = 0; k < NR / 8; ++k) { const int idx = tid + 512 * k, r2 = idx >> 6, c8 = (idx & 63) * 8, t = t0 + r2;
            const u32x4 w = *(const u32x4*)(Z + (mb + t) * ZW + 2560 + c8);
            if (!smp) *(u32x4*)(P.Vp + (size_t)t * 512 + c8) = w;
            f32x4* od = (f32x4*)(smp ? P.out + O_VS + (((size_t)l * DECB + b) * DECS + t) * 512 + c8 : P.out + O_VP + ((size_t)l * SEQ + t) * 512 + c8);
            od[0] = (f32x4){__builtin_bit_cast(float, w.x << 16), __builtin_bit_cast(float, w.x & 0xffff0000u), __builtin_bit_cast(float, w.y << 16), __builtin_bit_cast(float, w.y & 0xffff0000u)};
            od[1] = (f32x4){__builtin_bit_cast(float, w.z << 16), __builtin_bit_cast(float, w.z & 0xffff0000u), __builtin_bit_cast(float, w.w << 16), __builtin_bit_cast(float, w.w & 0xffff0000u)}; }
    }
    __syncthreads();
}
}
#endif
#ifndef CPU_TEST_NEVER
namespace tailg {
#define TG_GAS __attribute__((address_space(1)))
typedef short bf16x8 __attribute__((ext_vector_type(8)));
typedef float f32x4 __attribute__((ext_vector_type(4)));
typedef unsigned u32x2 __attribute__((ext_vector_type(2)));
constexpr int TM = 32, TN = 64, NTILES = (MS / TM) * (D / TN);
template <int MODE> struct Tail {
    const bf16_t* A; const bf16_t* Bt;
    float* X; bf16_t* XB; float* SSP;
    bf16_t* OUT; const bf16_t* gate;
    int K, lda, ldb, ldg; float s; int pad;
};
template <int MODE> __device__ __forceinline__ void run(LAS unsigned char* lds, int tid, int bx, int G, const Tail<MODE>& t) {
    const int lane = tid & 63, w = __builtin_amdgcn_readfirstlane(tid >> 6), fr = lane & 15, fq = lane >> 4;
    LAS f32x4* RED = (LAS f32x4*)lds;
    const int nsteps = t.K / 32, per = nsteps / 8;
    for (int tile = bx; tile < NTILES; tile += G) {
        const int R0 = SEQ + (tile >> 4) * TM, C0 = (tile & 15) * TN;
        const bf16_t* ap = t.A + (size_t)(R0 + fr) * t.lda + fq * 8;
        const bf16_t* bp = t.Bt + (size_t)(C0 + fr) * t.ldb + fq * 8;
        f32x4 acc[2][4], tot[2][4];
#pragma unroll
        for (int m = 0; m < 2; ++m)
#pragma unroll
            for (int n = 0; n < 4; ++n) { acc[m][n] = (f32x4){0.f, 0.f, 0.f, 0.f}; tot[m][n] = (f32x4){0.f, 0.f, 0.f, 0.f}; }
        const int s0 = w * per;
        u32x2 xw0 = {0u, 0u};
        if (MODE == 0) xw0 = *(const TG_GAS u32x2*)(t.XB + (size_t)(R0 + (w >> 2) * 16 + fr) * D + C0 + (w & 3) * 16 + 4 * fq);
        for (int sb = 0; sb < per; sb += 6) {
            bf16x8 af[6][2], bf[6][4];
#pragma unroll
            for (int j = 0; j < 6; ++j) if (sb + j < per) { const int k0 = (s0 + sb + j) * 32;
#pragma unroll
                for (int m = 0; m < 2; ++m) af[j][m] = *(const TG_GAS bf16x8*)(ap + (size_t)(m * 16) * t.lda + k0);
#pragma unroll
                for (int n = 0; n < 4; ++n) bf[j][n] = *(const TG_GAS bf16x8*)(bp + (size_t)(n * 16) * t.ldb + k0); }
#pragma unroll
            for (int j = 0; j < 6; ++j) if (sb + j < per) {
#pragma unroll
                for (int m = 0; m < 2; ++m)
#pragma unroll
                    for (int n = 0; n < 4; ++n) acc[m][n] = __builtin_amdgcn_mfma_f32_16x16x32_bf16(bf[j][n], af[j][m], acc[m][n], 0, 0, 0);
                if (MODE == 1) {
                    const int st = s0 + sb + j, br = st < 8 ? 0 : st < 16 ? 1 : st < 24 ? 2 : 3, nx = st + 1, brn = nx < 8 ? 0 : nx < 16 ? 1 : nx < 24 ? 2 : 3;
                    if (brn != br || sb + j + 1 == per) {
#pragma unroll
                        for (int m = 0; m < 2; ++m)
#pragma unroll
                            for (int n = 0; n < 4; ++n) { const bf16_t* fp = t.gate + (size_t)(R0 + m * 16 + fr) * t.ldg + C0 + n * 16 + 4 * fq;
                                const u32x2 gw = *(const TG_GAS u32x2*)(fp + br * 1024); f32x4 g;
                                g[0] = __builtin_bit_cast(float, gw.x << 16); g[1] = __builtin_bit_cast(float, gw.x & 0xffff0000u); g[2] = __builtin_bit_cast(float, gw.y << 16); g[3] = __builtin_bit_cast(float, gw.y & 0xffff0000u);
                                tot[m][n] += g * acc[m][n]; acc[m][n] = (f32x4){0.f, 0.f, 0.f, 0.f}; }
                    }
                }
            }
        }
#pragma unroll
        for (int m = 0; m < 2; ++m)
#pragma unroll
            for (int n = 0; n < 4; ++n) RED[(w * 8 + m * 4 + n) * 64 + lane] = (MODE == 1) ? tot[m][n] : acc[m][n];
        __syncthreads();
        f32x4 v = RED[(0 * 8 + w) * 64 + lane];
#pragma unroll
        for (int w2 = 1; w2 < 8; ++w2) v += RED[(w2 * 8 + w) * 64 + lane];
        const size_t row = (size_t)(R0 + (w >> 2) * 16 + fr); const int col = C0 + (w & 3) * 16 + 4 * fq;
        if (MODE == 0) { const u32x2 xw = xw0;
            f32x4 xn; xn[0] = __builtin_bit_cast(float, xw.x << 16); xn[1] = __builtin_bit_cast(float, xw.x & 0xffff0000u); xn[2] = __builtin_bit_cast(float, xw.y << 16); xn[3] = __builtin_bit_cast(float, xw.y & 0xffff0000u);
            xn += v * t.s;
            if (t.X) *(TG_GAS f32x4*)(t.X + row * D + col) = xn;
            else { u32x2 o; o.x = f2bf(xn[0]) | (f2bf(xn[1]) << 16); o.y = f2bf(xn[2]) | (f2bf(xn[3]) << 16); *(TG_GAS u32x2*)(t.XB + row * D + col) = o; }
            float ss = (xn[0] * xn[0] + xn[1] * xn[1]) + (xn[2] * xn[2] + xn[3] * xn[3]);
            ss += __builtin_bit_cast(float, __builtin_amdgcn_ds_bpermute((lane ^ 16) << 2, __builtin_bit_cast(int, ss)));
            ss += __builtin_bit_cast(float, __builtin_amdgcn_ds_bpermute((lane ^ 32) << 2, __builtin_bit_cast(int, ss)));
            __syncthreads();
            LAS float* PS = (LAS float*)lds;
            if (fq == 0) PS[((w >> 2) * 16 + fr) * 4 + (w & 3)] = ss;
            __syncthreads();
            if (tid < TM) t.SSP[(size_t)(R0 - SEQ + tid) * 16 + (tile & 15)] = (PS[tid * 4] + PS[tid * 4 + 1]) + (PS[tid * 4 + 2] + PS[tid * 4 + 3]); }
        else { u32x2 o; o.x = f2bf(v[0]) | (f2bf(v[1]) << 16); o.y = f2bf(v[2]) | (f2bf(v[3]) << 16); *(TG_GAS u32x2*)(t.OUT + row * D + col) = o; }
        __syncthreads();
    }
}
}
#endif
#ifndef CPU_TEST
namespace sattn {
using attn_body::bf16x8; using attn_body::f32x16; using attn_body::s16x4; using attn_body::crow; using attn_body::vtr; using attn_body::lds_cptr; using attn_body::cvtpk_s;
typedef float f32x4 __attribute__((ext_vector_type(4)));
typedef float f32x2 __attribute__((ext_vector_type(2)));
typedef unsigned u32x4 __attribute__((ext_vector_type(4)));
#define SA_GAS __attribute__((address_space(1)))
constexpr int PART_LD = 132;
constexpr int N_ITEMS = DECB * 4 * 2;
__device__ __forceinline__ bf16x8 pack8f(const f32x4 a, const f32x4 c) { u32x4 w; w.x = cvtpk_s(a[0], a[1]); w.y = cvtpk_s(a[2], a[3]); w.z = cvtpk_s(c[0], c[1]); w.w = cvtpk_s(c[2], c[3]); return __builtin_bit_cast(bf16x8, w); }

__device__ __forceinline__ void item(int it, const float* __restrict__ ck, const float* __restrict__ cv, const float* __restrict__ knew, const float* __restrict__ vnew, const bf16_t* __restrict__ QS, float* PART,
                                     LAS unsigned char* lds, LAS float* ex, int tid) {
    const int lane = tid & 63, w = __builtin_amdgcn_readfirstlane(tid >> 6), r32 = lane & 31, hi = lane >> 5;
    const int b = it >> 3, h = (it >> 1) & 3, kh = it & 1;
    LAS float* EXM = ex; LAS float* wsf = ex + 512 + w * 32;
    bf16x8 qn[4]; const bool mp1 = (r32 >> 4) != 0;
    { const int q = r32 & 15, mp = r32 >> 4; const bf16_t* qrow = QS + ((size_t)b * QSROWS + q) * 512 + (2 * h + mp) * 64 + hi * 8;
#pragma unroll
      for (int j = 0; j < 4; ++j) qn[j] = *(const SA_GAS bf16x8*)(qrow + j * 16); }
    float m = -INFINITY, l = 0.f; f32x16 o[4];
#pragma unroll
    for (int d = 0; d < 4; ++d) o[d] = f32x16{};
    LAS unsigned char* vbuf = lds + w * 8192;
    const lds_cptr vp = (lds_cptr)vbuf + ((lane >> 4) & 1) * 32 + (lane & 3) * 8 + (4 * hi + ((lane & 15) >> 2)) * 64;
    const int nsteps = (kh == 1 && w == 7) ? 5 : 4;
    f32x4 ka[8], kc[8], va[2][4], vc[2][4];
#define SA_STEP_PTRS(ss, Kp_, Vp_, nv_) do { if ((ss) < 4) { const size_t k0_ = (size_t)b * PAST + 1024 * kh + 128 * w + 32 * (ss); Kp_ = ck + k0_ * 512 + h * 128; Vp_ = cv + k0_ * 512 + h * 128; nv_ = 32; } \
        else { Kp_ = knew + (size_t)b * DECS * 512 + h * 128; Vp_ = vnew + (size_t)b * DECS * 512 + h * 128; nv_ = DECS; } } while (0)
#define SA_LOAD_K(ss) do { const float* Kp_; const float* Vp_; int nv_; SA_STEP_PTRS(ss, Kp_, Vp_, nv_); (void)Vp_; int t_ = tid; asm volatile("" : "+v"(t_)); const int r_ = t_ & 31, h_ = (t_ >> 5) & 1; \
        const int krow_ = r_ < nv_ ? r_ : nv_ - 1; const SA_GAS f32x4* kp_ = (const SA_GAS f32x4*)(Kp_ + (size_t)krow_ * 512 + h_ * 8); \
        _Pragma("unroll") for (int j = 0; j < 8; ++j) { ka[j] = kp_[j * 4]; kc[j] = kp_[j * 4 + 1]; } } while (0)
#define SA_LOAD_V(ss) do { const float* Kp_; const float* Vp_; int nv_; SA_STEP_PTRS(ss, Kp_, Vp_, nv_); (void)Kp_; \
        int t_ = tid; asm volatile("" : "+v"(t_)); const int k16_ = (t_ & 63) >> 2, c4_ = t_ & 3; \
        _Pragma("unroll") for (int kq = 0; kq < 2; ++kq) { const int vr_ = kq * 16 + k16_, vrow_ = vr_ < nv_ ? vr_ : nv_ - 1; const SA_GAS f32x4* vpn_ = (const SA_GAS f32x4*)(Vp_ + (size_t)vrow_ * 512 + c4_ * 8); \
            _Pragma("unroll") for (int db = 0; db < 4; ++db) { va[kq][db] = vpn_[db * 8]; vc[kq][db] = vpn_[db * 8 + 1]; } } } while (0)
    SA_LOAD_K(0);
    for (int s = 0; s < nsteps; ++s) {
        const int nvalid = (s < 4) ? 32 : DECS;
        SA_LOAD_V(s);
        __builtin_amdgcn_sched_barrier(0);
        f32x16 S = f32x16{};
#pragma unroll
        for (int j = 0; j < 8; ++j) { const bf16x8 z8 = {0, 0, 0, 0, 0, 0, 0, 0}; const bf16x8 qb = ((j >= 4) == mp1) ? qn[j & 3] : z8; S = __builtin_amdgcn_mfma_f32_32x32x16_bf16(pack8f(ka[j], kc[j]), qb, S, 0, 0, 0); }
        if (nvalid < 32) {
#pragma unroll
            for (int r = 0; r < 16; ++r) if (crow(r, hi) >= nvalid) S[r] = -INFINITY; }
        float rm = S[0];
#pragma unroll
        for (int r = 1; r < 16; ++r) rm = fmaxf(rm, S[r]);
        { auto rr = __builtin_amdgcn_permlane32_swap(__float_as_uint(rm), __float_as_uint(rm), false, false); rm = fmaxf(__uint_as_float(rr[0]), __uint_as_float(rr[1])); }
        const float mn = fmaxf(m, rm), alpha = __builtin_amdgcn_exp2f(m - mn); m = mn;
        float ls = 0.f;
#pragma unroll
        for (int r = 0; r < 16; ++r) { S[r] = __builtin_amdgcn_exp2f(S[r] - mn); ls += S[r]; }
        l = l * alpha + ls;
        u32x4 pw0, pw1;
        pw0 = (u32x4){cvtpk_s(S[0], S[1]), cvtpk_s(S[2], S[3]), cvtpk_s(S[4], S[5]), cvtpk_s(S[6], S[7])};
        pw1 = (u32x4){cvtpk_s(S[8], S[9]), cvtpk_s(S[10], S[11]), cvtpk_s(S[12], S[13]), cvtpk_s(S[14], S[15])};
        if (hi == 0) wsf[r32] = alpha;
        __builtin_amdgcn_sched_barrier(0);
        if (s + 1 < nsteps) SA_LOAD_K(s + 1);
        __builtin_amdgcn_sched_barrier(0);
#pragma unroll
        for (int kq = 0; kq < 2; ++kq)
#pragma unroll
            for (int db = 0; db < 4; ++db) *(LAS bf16x8*)(vbuf + (db * 2 + kq) * 1024 + lane * 16) = pack8f(va[kq][db], vc[kq][db]);
        asm volatile("s_waitcnt lgkmcnt(0)" ::: "memory");
#pragma unroll
        for (int d = 0; d < 4; ++d)
#pragma unroll
            for (int r = 0; r < 16; ++r) o[d][r] *= wsf[crow(r, hi)];
#pragma unroll
        for (int kq = 0; kq < 2; ++kq)
#pragma unroll
            for (int db = 0; db < 4; ++db) { const s16x4 vlo = vtr(vp + (db * 2 + kq) * 1024), vhi = vtr(vp + (db * 2 + kq) * 1024 + 512);
                const bf16x8 vf = (bf16x8){vlo[0], vlo[1], vlo[2], vlo[3], vhi[0], vhi[1], vhi[2], vhi[3]};
                o[db] = __builtin_amdgcn_mfma_f32_32x32x16_bf16(__builtin_bit_cast(bf16x8, kq ? pw1 : pw0), vf, o[db], 0, 0, 0); }
        asm volatile("s_waitcnt lgkmcnt(0)" ::: "memory");
    }
#undef SA_STEP_PTRS
#undef SA_LOAD_K
#undef SA_LOAD_V
    int tidb = tid; asm volatile("" : "+v"(tidb)); const int laneb = tidb & 63, r32b = laneb & 31, hib = laneb >> 5;
    LAS float* wsfb = ex + 512 + w * 32;
    { auto rr = __builtin_amdgcn_permlane32_swap(__float_as_uint(l), __float_as_uint(l), false, false); l = __uint_as_float(rr[0]) + __uint_as_float(rr[1]); }
    if (hib == 0) { EXM[w * 64 + r32b] = m; EXM[w * 64 + 32 + r32b] = l; }
    __syncthreads();
    float Mx = EXM[r32b];
#pragma unroll
    for (int w2 = 1; w2 < 8; ++w2) Mx = fmaxf(Mx, EXM[w2 * 64 + r32b]);
    float Lx = 0.f;
#pragma unroll
    for (int w2 = 0; w2 < 8; ++w2) Lx += __builtin_amdgcn_exp2f(EXM[w2 * 64 + r32b] - Mx) * EXM[w2 * 64 + 32 + r32b];
    if (hib == 0) wsfb[r32b] = __builtin_amdgcn_exp2f(m - Mx);
    asm volatile("s_waitcnt lgkmcnt(0)" ::: "memory");
#pragma unroll
    for (int d = 0; d < 4; ++d)
#pragma unroll
        for (int r = 0; r < 16; ++r) o[d][r] *= wsfb[crow(r, hib)];
    __syncthreads();
    LAS float* OX = (LAS float*)lds;
#pragma unroll
    for (int d = 0; d < 4; ++d)
#pragma unroll
        for (int r = 0; r < 16; ++r) OX[(w * 32 + crow(r, hib)) * 128 + 32 * d + r32b] = o[d][r];
    __syncthreads();
#pragma unroll
    for (int k = 0; k < 4; ++k) { const int row = 4 * w + k; f32x2 acc = *(const LAS f32x2*)(OX + row * 128 + 2 * laneb);
#pragma unroll
        for (int w2 = 1; w2 < 8; ++w2) acc += *(const LAS f32x2*)(OX + (w2 * 32 + row) * 128 + 2 * laneb);
        *(SA_GAS f32x2*)(PART + ((size_t)it * 32 + row) * PART_LD + 2 * laneb) = acc; }
    if (hib == 0 && (r32b >> 2) == w) { SA_GAS float* pp = (SA_GAS float*)(PART + ((size_t)it * 32 + r32b) * PART_LD + 128); pp[0] = Mx; pp[1] = Lx; }
    __syncthreads();
}
__device__ __forceinline__ void post_sample(const float* PART, bf16_t* Ydst  , int b, int t, int h, float lam, float scale, const float* subln_g) {
    const SA_GAS float* p00 = (const SA_GAS float*)(PART + ((size_t)(((b * 4 + h) * 2 + 0) * 32) + t) * PART_LD);
    const SA_GAS float* p01 = p00 + 16 * PART_LD; const SA_GAS float* p10 = p00 + 32 * PART_LD; const SA_GAS float* p11 = p10 + 16 * PART_LD;
    float a0, a1, c0, c1;
    { const float M0 = p00[128], L0 = p00[129], M1 = p10[128], L1 = p10[129], Mx = fmaxf(M0, M1), f0 = __builtin_amdgcn_exp2f(M0 - Mx), f1 = __builtin_amdgcn_exp2f(M1 - Mx), inv = 1.0f / (f0 * L0 + f1 * L1); a0 = f0 * inv; a1 = f1 * inv; }
    { const float M0 = p01[128], L0 = p01[129], M1 = p11[128], L1 = p11[129], Mx = fmaxf(M0, M1), f0 = __builtin_amdgcn_exp2f(M0 - Mx), f1 = __builtin_amdgcn_exp2f(M1 - Mx), inv = 1.0f / (f0 * L0 + f1 * L1); c0 = f0 * inv; c1 = f1 * inv; }
    float ss = 0.f;
    for (int i = 0; i < 32; ++i) { const f32x4 x0 = *(const SA_GAS f32x4*)(p00 + 4 * i), x1 = *(const SA_GAS f32x4*)(p10 + 4 * i), y0 = *(const SA_GAS f32x4*)(p01 + 4 * i), y1 = *(const SA_GAS f32x4*)(p11 + 4 * i);
        const f32x4 ov = (x0 * a0 + x1 * a1) - lam * (y0 * c0 + y1 * c1); ss += (ov[0] * ov[0] + ov[1] * ov[1]) + (ov[2] * ov[2] + ov[3] * ov[3]); }
    const float rn = scale / sqrtf(ss * (1.f / 128.f) + EPS);
    for (int i = 0; i < 16; ++i) { float ob[8];
#pragma unroll
        for (int hh = 0; hh < 2; ++hh) { const int i4 = 2 * i + hh; const f32x4 x0 = *(const SA_GAS f32x4*)(p00 + 4 * i4), x1 = *(const SA_GAS f32x4*)(p10 + 4 * i4), y0 = *(const SA_GAS f32x4*)(p01 + 4 * i4), y1 = *(const SA_GAS f32x4*)(p11 + 4 * i4);
            const f32x4 ov = (x0 * a0 + x1 * a1) - lam * (y0 * c0 + y1 * c1);
#pragma unroll
            for (int j = 0; j < 4; ++j) ob[4 * hh + j] = ov[j] * rn * subln_g[8 * i + 4 * hh + j]; }
        st_bf16x8(Ydst + 8 * i, ob); }
}
__device__ __forceinline__ void post_sample_wave(const float* PART, bf16_t* Ydst  , int b, int t, int h, float lam, float scale, const float* subln_g, int lane) {
    const SA_GAS float* p00 = (const SA_GAS float*)(PART + ((size_t)(((b * 4 + h) * 2 + 0) * 32) + t) * PART_LD);
    const SA_GAS float* p01 = p00 + 16 * PART_LD; const SA_GAS float* p10 = p00 + 32 * PART_LD; const SA_GAS float* p11 = p10 + 16 * PART_LD;
    const f32x2 x0 = *(const SA_GAS f32x2*)(p00 + 2 * lane), x1 = *(const SA_GAS f32x2*)(p10 + 2 * lane), y0 = *(const SA_GAS f32x2*)(p01 + 2 * lane), y1 = *(const SA_GAS f32x2*)(p11 + 2 * lane);
    const f32x2 ml00 = *(const SA_GAS f32x2*)(p00 + 128), ml10 = *(const SA_GAS f32x2*)(p10 + 128), ml01 = *(const SA_GAS f32x2*)(p01 + 128), ml11 = *(const SA_GAS f32x2*)(p11 + 128);
    const f32x2 sg = *(const SA_GAS f32x2*)(subln_g + 2 * lane);
    float a0, a1, c0, c1;
    { const float Mx = fmaxf(ml00[0], ml10[0]), f0 = __builtin_amdgcn_exp2f(ml00[0] - Mx), f1 = __builtin_amdgcn_exp2f(ml10[0] - Mx), inv = 1.0f / (f0 * ml00[1] + f1 * ml10[1]); a0 = f0 * inv; a1 = f1 * inv; }
    { const float Mx = fmaxf(ml01[0], ml11[0]), f0 = __builtin_amdgcn_exp2f(ml01[0] - Mx), f1 = __builtin_amdgcn_exp2f(ml11[0] - Mx), inv = 1.0f / (f0 * ml01[1] + f1 * ml11[1]); c0 = f0 * inv; c1 = f1 * inv; }
    const f32x2 ov = (x0 * a0 + x1 * a1) - lam * (y0 * c0 + y1 * c1);
    const float ss = mixf::wsum(ov[0] * ov[0] + ov[1] * ov[1], lane);
    const float rn = scale / sqrtf(ss * (1.f / 128.f) + EPS);
    const unsigned w = f2bf(ov[0] * rn * sg[0]) | (f2bf(ov[1] * rn * sg[1]) << 16);
    *(SA_GAS unsigned*)(Ydst + 2 * lane) = w;
}
}
#endif
constexpr int NWAVES = 8;
static_assert(M % 256 == 0 && SEQ % 512 == 0 && PAST % 64 == 0 && KSROWS % 128 == 0, "shape assumptions of the GEMM / attention bodies");
constexpr size_t MiB = 1u << 20;
constexpr size_t alup(size_t x) { return (x + MiB - 1) / MiB * MiB; }
constexpr size_t LW_GU1 = 0, LW_D1 = LW_GU1 + (size_t)NGU * D * 2, LW_IN = LW_D1 + (size_t)D * FF * 2, LW_P = LW_IN + (size_t)ZW * D * 2, LW_O = LW_P + (size_t)D * YW * 2,
                 LW_GU2 = LW_O + (size_t)D * D * 2, LW_D2 = LW_GU2 + (size_t)NGU * D * 2, LW_BYTES = LW_D2 + (size_t)D * FF * 2;
constexpr size_t WS_CTL = 0, CTL_ZERO_BYTES = 1 * MiB;
constexpr size_t WS_ROPE = 1 * MiB;
constexpr size_t WS_PWT = alup(WS_ROPE + (size_t)ROPE_ROWS * 64 * 4);
constexpr size_t WS_W = alup(WS_PWT + (size_t)DEPTH * 256 * 64 * 2);
constexpr size_t WS_XN = alup(WS_W + (size_t)DEPTH * LW_BYTES);
constexpr size_t WS_ACT = alup(WS_XN + (size_t)M * D * 2);
constexpr size_t WS_Z = alup(WS_ACT + (size_t)M * FF * 2);
constexpr size_t WS_Y = alup(WS_Z + (size_t)M * ZW * 2);
constexpr size_t WS_QP = alup(WS_Y + (size_t)M * YW * 2);
constexpr size_t WS_KP = alup(WS_QP + (size_t)SEQ * 512 * 2);
constexpr size_t WS_VP = alup(WS_KP + (size_t)SEQ * 512 * 2);
constexpr size_t WS_OB = alup(WS_VP + (size_t)SEQ * 512 * 2);
constexpr size_t WS_QS = alup(WS_OB + (size_t)SEQ * 1024 * 2);
constexpr size_t WS_KS = alup(WS_QS + (size_t)DECB * QSROWS * 512 * 2);
constexpr size_t WS_VS = alup(WS_KS + (size_t)DECB * KSROWS * 512 * 2);
constexpr size_t WS_OS = alup(WS_VS + (size_t)DECB * KSROWS * 512 * 2);
constexpr size_t WS_MG = alup(WS_OS + (size_t)DECB * QSROWS * 1024 * 2);
constexpr size_t WS_MRG = alup(WS_MG + (size_t)M * D * 4);
constexpr size_t WS_SSP = alup(WS_MRG + (size_t)M * D * 2);
constexpr size_t WS_SS4 = alup(WS_SSP + (size_t)M * 16 * 4);
constexpr size_t WS_PART = alup(WS_SS4 + (size_t)SEQ * 4 * 4);
constexpr size_t WS_FAC = alup(WS_PART + (size_t)DECB * 8 * 32 * 132 * 4);
constexpr size_t WS_END = alup(WS_FAC + (size_t)(SEQ / 256) * 4 * 4 * 131072);
constexpr int CW_TMO = 0, CW_BAR = 4096;

constexpr int RING_OFF = 0, RING_BYTES = 131072;
constexpr int LDSCTL_OFF = RING_BYTES, MISC_OFF = LDSCTL_OFF + 320;
constexpr int LDS_BYTES = 147456;

typedef unsigned v4u __attribute__((ext_vector_type(4)));
typedef unsigned v2u __attribute__((ext_vector_type(2)));
typedef float f32x4 __attribute__((ext_vector_type(4)));
#define LDS_WAIT() asm volatile("s_waitcnt lgkmcnt(0)" ::: "memory")
#define VM_WAIT() asm volatile("s_waitcnt vmcnt(0)" ::: "memory")
__device__ __forceinline__ unsigned pk2(float lo, float hi) { return f2bf(lo) | (f2bf(hi) << 16); }

__device__ __forceinline__ int tid_now(int wv) { int z = 0; asm volatile("" : "+v"(z)); return wv * 64 + (int)__builtin_amdgcn_mbcnt_hi(~0u, __builtin_amdgcn_mbcnt_lo(~0u, (unsigned)z)); }
#define XB_TMO      128
#define XB_XCNT(j)  (256  + 64 * (j))
#define XB_XSUB(j)  (1280 + 64 * (j))
#define XB_XGEN(j)  (2304 + 64 * (j))
#define XB_TOP      3328
#define XB_TOPGEN   3392
#define XCD_BAR_WORDS 3456
#define XB_SPIN_CAP (1u << 18)
__device__ __forceinline__ unsigned xb_ld(unsigned* p)              { return __hip_atomic_load(p, __ATOMIC_RELAXED, __HIP_MEMORY_SCOPE_AGENT); }
__device__ __forceinline__ unsigned xb_add(unsigned* p, unsigned v) { return __hip_atomic_fetch_add(p, v, __ATOMIC_RELAXED, __HIP_MEMORY_SCOPE_AGENT); }
__device__ __forceinline__ unsigned xb_xcc_id() { return (unsigned)__builtin_amdgcn_s_getreg((3 << 11) | 20) & 0xFu; }
#define XB_SPIN(cond, bar) do { unsigned _sp = 0; while (cond) { __builtin_amdgcn_s_sleep(1); \
    if ((++_sp & 255u) == 0u) { if (xb_ld(&(bar)[XB_TMO])) break; if (_sp > XB_SPIN_CAP) { atomicAdd(&(bar)[XB_TMO], 1u); break; } } } } while (0)
struct XcdBarrier { unsigned* bar; unsigned x; volatile LAS unsigned* st; };
__device__ __forceinline__ XcdBarrier xcd_barrier_post(unsigned* bar, volatile LAS unsigned* st, int wv) {
    XcdBarrier b; b.bar = bar; b.x = xb_xcc_id(); b.st = st;
    if (tid_now(wv) == 0) (void)xb_add(&bar[XB_XCNT(b.x)], 1u);
    return b;
}
__device__ __forceinline__ void xcd_barrier_complete(unsigned* bar, unsigned x, unsigned& nloc, unsigned& nx) {
    const unsigned G = gridDim.x * gridDim.y * gridDim.z;
    unsigned sum, cnt, mine, sp = 0u;
    for (;;) {
        sum = 0u; cnt = 0u; mine = 0u;
#pragma unroll
        for (unsigned j = 0; j < 16; ++j) { const unsigned c = xb_ld(&bar[XB_XCNT(j)]); sum += c; cnt += (c > 0u) ? 1u : 0u; mine = (j == x) ? c : mine; }
        if (sum == G) break;
        __builtin_amdgcn_s_sleep(1);
        if ((++sp & 255u) == 0u) { if (xb_ld(&bar[XB_TMO])) break; if (sp > XB_SPIN_CAP) { atomicAdd(&bar[XB_TMO], 1u); break; } }
    }
    nloc = mine > 0u ? mine : 1u; nx = cnt > 0u ? cnt : 1u;
}
__device__ __forceinline__ void xcd_barrier(const XcdBarrier& b, int wv) {
    asm volatile("s_waitcnt vmcnt(0)" ::: "memory");
    __syncthreads();
    if (tid_now(wv) == 0) {
        unsigned* bar = b.bar; asm volatile("" : "+s"(bar));
        unsigned bx_ = b.x; asm volatile("" : "+s"(bx_));
        __builtin_amdgcn_s_waitcnt(0);
        unsigned nloc = b.st[0], nx = b.st[1];
        if (nloc == 0u) { xcd_barrier_complete(bar, bx_, nloc, nx); b.st[0] = nloc; b.st[1] = nx; }
        const unsigned old = xb_add(&bar[XB_XSUB(bx_)], 1u);
        const unsigned gen = old / nloc;
        if (old + 1u == (gen + 1u) * nloc) {
            __builtin_amdgcn_fence(__ATOMIC_RELEASE, "agent");
            asm volatile("s_waitcnt vmcnt(0)" ::: "memory");
            const unsigned og = xb_add(&bar[XB_TOP], 1u);
            const unsigned tg = og / nx;
            if (og + 1u == (tg + 1u) * nx) xb_add(&bar[XB_TOPGEN], 1u);
            else XB_SPIN(xb_ld(&bar[XB_TOPGEN]) == tg, bar);
            __builtin_amdgcn_fence(__ATOMIC_ACQUIRE, "agent");
            xb_add(&bar[XB_XGEN(bx_)], 1u);
            asm volatile("s_waitcnt vmcnt(0)" ::: "memory");
        } else {
            XB_SPIN(xb_ld(&bar[XB_XGEN(bx_)]) == gen, bar);
            __builtin_amdgcn_fence(__ATOMIC_ACQUIRE, "agent");
            asm volatile("s_waitcnt vmcnt(0)" ::: "memory");
        }
    }
    __syncthreads();
}

__device__ __forceinline__ float wave_sum(float v, int lane) {
#pragma unroll
    for (int o = 1; o < 64; o <<= 1) v += __builtin_bit_cast(float, __builtin_amdgcn_ds_bpermute((lane ^ o) << 2, __builtin_bit_cast(int, v)));
    return v;
}
__device__ __forceinline__ void transpose_item(const float* W, int K, int N, bf16_t* WT, int ldk, int koff, int mode, LAS float* scr, int item, int lane, const float* gk = nullptr) {
    const int nblk = N / 32, kb = item / nblk, nb = item % nblk, k0 = 64 * kb, n0 = 32 * nb;
    const int drow0 = (mode == 0 || mode == 3) ? n0 : ((n0 >> 7) * 256 + (mode - 1) * 128 + (n0 & 127));
    float wv_[32];
#pragma unroll
    for (int i = 0; i < 32; ++i) wv_[i] = W[(size_t)(k0 + 2 * i + (lane >> 5)) * N + n0 + (lane & 31)];
#pragma unroll
    for (int i = 0; i < 32; ++i) scr[(2 * i + (lane >> 5)) * 33 + (lane & 31)] = wv_[i];
    LDS_WAIT(); asm volatile("" ::: "memory");
    const int c = lane & 7;
    f32x4 ga = {1.f, 1.f, 1.f, 1.f}, gb = {1.f, 1.f, 1.f, 1.f}; if (gk) { ga = *(const f32x4*)(gk + k0 + 8 * c); gb = *(const f32x4*)(gk + k0 + 8 * c + 4); }
#pragma unroll
    for (int j = 0; j < 4; ++j) { const int n = (lane >> 3) + 8 * j; const LAS float* s = scr + (8 * c) * 33 + n;
        v4u o; o.x = pk2(s[0 * 33] * ga[0], s[1 * 33] * ga[1]); o.y = pk2(s[2 * 33] * ga[2], s[3 * 33] * ga[3]); o.z = pk2(s[4 * 33] * gb[0], s[5 * 33] * gb[1]); o.w = pk2(s[6 * 33] * gb[2], s[7 * 33] * gb[3]);
        int drow = drow0 + n;
        if (mode == 3 && n0 >= 3072) { const int gi = n0 + n - 3072, br = gi >> 10, oc = gi & 1023, r6 = oc & 63; drow = (12 + (oc >> 6)) * 256 + 128 * (br >> 1) + 32 * (r6 >> 4) + 8 * ((r6 & 15) >> 2) + 4 * (br & 1) + (oc & 3); }
        *(v4u*)(WT + (size_t)drow * ldk + koff + k0 + 8 * c) = o; }
    LDS_WAIT(); asm volatile("" ::: "memory");
}
__device__ __forceinline__ void sincos_d(double a, float& s_out, float& c_out) {
    const double k = rint(a * 0.63661977236758134308);
    double r = fma(-k, 1.57079632679489655800e+00, a); r = fma(-k, 6.12323399573676603587e-17, r);
    const double r2 = r * r;
    const double sp = r * (1.0 + r2 * (-1.0 / 6 + r2 * (1.0 / 120 + r2 * (-1.0 / 5040 + r2 * (1.0 / 362880 + r2 * (-1.0 / 39916800 + r2 * (1.0 / 6227020800.0)))))));
    const double cp = 1.0 + r2 * (-0.5 + r2 * (1.0 / 24 + r2 * (-1.0 / 720 + r2 * (1.0 / 40320 + r2 * (-1.0 / 3628800 + r2 * (1.0 / 479001600 + r2 * (-1.0 / 87178291200.0)))))));
    const int q = (int)((long long)k & 3);
    const double s = (q == 0) ? sp : (q == 1) ? cp : (q == 2) ? -sp : -cp;
    const double c = (q == 0) ? cp : (q == 1) ? -sp : (q == 2) ? -cp : sp;
    s_out = (float)s; c_out = (float)c;
}

struct Args { const float* in[36]; float* out; unsigned char* ws; float inv_freq[32]; float lam_init[4]; };

#define LAUNDER_V(x) asm volatile("" : "+v"(x))
#define LAUNDER_S(x) asm volatile("" : "+s"(x))
struct Ctx { LAS unsigned char* lds; int tid, lane, wave, bx, vcu, G, gtid, GT; };
__device__ __forceinline__ Ctx mkctx(LAS unsigned char* lds, int wv) {
    Ctx c; c.lds = lds; int tid = tid_now(wv); LAUNDER_V(tid); int bx = blockIdx.x; LAUNDER_S(bx); int G = gridDim.x; LAUNDER_S(G);
    c.tid = tid; c.lane = tid & 63; c.wave = __builtin_amdgcn_readfirstlane(tid >> 6); c.bx = bx; c.G = G; c.vcu = (G % 8 == 0) ? (bx % 8) * (G / 8) + bx / 8 : bx;
    c.gtid = bx * (NWAVES * 64) + tid; c.GT = G * NWAVES * 64; return c;
}
#define GAS __attribute__((address_space(1)))
template <class T> __device__ __forceinline__ T* lp(T* q) { asm volatile("" : "+s"(q)); return (T*)(GAS T*)q; }
__device__ __forceinline__ const float* inptr(LAS unsigned char* lds, int i) {
    int ii = i; LAUNDER_S(ii);
    const LAS unsigned* t = (const LAS unsigned*)(lds + LDSCTL_OFF) + 2 * ii; const unsigned lo = __builtin_amdgcn_readfirstlane(t[0]), hi = __builtin_amdgcn_readfirstlane(t[1]);
    return (const float*)(GAS const float*)(((unsigned long long)hi << 32) | lo);
}

__device__ __forceinline__ void norm_phase(LAS unsigned char* lds, int wv, const float* X, const float* g, bf16_t* XN) {
    const Ctx c = mkctx(lds, wv);
    const int gw = c.vcu * NWAVES + c.wave, NGW = c.G * NWAVES;
    f32x4 gv[4];
#pragma unroll
    for (int j = 0; j < 4; ++j) gv[j] = *((const f32x4*)g + c.lane + 64 * j);
    for (int m = gw; m < M; m += NGW) {
        const f32x4* xr = (const f32x4*)(X + (size_t)m * D) + c.lane;
        f32x4 v[4]; float s = 0.f;
#pragma unroll
        for (int j = 0; j < 4; ++j) { v[j] = xr[64 * j]; s += (v[j].x * v[j].x + v[j].y * v[j].y) + (v[j].z * v[j].z + v[j].w * v[j].w); }
        const float r = 1.0f / sqrtf(wave_sum(s, c.lane) * (1.f / D) + EPS);
        v2u* o8 = (v2u*)(XN + (size_t)m * D) + c.lane;
#pragma unroll
        for (int j = 0; j < 4; ++j) { v2u w; w.x = pk2(v[j].x * r * gv[j].x, v[j].y * r * gv[j].y); w.y = pk2(v[j].z * r * gv[j].z, v[j].w * r * gv[j].w); o8[64 * j] = w; }
    }
}

constexpr int I_G = (D / 64) * (FF / 32), I_D = (FF / 64) * (D / 32), I_IN = (D / 64) * (ZW / 32), I_PA = (256 / 64) * (D / 32), I_PD = (512 / 64) * (D / 32), I_O = (D / 64) * (D / 32);
constexpr int I_LAYER = 6 * I_G + I_IN + 3 * I_PA + I_PD + I_O; static_assert(I_G == I_D, "item counts");
__device__ __forceinline__ void weight_item(LAS unsigned char* lds, unsigned char* ws, LAS float* scr, int l, int r, int lane) {
    unsigned char* wl = ws + WS_W + (size_t)l * LW_BYTES;
    if (r < I_G) { transpose_item(inptr(lds, 8) + (size_t)l * D * FF, D, FF, (bf16_t*)(wl + LW_GU1), D, 0, 1, scr, r, lane, inptr(lds, 7) + (size_t)l * D); return; } r -= I_G;
    if (r < I_G) { transpose_item(inptr(lds, 9) + (size_t)l * D * FF, D, FF, (bf16_t*)(wl + LW_GU1), D, 0, 2, scr, r, lane, inptr(lds, 7) + (size_t)l * D); return; } r -= I_G;
    if (r < I_D) { transpose_item(inptr(lds, 10) + (size_t)l * FF * D, FF, D, (bf16_t*)(wl + LW_D1), FF, 0, 0, scr, r, lane); return; } r -= I_D;
    if (r < I_IN) { transpose_item(inptr(lds, 12) + (size_t)l * D * ZW, D, ZW, (bf16_t*)(wl + LW_IN), D, 0, 3, scr, r, lane, inptr(lds, 11) + (size_t)l * D); return; } r -= I_IN;
    if (r < I_PA) { transpose_item(inptr(lds, 27) + (size_t)l * 256 * D, 256, D, (bf16_t*)(wl + LW_P), YW, 0, 0, scr, r, lane); return; } r -= I_PA;
    if (r < I_PA) { transpose_item(inptr(lds, 28) + (size_t)l * 256 * D, 256, D, (bf16_t*)(wl + LW_P), YW, 256, 0, scr, r, lane); return; } r -= I_PA;
    if (r < I_PA) { transpose_item(inptr(lds, 29) + (size_t)l * 256 * D, 256, D, (bf16_t*)(wl + LW_P), YW, 512, 0, scr, r, lane); return; } r -= I_PA;
    if (r < I_PD) { transpose_item(inptr(lds, 30) + (size_t)l * 512 * D, 512, D, (bf16_t*)(wl + LW_P), YW, 768, 0, scr, r, lane); return; } r -= I_PD;
    if (r < I_O) { transpose_item(inptr(lds, 31) + (size_t)l * D * D, D, D, (bf16_t*)(wl + LW_O), D, 0, 0, scr, r, lane); return; } r -= I_O;
    if (r < I_G) { transpose_item(inptr(lds, 33) + (size_t)l * D * FF, D, FF, (bf16_t*)(wl + LW_GU2), D, 0, 1, scr, r, lane, inptr(lds, 32) + (size_t)l * D); return; } r -= I_G;
    if (r < I_G) { transpose_item(inptr(lds, 34) + (size_t)l * D * FF, D, FF, (bf16_t*)(wl + LW_GU2), D, 0, 2, scr, r, lane, inptr(lds, 32) + (size_t)l * D); return; } r -= I_G;
    transpose_item(inptr(lds, 35) + (size_t)l * FF * D, FF, D, (bf16_t*)(wl + LW_D2), FF, 0, 0, scr, r, lane);
}
constexpr int NU_GU = (M / 256) * (NGU / 256), NU_IN = (M / 256) * (ZW / 256);
constexpr int IDLE_GU = 256 - NU_GU % 256, IDLE_IN = 256 - NU_IN % 256, IDLE_ALL = 2 * IDLE_GU + IDLE_IN;
constexpr int WS1 = (int)((long)I_LAYER * IDLE_GU / IDLE_ALL), WS2 = WS1 + (int)((long)I_LAYER * IDLE_IN / IDLE_ALL);
static_assert(NU_GU % 256 != 0 && NU_IN % 256 != 0 && WS2 < I_LAYER, "idle-slot weight conversion needs idle workgroups in those phases");
__device__ __forceinline__ void weight_slice(LAS unsigned char* lds, int wv, unsigned char* ws, int l, int beg, int end, int nbusy) {
    const Ctx c = mkctx(lds, wv);
    if (c.G != 256 || l >= DEPTH || c.bx < nbusy) return;
    LAS float* scr = (LAS float*)(lds + RING_OFF + c.wave * 16384);
    const int nset = 256 - nbusy, iset = c.bx - nbusy;
    for (int it = beg + iset * NWAVES + c.wave; it < end; it += nset * NWAVES) weight_item(lds, ws, scr, l, it, c.lane);
}

__device__ __forceinline__ void prologue_phase(LAS unsigned char* lds, int wv, unsigned char* ws, float* X, const Args& args) {
    const Ctx c = mkctx(lds, wv);
    LAS float* scr = (LAS float*)(lds + RING_OFF + c.wave * 16384);
    const int gw = c.vcu * NWAVES + c.wave, NGW = c.G * NWAVES;
    { const int nl = (c.G == 256) ? 1 : DEPTH;
      for (int it = gw; it < nl * I_LAYER; it += NGW) weight_item(lds, ws, scr, it / I_LAYER, it % I_LAYER, c.lane); }
    { const float* s0 = inptr(lds, 0); const float* s1 = inptr(lds, 1); bf16_t* XB = (bf16_t*)(ws + WS_XN); float* SSP = (float*)(ws + WS_SSP); float* SS4 = (float*)(ws + WS_SS4);
      for (int m = gw; m < M; m += NGW) { const f32x4* xr = (const f32x4*)((m < SEQ) ? s0 + (size_t)m * D : s1 + (size_t)(m - SEQ) * D) + c.lane;
          v2u* o8 = (v2u*)(XB + (size_t)m * D) + c.lane; float ss = 0.f;
#pragma unroll
          for (int j = 0; j < 4; ++j) { const f32x4 v = xr[64 * j]; v2u w; w.x = pk2(v.x, v.y); w.y = pk2(v.z, v.w); o8[64 * j] = w; ss += (v.x * v.x + v.y * v.y) + (v.z * v.z + v.w * v.w); }
          ss = wave_sum(ss, c.lane);
          if (m < SEQ) { if (c.lane < 4) SS4[(size_t)m * 4 + c.lane] = (c.lane == 0) ? ss : 0.f; } else if (c.lane < 16) SSP[(size_t)(m - SEQ) * 16 + c.lane] = (c.lane == 0) ? ss : 0.f; } }
    { bf16_t* QS = (bf16_t*)(ws + WS_QS); v4u z = {0u, 0u, 0u, 0u};
      for (size_t i = c.gtid; i < (size_t)DECB * QSROWS * 512 / 8; i += c.GT) ((v4u*)QS)[i] = z;
    }
    { bf16_t* wt = (bf16_t*)(ws + WS_PWT); const float* pw = inptr(lds, 13);
      for (int i = c.gtid; i < DEPTH * 4 * 64 * 64; i += c.GT) { const int k = i & 63, n = (i >> 6) & 63, g = (i >> 12) & 3, l = i >> 14; wt[i] = (bf16_t)f2bf(pw[(((size_t)l * 4 + g) * 64 + k) * 64 + n]); } }
    { float* rope = (float*)(ws + WS_ROPE);
      for (int i = c.gtid; i < ROPE_ROWS * 32; i += c.GT) { const int p = i >> 5, j = i & 31; const float ang = (float)p * args.inv_freq[j]; float s, co; sincos_d((double)ang, s, co); rope[(size_t)p * 64 + j] = co; rope[(size_t)p * 64 + 32 + j] = s; } }
}

__device__ __forceinline__ void mix_phase(LAS unsigned char* lds, int wv, unsigned char* ws, float* out, int l) {
    const Ctx c = mkctx(lds, wv);
    MixP P; P.Z = (const bf16_t*)(ws + WS_Z); P.Y = (bf16_t*)(ws + WS_Y); P.Qp = (bf16_t*)(ws + WS_QP); P.Kp = (bf16_t*)(ws + WS_KP); P.Vp = (bf16_t*)(ws + WS_VP);
    P.QS = (bf16_t*)(ws + WS_QS); P.KS = (bf16_t*)(ws + WS_KS); P.VS = (bf16_t*)(ws + WS_VS); P.out = out;
    P.st_pool = inptr(lds, 4) + (size_t)l * DECB * 15 * 256; P.st_sconv = inptr(lds, 5) + (size_t)l * DECB * 2 * 256; P.st_cconv = inptr(lds, 6) + (size_t)l * DECB * 30 * 256;
    P.pool_w = inptr(lds, 13) + (size_t)l * 4 * 64 * 64; P.pool_scale = inptr(lds, 14) + (size_t)l * 256; P.sconv_w = inptr(lds, 15) + (size_t)l * 3 * 256; P.cconv_w = inptr(lds, 16) + (size_t)l * 31 * 256;
    P.cconv_b = inptr(lds, 17) + (size_t)l * 256; P.ln_g = inptr(lds, 18) + (size_t)l * 256; P.ln_b = inptr(lds, 19) + (size_t)l * 256; P.qg = inptr(lds, 20) + (size_t)l * 64; P.kg = inptr(lds, 21) + (size_t)l * 64;
    P.rope = (const float*)(ws + WS_ROPE); P.layer = l;
    const bf16_t* WTg = (const bf16_t*)(ws + WS_PWT) + (size_t)l * 256 * 64;
    for (int it = c.bx; it < N_MIX_ITEMS; it += c.G) { const MixItem I = mix_item(it);
        int tl = c.tid; LAUNDER_V(tl);
        if (I.nrows == 32) mixf::item<32>(P, I, WTg, tl, lds + RING_OFF); else mixf::item<16>(P, I, WTg, tl, lds + RING_OFF); }
}

__device__ __forceinline__ void attn_phase(unsigned char* lds_generic, LAS unsigned char* lds, int wv, unsigned char* ws, float* out, int l) {
    const Ctx c = mkctx(lds, wv);
    typedef attn_body::bf16 abf;
    constexpr int NQB = SEQ / 256, NPAIR = 8 * (NQB / 2);
    const abf* QP = (const abf*)(ws + WS_QP); const abf* KP = (const abf*)(ws + WS_KP); const abf* VP = (const abf*)(ws + WS_VP); abf* OB = (abf*)(ws + WS_OB);
    int p = c.vcu, half = 0;
    while (p < NPAIR) { const int map = p / (NQB / 2), s = p % (NQB / 2), qb = half ? NQB - 1 - s : s;
        attn_body::attn_unit<8>(QP + (size_t)qb * 256 * 512 + map * 64, KP + map * 64, VP + (map >> 1) * 128, OB + (size_t)qb * 256 * 1024 + map * 128, 4 * qb + 4, 0, (char*)lds_generic + RING_OFF, c.tid);
        if (half) { p += c.G; half = 0; } else half = 1; }
    const float* ck = inptr(lds, 2) + (size_t)l * DECB * PAST * 512; const float* cv = inptr(lds, 3) + (size_t)l * DECB * PAST * 512;
    const float* knew = out + O_KS + (size_t)l * MS * 512; const float* vnew = out + O_VS + (size_t)l * MS * 512;
    for (int it = c.vcu; it < sattn::N_ITEMS; it += c.G)
        sattn::item(it, ck, cv, knew, vnew, (const bf16_t*)(ws + WS_QS), (float*)(ws + WS_PART), lds + RING_OFF, (LAS float*)(lds + LDSCTL_OFF + 1024), c.tid);
}

__device__ __forceinline__ void post_phase(LAS unsigned char* lds, int wv, unsigned char* ws, int l) {
    const Ctx c = mkctx(lds, wv);
    const LAS float* LAMF = (const LAS float*)(lds + MISC_OFF + 64);
    const float lam = LAMF[l], sc = LAMF[4 + l]; const float* sg = inptr(lds, 26) + (size_t)l * 128;
    const bf16_t* OB = (const bf16_t*)(ws + WS_OB); bf16_t* Y = (bf16_t*)(ws + WS_Y);
    { const int gw = c.vcu * NWAVES + c.wave, NGW = c.G * NWAVES, lane = c.lane, odd = (lane >> 3) & 1, hh = lane >> 4, eo = 16 * (lane & 7) + 8 * odd;
      const f32x4 ga = *(const GAS f32x4*)(sg + eo), gb = *(const GAS f32x4*)(sg + eo + 4);
      for (int m = gw; m < SEQ; m += NGW) { const GAS v4u* src = (const GAS v4u*)(OB + (size_t)m * 1024) + 2 * lane; const v4u w0 = src[0], w1 = src[1];
          float v[16];
          v[0] = __builtin_bit_cast(float, w0.x << 16); v[1] = __builtin_bit_cast(float, w0.x & 0xffff0000u); v[2] = __builtin_bit_cast(float, w0.y << 16); v[3] = __builtin_bit_cast(float, w0.y & 0xffff0000u);
          v[4] = __builtin_bit_cast(float, w0.z << 16); v[5] = __builtin_bit_cast(float, w0.z & 0xffff0000u); v[6] = __builtin_bit_cast(float, w0.w << 16); v[7] = __builtin_bit_cast(float, w0.w & 0xffff0000u);
          v[8] = __builtin_bit_cast(float, w1.x << 16); v[9] = __builtin_bit_cast(float, w1.x & 0xffff0000u); v[10] = __builtin_bit_cast(float, w1.y << 16); v[11] = __builtin_bit_cast(float, w1.y & 0xffff0000u);
          v[12] = __builtin_bit_cast(float, w1.z << 16); v[13] = __builtin_bit_cast(float, w1.z & 0xffff0000u); v[14] = __builtin_bit_cast(float, w1.w << 16); v[15] = __builtin_bit_cast(float, w1.w & 0xffff0000u);
          float o[8], ss = 0.f;
#pragma unroll
          for (int j = 0; j < 8; ++j) { const float send = odd ? v[j] : v[8 + j];
              const float recv = __builtin_bit_cast(float, __builtin_amdgcn_ds_bpermute((lane ^ 8) << 2, __builtin_bit_cast(int, send)));
              o[j] = odd ? (recv - lam * v[8 + j]) : (v[j] - lam * recv); ss += o[j] * o[j]; }
#pragma unroll
          for (int x = 1; x < 16; x <<= 1) ss += __builtin_bit_cast(float, __builtin_amdgcn_ds_bpermute((lane ^ x) << 2, __builtin_bit_cast(int, ss)));
          const float rn = sc / sqrtf(ss * (1.f / 128.f) + EPS);
          v4u wo; wo.x = pk2(o[0] * rn * ga[0], o[1] * rn * ga[1]); wo.y = pk2(o[2] * rn * ga[2], o[3] * rn * ga[3]); wo.z = pk2(o[4] * rn * gb[0], o[5] * rn * gb[1]); wo.w = pk2(o[6] * rn * gb[2], o[7] * rn * gb[3]);
          *(GAS v4u*)(Y + (size_t)m * YW + 768 + hh * 128 + eo) = wo; } }
    for (int idx = c.vcu * NWAVES + c.wave; idx < MS * 4; idx += c.G * NWAVES) { const int ms = idx >> 2, h = idx & 3;
        sattn::post_sample_wave((const float*)(ws + WS_PART), Y + (size_t)(SEQ + ms) * YW + 768 + h * 128, ms / DECS, ms % DECS, h, lam, sc, sg, c.lane); }
}

template <class Epi> __device__ __forceinline__ void gemm_call(LAS unsigned char* lds, int wv, int Mrows, const bf16_t* A, const bf16_t* Bt, int N, int K, int lda, int ldb, const Epi& E) {
    int bx = blockIdx.x; LAUNDER_S(bx); int G = gridDim.x; LAUNDER_S(G);
    pg8::Gemm g{A, Bt, Mrows, N, K, lda, ldb}; pg8::StaticOrder S; S.init(Mrows, N, G, bx);
    pg8::gemm_phase<Epi, pg8::StaticOrder>(lds + RING_OFF, g, S, E, tid_now(wv));
}
template <int MODE> __device__ __forceinline__ void tail_call(LAS unsigned char* lds, int wv, const tailg::Tail<MODE>& t) {
    int bx = blockIdx.x; LAUNDER_S(bx); int G = gridDim.x; LAUNDER_S(G); int tid = tid_now(wv); LAUNDER_V(tid);
    tailg::run<MODE>(lds + RING_OFF, tid, bx, G, t);
}

__global__ void __launch_bounds__(NWAVES * 64, 2) enc_fwd(Args args) {
    extern __shared__ __attribute__((aligned(16))) unsigned char lds_raw[];
    LAS unsigned char* lds = (LAS unsigned char*)lds_raw;
    unsigned char* const ws = args.ws;
    float* const X = args.out;
    int wv;
    {
        const int tid = threadIdx.x;
        wv = __builtin_amdgcn_readfirstlane(tid >> 6);
        for (int u = tid; u < (LDS_BYTES - LDSCTL_OFF) / 4; u += NWAVES * 64) ((LAS unsigned*)(lds + LDSCTL_OFF))[u] = 0u;
        __syncthreads();
        if (tid < 36) ((LAS unsigned long long*)(lds + LDSCTL_OFF))[tid] = (unsigned long long)args.in[tid];
        LAS float* LAMF = (LAS float*)(lds + MISC_OFF + 64);
        if (tid >= 64 && tid < 64 + DEPTH) { const int l = tid - 64; float d1 = 0.f, d2 = 0.f;
            const float* q1 = args.in[22] + l * 64; const float* k1 = args.in[23] + l * 64; const float* q2 = args.in[24] + l * 64; const float* k2 = args.in[25] + l * 64;
            for (int i = 0; i < 64; ++i) { d1 += q1[i] * k1[i]; d2 += q2[i] * k2[i]; }
            LAMF[l] = expf(d1) - expf(d2) + args.lam_init[l]; LAMF[4 + l] = 1.0f - args.lam_init[l]; }
        __syncthreads();
    }
    XcdBarrier bar = xcd_barrier_post((unsigned*)(ws + WS_CTL) + CW_BAR, (volatile LAS unsigned*)(lds + MISC_OFF) + 8, wv);
#define GRID_BAR() xcd_barrier(bar, wv)
    asm volatile("; MARK P0");
    prologue_phase(lds, wv, ws, X, args);
    GRID_BAR();

    for (int l = 0; l < DEPTH; ++l) {
#define WSP(T, off) ((T*)(lp(ws) + (off)))
#define WLP(off) ((const bf16_t*)(lp(ws) + WS_W + (size_t)l * LW_BYTES + (off)))
        asm volatile("; MARK FFN1");
        gemm_call(lds, wv, M, WSP(bf16_t, WS_XN), WLP(LW_GU1), NGU, D, D, D, pg8::EpiSwiGLU{WSP(bf16_t, WS_ACT), pg8::RowScale{WSP(float, WS_SS4), WSP(float, WS_SSP), SEQ}, FF, 0});
        weight_slice(lds, wv, lp(ws), l + 1, 0, WS1, NU_GU % 256); GRID_BAR();
        gemm_call(lds, wv, SEQ, WSP(bf16_t, WS_ACT), WLP(LW_D1), D, FF, FF, FF, pg8::EpiResid{WSP(bf16_t, WS_XN), WSP(float, WS_SS4), (l == DEPTH - 1 && false) ? lp(X) : nullptr, (LAS float*)(lds + LDSCTL_OFF + 1024), D, 0.5f});
        tail_call<0>(lds, wv, tailg::Tail<0>{WSP(bf16_t, WS_ACT), WLP(LW_D1), nullptr, WSP(bf16_t, WS_XN), WSP(float, WS_SSP), nullptr, nullptr, FF, FF, FF, 0, 0.5f, 0}); GRID_BAR();
        asm volatile("; MARK NORM2");
        gemm_call(lds, wv, M, WSP(bf16_t, WS_XN), WLP(LW_IN), ZW, D, D, D, pg8::EpiZ{WSP(bf16_t, WS_Z), WSP(bf16_t, WS_FAC), pg8::RowScale{WSP(float, WS_SS4), WSP(float, WS_SSP), SEQ}, ZW, 12, SEQ / 256, 0});
        weight_slice(lds, wv, lp(ws), l + 1, WS1, WS2, NU_IN % 256); GRID_BAR();
        asm volatile("; MARK MIX");
        mix_phase(lds, wv, lp(ws), lp(X), l); GRID_BAR();
        asm volatile("; MARK ATTN");
        attn_phase(lds_raw, lds, wv, lp(ws), lp(X), l); GRID_BAR();
        asm volatile("; MARK POST");
        post_phase(lds, wv, lp(ws), l); GRID_BAR();
        asm volatile("; MARK MERGE");
        gemm_call(lds, wv, SEQ, WSP(bf16_t, WS_Y), WLP(LW_P), D, YW, YW, YW, pg8::EpiMerged{WSP(bf16_t, WS_MRG), WSP(bf16_t, WS_FAC), D, ZW});
        tail_call<1>(lds, wv, tailg::Tail<1>{WSP(bf16_t, WS_Y), WLP(LW_P), nullptr, nullptr, nullptr, WSP(bf16_t, WS_MRG), WSP(bf16_t, WS_Z) + 3072, YW, YW, YW, ZW, 0.f, 0}); GRID_BAR();
        gemm_call(lds, wv, SEQ, WSP(bf16_t, WS_MRG), WLP(LW_O), D, D, D, D, pg8::EpiResid{WSP(bf16_t, WS_XN), WSP(float, WS_SS4), nullptr, (LAS float*)(lds + LDSCTL_OFF + 1024), D, 1.0f});
        tail_call<0>(lds, wv, tailg::Tail<0>{WSP(bf16_t, WS_MRG), WLP(LW_O), nullptr, WSP(bf16_t, WS_XN), WSP(float, WS_SSP), nullptr, nullptr, D, D, D, 0, 1.0f, 0}); GRID_BAR();
        asm volatile("; MARK FFN2");
        gemm_call(lds, wv, M, WSP(bf16_t, WS_XN), WLP(LW_GU2), NGU, D, D, D, pg8::EpiSwiGLU{WSP(bf16_t, WS_ACT), pg8::RowScale{WSP(float, WS_SS4), WSP(float, WS_SSP), SEQ}, FF, 0});
        weight_slice(lds, wv, lp(ws), l + 1, WS2, I_LAYER, NU_GU % 256); GRID_BAR();
        gemm_call(lds, wv, SEQ, WSP(bf16_t, WS_ACT), WLP(LW_D2), D, FF, FF, FF, pg8::EpiResid{WSP(bf16_t, WS_XN), WSP(float, WS_SS4), (l == DEPTH - 1 && true) ? lp(X) : nullptr, (LAS float*)(lds + LDSCTL_OFF + 1024), D, 0.5f});
        tail_call<0>(lds, wv, tailg::Tail<0>{WSP(bf16_t, WS_ACT), WLP(LW_D2), (l == DEPTH - 1) ? lp(X) : nullptr, WSP(bf16_t, WS_XN), WSP(float, WS_SSP), nullptr, nullptr, FF, FF, FF, 0, 0.5f, 0}); GRID_BAR();
#undef WSP
#undef WLP
    }
#undef GRID_BAR
}

extern "C" void kernel_launch(void* const* d_in, const int* in_sizes, int n_in, void* d_out, int out_size, void* d_ws, size_t ws_size, hipStream_t stream) {
    static int grid = 0;
    if (grid == 0) {
        if (n_in != 36 || in_sizes[0] != SEQ * D || (size_t)out_size != O_END || ws_size < WS_END) { fprintf(stderr, "kernel_launch: unexpected shapes (n_in %d, in0 %d, out %d, ws %zu need %zu)\n", n_in, n_in > 0 ? in_sizes[0] : -1, out_size, ws_size, (size_t)WS_END); grid = -1; return; }
        int dev = 0, cus = 0, per_cu = 0;
        if (hipGetDevice(&dev) != hipSuccess || hipDeviceGetAttribute(&cus, hipDeviceAttributeMultiprocessorCount, dev) != hipSuccess) { grid = -1; return; }
        if (hipFuncSetAttribute((const void*)enc_fwd, hipFuncAttributeMaxDynamicSharedMemorySize, LDS_BYTES) != hipSuccess) { fprintf(stderr, "kernel_launch: hipFuncSetAttribute failed\n"); grid = -1; return; }
        if (hipOccupancyMaxActiveBlocksPerMultiprocessor(&per_cu, (const void*)enc_fwd, NWAVES * 64, LDS_BYTES) != hipSuccess || per_cu < 1) fprintf(stderr, "kernel_launch: occupancy query reports %d\n", per_cu);
        (void)hipGetLastError();
        grid = cus;
    }
    if (grid < 0) return;
    if (hipMemsetAsync((char*)d_ws + WS_CTL, 0, CTL_ZERO_BYTES, stream) != hipSuccess) return;
    Args a; memset(&a, 0, sizeof(a));
    for (int i = 0; i < 36; ++i) a.in[i] = (const float*)d_in[i];
    a.out = (float*)d_out; a.ws = (unsigned char*)d_ws;
    for (int i = 0; i < 32; ++i) a.inv_freq[i] = (float)pow(10000.0, -(double)i / 32.0);
    for (int l = 0; l < 4; ++l) a.lam_init[l] = (float)(0.8 - 0.6 * exp(-0.3 * l));
    hipLaunchKernelGGL(enc_fwd, dim3(grid), dim3(NWAVES * 64), LDS_BYTES, stream, a);
    const hipError_t le = hipPeekAtLastError();
    if (le != hipSuccess) fprintf(stderr, "kernel_launch: launch failed: %s\n", hipGetErrorName(le));
}
#endif
```

```cpp
#ifndef CPU_TEST
#include <hip/hip_runtime.h>
#include <hip/hip_bf16.h>
#endif
#include <cstdio>
#include <cstdint>
#include <cmath>
#include <cstring>

#ifndef CFG_SEQ
#define CFG_SEQ 16384
#endif
#ifndef CFG_DEPTH
#define CFG_DEPTH 4
#endif
#ifndef CFG_DECB
#define CFG_DECB 32
#endif
#ifndef CFG_PAST
#define CFG_PAST 2048
#endif
constexpr int D = 1024, SEQ = CFG_SEQ, DEPTH = CFG_DEPTH, DECB = CFG_DECB, DECS = 16, PAST = CFG_PAST;
constexpr int MS = DECB * DECS, M = SEQ + MS;
constexpr int FF = 2816, NGU = 2 * FF, ZW = 7168, YW = 1280;
constexpr int KSROWS = PAST + 128;
constexpr int QSROWS = 256;
constexpr int ROPE_ROWS = (SEQ > PAST + DECS) ? SEQ : (PAST + DECS);
constexpr float EPS = 1e-6f;
constexpr float C2 = 0.125f * 1.4426950408889634f;

constexpr size_t O_YP = 0, O_YS = O_YP + (size_t)SEQ * D, O_KP = O_YS + (size_t)MS * D, O_VP = O_KP + (size_t)DEPTH * SEQ * 512,
                 O_POOLP = O_VP + (size_t)DEPTH * SEQ * 512, O_SCP = O_POOLP + (size_t)DEPTH * 15 * 256, O_CCP = O_SCP + (size_t)DEPTH * 2 * 256,
                 O_KS = O_CCP + (size_t)DEPTH * 30 * 256, O_VS = O_KS + (size_t)DEPTH * MS * 512, O_POOLS = O_VS + (size_t)DEPTH * MS * 512,
                 O_SCS = O_POOLS + (size_t)DEPTH * DECB * 15 * 256, O_CCS = O_SCS + (size_t)DEPTH * DECB * 2 * 256, O_END = O_CCS + (size_t)DEPTH * DECB * 30 * 256;

typedef unsigned short bf16_t;
#ifdef CPU_TEST
#define HD inline
#define LDSF float*
#else
#define HD __device__ __forceinline__
#define LAS __attribute__((address_space(3)))
#define LDSF LAS float*
#endif
#ifdef CPU_TEST
#define CBAR()
#else
#define CBAR() asm volatile("" ::: "memory")
#endif
HD unsigned f2bf(float f) { unsigned u = __builtin_bit_cast(unsigned, f); return (u + 0x7fffu + ((u >> 16) & 1u)) >> 16; }
HD float bf2f(bf16_t b) { return __builtin_bit_cast(float, (unsigned)b << 16); }
HD float sigmoid_f(float x) { return 1.0f / (1.0f + expf(-x)); }

HD void ld_bf16x8(const bf16_t* p, float* o) {
#ifdef CPU_TEST
    for (int i = 0; i < 8; ++i) o[i] = bf2f(p[i]);
#else
    typedef unsigned u4 __attribute__((ext_vector_type(4)));
    const u4 w = *(const u4*)p;
    o[0] = __builtin_bit_cast(float, w.x << 16); o[1] = __builtin_bit_cast(float, w.x & 0xffff0000u);
    o[2] = __builtin_bit_cast(float, w.y << 16); o[3] = __builtin_bit_cast(float, w.y & 0xffff0000u);
    o[4] = __builtin_bit_cast(float, w.z << 16); o[5] = __builtin_bit_cast(float, w.z & 0xffff0000u);
    o[6] = __builtin_bit_cast(float, w.w << 16); o[7] = __builtin_bit_cast(float, w.w & 0xffff0000u);
#endif
}
HD void st_bf16x8(bf16_t* p, const float* v) {
#ifdef CPU_TEST
    for (int i = 0; i < 8; ++i) p[i] = (bf16_t)f2bf(v[i]);
#else
    typedef unsigned u4 __attribute__((ext_vector_type(4)));
    u4 w; w.x = f2bf(v[0]) | (f2bf(v[1]) << 16); w.y = f2bf(v[2]) | (f2bf(v[3]) << 16); w.z = f2bf(v[4]) | (f2bf(v[5]) << 16); w.w = f2bf(v[6]) | (f2bf(v[7]) << 16);
    *(u4*)p = w;
#endif
}

struct MixP {
    const bf16_t* Z; bf16_t* Y;
    bf16_t *Qp, *Kp, *Vp;
    bf16_t *QS, *KS, *VS;
    float* out;
    const float *st_pool, *st_sconv, *st_cconv;
    const float *pool_w, *pool_scale, *sconv_w, *cconv_w, *cconv_b, *ln_g, *ln_b, *qg, *kg;
    const float* rope;
    int layer;
};
struct MixItem { int sample, b, t0, nrows; };
constexpr int MIX_PROWS = 32, N_MIX_PROMPT = SEQ / MIX_PROWS, N_MIX_ITEMS = N_MIX_PROMPT + DECB;
HD MixItem mix_item(int it) { MixItem I; if (it < N_MIX_PROMPT) { I.sample = 0; I.b = 0; I.t0 = it * MIX_PROWS; I.nrows = MIX_PROWS; } else { I.sample = 1; I.b = it - N_MIX_PROMPT; I.t0 = 0; I.nrows = DECS; } return I; }

HD void mix_c_fill(const MixP& P, const MixItem& I, int tid, LDSF T) {
    const int ch = tid & 255, half = tid >> 8, l = P.layer, b = I.b; const size_t mb = I.sample ? (size_t)SEQ + (size_t)DECS * b : 0;
    for (int i = half; i < I.nrows + 30; i += 2) { const int t = I.t0 - 30 + i; float v;
        if (t >= 0) { const bf16_t* zr = P.Z + (mb + t) * ZW; v = bf2f(zr[1024 + ch]) * sigmoid_f(bf2f(zr[1280 + ch])); }
        else v = I.sample ? P.st_cconv[((size_t)b * 30 + (30 + t)) * 256 + ch] : 0.f;
        T[i * 256 + ch] = v;
        if (!I.sample) { if (t >= I.t0 && t >= SEQ - 30) P.out[O_CCP + ((size_t)l * 30 + (t - (SEQ - 30))) * 256 + ch] = v; }
        else { if (t + 14 >= 0) P.out[O_CCS + (((size_t)l * DECB + b) * 30 + (t + 14)) * 256 + ch] = v; } }
}
HD void mix_c_conv(const MixP& P, const MixItem& I, int tid, LDSF T, LDSF cv) {
    const int ch = tid & 255, half = tid >> 8;
    float w[31];
#pragma unroll
    for (int j = 0; j < 31; ++j) w[j] = P.cconv_w[j * 256 + ch];
    for (int r = half; r < I.nrows; r += 2) { float a = 0.f;
#pragma unroll
        for (int j = 0; j < 31; ++j) a += w[j] * T[(r + j) * 256 + ch];
        cv[r * 256 + ch] = a; }
}
HD void mix_b_fill(const MixP& P, const MixItem& I, int tid, LDSF T) {
    const int ch = tid & 255, half = tid >> 8, l = P.layer, b = I.b; const size_t mb = I.sample ? (size_t)SEQ + (size_t)DECS * b : 0;
    for (int i = half; i < I.nrows + 2; i += 2) { const int t = I.t0 - 2 + i; float v;
        if (t >= 0) { const bf16_t* zr = P.Z + (mb + t) * ZW; v = bf2f(zr[512 + ch]) * bf2f(zr[768 + ch]); }
        else v = I.sample ? P.st_sconv[((size_t)b * 2 + (2 + t)) * 256 + ch] : 0.f;
        T[i * 256 + ch] = v;
        if (!I.sample) { if (t >= I.t0 && t >= SEQ - 2) P.out[O_SCP + ((size_t)l * 2 + (t - (SEQ - 2))) * 256 + ch] = v; }
        else { if (t >= DECS - 2) P.out[O_SCS + (((size_t)l * DECB + b) * 2 + (t - (DECS - 2))) * 256 + ch] = v; } }
}
HD void mix_b_conv(const MixP& P, const MixItem& I, int tid, LDSF T) {
    const int ch = tid & 255, half = tid >> 8; const size_t mb = I.sample ? (size_t)SEQ + (size_t)DECS * I.b : 0;
    const float w0 = P.sconv_w[ch], w1 = P.sconv_w[256 + ch], w2 = P.sconv_w[512 + ch];
    for (int r = half; r < I.nrows; r += 2) { const int t = I.t0 + r; const float y = w0 * T[r * 256 + ch] + w1 * T[(r + 1) * 256 + ch] + w2 * T[(r + 2) * 256 + ch];
        const float zb = bf2f(P.Z[(mb + t) * ZW + 256 + ch]);
        P.Y[(mb + t) * YW + 256 + ch] = (bf16_t)f2bf(zb * y); }
}
HD void mix_a_fill(const MixP& P, const MixItem& I, int tid, LDSF T) {
    const int ch = tid & 255, half = tid >> 8, l = P.layer, b = I.b; const size_t mb = I.sample ? (size_t)SEQ + (size_t)DECS * b : 0;
    for (int i = half; i < I.nrows + 15; i += 2) { const int t = I.t0 - 15 + i;
        const float v = (t >= 0) ? bf2f(P.Z[(mb + t) * ZW + ch]) : (I.sample ? P.st_pool[((size_t)b * 15 + (15 + t)) * 256 + ch] : 0.f);
        T[i * 256 + ch] = v;
        if (!I.sample) { if (t >= I.t0 && t >= SEQ - 15) P.out[O_POOLP + ((size_t)l * 15 + (t - (SEQ - 15))) * 256 + ch] = v; }
        else { if (t >= 1) P.out[O_POOLS + (((size_t)l * DECB + b) * 15 + (t - 1)) * 256 + ch] = v; } }
}
HD void mix_a_pool(const MixP& P, const MixItem& I, int tid, LDSF T, LDSF dA) {
    const int ch = tid & 255, half = tid >> 8; const int win = 2 << (ch >> 6);
    for (int r = half; r < I.nrows; r += 2) { const int t = I.t0 + r; float s = 0.f;
        for (int j = 0; j < win; ++j) s += T[(15 + r - j) * 256 + ch];
        const int pos = I.sample ? PAST + t : t; const int cnt = (pos + 1 < win) ? pos + 1 : win;
        dA[r * 256 + ch] = s / (float)cnt - T[(15 + r) * 256 + ch]; }
}
HD void mix_s2(const MixP& P, const MixItem& I, int tid, LDSF cv, LDSF dA, LDSF st) {
    const int ch = tid & 255, half = tid >> 8, g = ch >> 6, dd = ch & 63;
    const size_t mb = I.sample ? (size_t)SEQ + (size_t)DECS * I.b : 0;
    float acc[16];
#pragma unroll
    for (int k = 0; k < 16; ++k) acc[k] = 0.f;
    for (int c = 0; c < 64; ++c) { const float w = P.pool_w[(g * 64 + c) * 64 + dd];
#pragma unroll
        for (int k = 0; k < 16; ++k) acc[k] += dA[(half + 2 * k) * 256 + g * 64 + c] * w; }
    const float sc = P.pool_scale[ch];
#pragma unroll
    for (int k = 0; k < 16; ++k) { const int r = half + 2 * k; if (r < I.nrows) P.Y[(mb + I.t0 + r) * YW + ch] = (bf16_t)f2bf(acc[k] * sc); }
    if (tid < I.nrows) { float s = 0.f;
        for (int c = 0; c < 256; ++c) s += cv[tid * 256 + c] + P.cconv_b[c];
        const float mean = s * (1.f / 256.f); float q = 0.f;
        for (int c = 0; c < 256; ++c) { const float d = cv[tid * 256 + c] + P.cconv_b[c] - mean; q += d * d; }
        st[2 * tid] = mean; st[2 * tid + 1] = 1.0f / sqrtf(q * (1.f / 256.f) + EPS); }
}
HD void mix_s3(const MixP& P, const MixItem& I, int tid, LDSF cv, LDSF st) {
    const int ch = tid & 255, half = tid >> 8;
    const size_t mb = I.sample ? (size_t)SEQ + (size_t)DECS * I.b : 0;
    const float bi = P.cconv_b[ch], lg = P.ln_g[ch], lb = P.ln_b[ch];
    for (int r = half; r < I.nrows; r += 2) { const float v = (cv[r * 256 + ch] + bi - st[2 * r]) * st[2 * r + 1] * lg + lb;
        P.Y[(mb + I.t0 + r) * YW + 512 + ch] = (bf16_t)f2bf(v * sigmoid_f(v)); }
}
HD void mix_s4(const MixP& P, const MixItem& I, int tid) {
    const int kind = tid >> 8, rr = (tid >> 3) & 31, map = tid & 7, l = P.layer, b = I.b;
    const size_t mb = I.sample ? (size_t)SEQ + (size_t)DECS * b : 0;
    if (rr < I.nrows) {
        const int t = I.t0 + rr; const bf16_t* src = P.Z + (mb + t) * ZW + 1536 + kind * 512 + map * 64;
        float v[64];
#pragma unroll
        for (int i = 0; i < 8; ++i) ld_bf16x8(src + 8 * i, v + 8 * i);
        float ss = 0.f;
#pragma unroll
        for (int i = 0; i < 64; ++i) ss += v[i] * v[i];
        const float rn = 1.0f / sqrtf(ss * (1.f / 64.f) + EPS);
        const float* gp = kind ? P.kg : P.qg;
        const int pos = I.sample ? PAST + t : t; const float* rp = P.rope + (size_t)pos * 64;
        float o[64];
#pragma unroll
        for (int i = 0; i < 32; ++i) { const float a = v[i] * rn * gp[i], c = v[i + 32] * rn * gp[i + 32], co = rp[i], si = rp[32 + i];
            o[i] = a * co - c * si; o[i + 32] = c * co + a * si; }
        if (kind == 0) {
            bf16_t* dst = I.sample ? P.QS + ((size_t)b * QSROWS + t) * 512 + map * 64 : P.Qp + (size_t)t * 512 + map * 64;
#pragma unroll
            for (int i = 0; i < 64; ++i) o[i] *= C2;
#pragma unroll
            for (int i = 0; i < 8; ++i) st_bf16x8(dst + 8 * i, o + 8 * i);
        } else {
            bf16_t* dst = I.sample ? P.KS + ((size_t)b * KSROWS + PAST + t) * 512 + map * 64 : P.Kp + (size_t)t * 512 + map * 64;
#pragma unroll
            for (int i = 0; i < 8; ++i) st_bf16x8(dst + 8 * i, o + 8 * i);
            float* od = I.sample ? P.out + O_KS + (((size_t)l * DECB + b) * DECS + t) * 512 + map * 64 : P.out + O_KP + ((size_t)l * SEQ + t) * 512 + map * 64;
#pragma unroll
            for (int i = 0; i < 64; ++i) od[i] = o[i];
        }
    }
    for (int idx = tid; idx < I.nrows * 512; idx += 512) { const int r2 = idx >> 9, c = idx & 511, t = I.t0 + r2;
        const bf16_t val = P.Z[(mb + t) * ZW + 2560 + c];
        if (I.sample) { P.VS[((size_t)b * KSROWS + PAST + t) * 512 + c] = val; P.out[O_VS + (((size_t)l * DECB + b) * DECS + t) * 512 + c] = bf2f(val); }
        else { P.Vp[(size_t)t * 512 + c] = val; P.out[O_VP + ((size_t)l * SEQ + t) * 512 + c] = bf2f(val); } }
}
HD void post_thread(const bf16_t* Orow  , bf16_t* Ydst  , int h, float lam, float scale, const float* subln_g) {
    const bf16_t* a = Orow + (2 * h) * 128; const bf16_t* c = a + 128; float ss = 0.f;
    for (int i = 0; i < 16; ++i) { float x[8], y[8]; ld_bf16x8(a + 8 * i, x); ld_bf16x8(c + 8 * i, y);
#pragma unroll
        for (int j = 0; j < 8; ++j) { const float o = x[j] - lam * y[j]; ss += o * o; } }
    const float rn = scale / sqrtf(ss * (1.f / 128.f) + EPS);
    for (int i = 0; i < 16; ++i) { float x[8], y[8], o[8]; ld_bf16x8(a + 8 * i, x); ld_bf16x8(c + 8 * i, y);
#pragma unroll
        for (int j = 0; j < 8; ++j) o[j] = (x[j] - lam * y[j]) * rn * subln_g[8 * i + j];
        st_bf16x8(Ydst + h * 128 + 8 * i, o); }
}
#ifndef CPU_TEST
namespace pg8 {
#define PG8_LAS __attribute__((address_space(3)))
#define PG8_GAS __attribute__((address_space(1)))
typedef short bf16x8 __attribute__((ext_vector_type(8)));
typedef float f32x4 __attribute__((ext_vector_type(4)));
typedef float f32x2 __attribute__((ext_vector_type(2)));
typedef unsigned u32x4 __attribute__((ext_vector_type(4)));
typedef unsigned u32x2 __attribute__((ext_vector_type(2)));
constexpr int BM = 256, BK = 64, HALF = 128, HTB = HALF * BK * 2  , STAGE_BYTES = 8 * HTB, NXCD = 8, WGM = 8;

__host__ __device__ __forceinline__ int lds_byte(int r, int c) { const int st = (r >> 4) * 2 + (c >> 5), rr = r & 15, cc = c & 31, ob = rr * 64 + cc * 2; return st * 1024 + (ob ^ (((ob >> 9) & 1) << 5)); }
__host__ __device__ __forceinline__ void stage_rc(int b, int& R, int& C) { const int st = b / 1024, sb = b % 1024, swz = sb ^ (((sb >> 9) & 1) << 5); R = (st >> 1) * 16 + swz / 64; C = (st & 1) * 32 + (swz % 64) / 2; }
__host__ __device__ __forceinline__ int perm32(int rho) { const int n = rho >> 4, i = rho & 15; return 8 * (i >> 2) + 4 * n + (i & 3); }

struct Unit { int pm, pn; };
struct Gemm { const bf16_t* A; const bf16_t* Bt; int M, N, K, lda, ldb; };

struct StaticOrder {
    int nM, nN, nwg, G, c;
    __host__ __device__ void init(int M_, int N_, int G_, int c_) { nM = M_ / BM; nN = N_ / BM; nwg = nM * nN; G = G_; c = c_; }
    __host__ __device__ bool next(int i, Unit& u) const {
        const long L = (long)i * G + c; if (L >= nwg) return false;
        int wgid = (int)L; { const int q = nwg / NXCD, r = nwg % NXCD, xcd = wgid % NXCD, off = wgid / NXCD; wgid = (xcd < r ? xcd * (q + 1) : r * (q + 1) + (xcd - r) * q) + off; }
        const int nig = WGM * nN, gid = wgid / nig, fm = gid * WGM, gsz = (nM - fm) < WGM ? (nM - fm) : WGM;
        u.pm = fm + ((wgid % nig) % gsz); u.pn = (wgid % nig) / gsz; return true;
    }
    __device__ __forceinline__ void a_ready(const Unit&) const {}
    __device__ __forceinline__ void done(const Unit&) const {}
};

typedef __bf16 bf16x2_v __attribute__((ext_vector_type(2)));
__device__ __forceinline__ unsigned cvt_pk_bf16(float lo, float hi) { f32x2 v = {lo, hi}; const bf16x2_v b = __builtin_convertvector(v, bf16x2_v); return __builtin_bit_cast(unsigned, b); }
__device__ __forceinline__ float fast_sigmoid(float x) { return __builtin_amdgcn_rcpf(1.0f + __expf(-x)); }

struct RowScale { const float* SS4; const float* SS16; int nfast; };
__device__ __forceinline__ void row_rscales(const RowScale& R, int row0, float (&rs)[2][4]) {
    if (row0 < R.nfast) { f32x4 q[2][4];
#pragma unroll
        for (int ai = 0; ai < 2; ++ai)
#pragma unroll
            for (int m = 0; m < 4; ++m) q[ai][m] = *(const PG8_GAS f32x4*)(R.SS4 + (size_t)(row0 + ai * HALF + m * 16) * 4);
#pragma unroll
        for (int ai = 0; ai < 2; ++ai)
#pragma unroll
            for (int m = 0; m < 4; ++m) rs[ai][m] = 1.0f / sqrtf(((q[ai][m][0] + q[ai][m][1]) + (q[ai][m][2] + q[ai][m][3])) * (1.0f / 1024.0f) + 1e-6f);
    } else {
#pragma unroll
        for (int ai = 0; ai < 2; ++ai)
#pragma unroll
            for (int m = 0; m < 4; ++m) { const PG8_GAS f32x4* p = (const PG8_GAS f32x4*)(R.SS16 + (size_t)(row0 + ai * HALF + m * 16 - R.nfast) * 16); const f32x4 a = p[0], b = p[1], c = p[2], d = p[3];
                const float ss = ((a[0] + a[1]) + (a[2] + a[3])) + ((b[0] + b[1]) + (b[2] + b[3])) + ((c[0] + c[1]) + (c[2] + c[3])) + ((d[0] + d[1]) + (d[2] + d[3]));
                rs[ai][m] = 1.0f / sqrtf(ss * (1.0f / 1024.0f) + 1e-6f); }
    }
}
struct EpiSwiGLU {
    static constexpr bool PERM = true, AFTER_DRAIN = false, MID = false, ROWSCALE = true;
    bf16_t* O; RowScale R; int ldc, pad;
    __device__ __forceinline__ void operator()(const f32x4 (&acc)[2][2][4][2], const Unit& u, int wr, int wc, int fr, int fq, const float (&rsv)[2][4]) const {
        const int row0 = u.pm * BM + wr * 64 + fr, col0 = u.pn * HALF + wc * 32 + 8 * fq;
#pragma unroll
        for (int ai = 0; ai < 2; ++ai)
#pragma unroll
            for (int m = 0; m < 4; ++m) { bf16_t* rowp = O + (size_t)(row0 + ai * HALF + m * 16) * ldc + col0; const float rs = rsv[ai][m];
                float v[8];
#pragma unroll
                for (int n = 0; n < 2; ++n)
#pragma unroll
                    for (int i = 0; i < 4; ++i) { const float g = acc[ai][0][m][n][i] * rs, up = acc[ai][1][m][n][i] * rs; v[4 * n + i] = g * fast_sigmoid(g) * up; }
                u32x4 w; w.x = cvt_pk_bf16(v[0], v[1]); w.y = cvt_pk_bf16(v[2], v[3]); w.z = cvt_pk_bf16(v[4], v[5]); w.w = cvt_pk_bf16(v[6], v[7]);
                *(PG8_GAS u32x4*)rowp = w; }
    }
};
struct EpiZ {
    static constexpr bool PERM = true, AFTER_DRAIN = false, MID = false, ROWSCALE = true;
    bf16_t* O; bf16_t* FAC; RowScale R; int ldc, sig_from, nfp, pad;
    __device__ __forceinline__ void operator()(const f32x4 (&acc)[2][2][4][2], const Unit& u, int wr, int wc, int fr, int fq, const float (&rsv)[2][4]) const {
        const int row0 = u.pm * BM + wr * 64 + fr;
        if (u.pn < sig_from) { const int col0 = u.pn * BM + wc * 32 + 8 * fq;
#pragma unroll
            for (int ai = 0; ai < 2; ++ai)
#pragma unroll
                for (int m = 0; m < 4; ++m) { bf16_t* rowp = O + (size_t)(row0 + ai * HALF + m * 16) * ldc + col0; const float rs = rsv[ai][m];
#pragma unroll
                    for (int bj = 0; bj < 2; ++bj) { const f32x4 v0 = acc[ai][bj][m][0] * rs, v1 = acc[ai][bj][m][1] * rs;
                        u32x4 w; w.x = cvt_pk_bf16(v0[0], v0[1]); w.y = cvt_pk_bf16(v0[2], v0[3]); w.z = cvt_pk_bf16(v1[0], v1[1]); w.w = cvt_pk_bf16(v1[2], v1[3]);
                        *(PG8_GAS u32x4*)(rowp + bj * HALF) = w; } }
        } else { const int j = u.pn - sig_from, oc = j * 64 + wc * 16 + 4 * fq; const int g0c = sig_from * BM;
            const bool blk = u.pm < nfp;
            bf16_t* const fb = FAC + ((size_t)(u.pm * 4 + (j >> 2)) << 18) + (size_t)((wr * 4 + ((j & 1) << 1) + (wc >> 1)) * 8192 + ((j >> 1) & 1) * 512 + (fq * 16 + fr) * 8 + (wc & 1) * 4);
#pragma unroll
            for (int ai = 0; ai < 2; ++ai)
#pragma unroll
                for (int m = 0; m < 4; ++m) { bf16_t* rowp = blk ? fb + (ai * 4 + m) * 1024 : O + (size_t)(row0 + ai * HALF + m * 16) * ldc + g0c + oc; const int qs = blk ? 65536 : 1024; const float rs = rsv[ai][m];
                    f32x4 e[4];
#pragma unroll
                    for (int b = 0; b < 4; ++b)
#pragma unroll
                        for (int i = 0; i < 4; ++i) e[b][i] = 1.0f + __expf(-acc[ai][b >> 1][m][b & 1][i] * rs);
#pragma unroll
                    for (int q = 0; q < 4; ++q) { f32x4 v;
#pragma unroll
                        for (int i = 0; i < 4; ++i) v[i] = (q < 3) ? e[q + 1 > 3 ? 3 : q + 1][i] * __builtin_amdgcn_rcpf(e[q][i]) : __builtin_amdgcn_rcpf(e[3][i]);
                        u32x2 w; w.x = cvt_pk_bf16(v[0], v[1]); w.y = cvt_pk_bf16(v[2], v[3]); *(PG8_GAS u32x2*)(rowp + q * qs) = w; } }
        }
    }
};
struct EpiMerged {
    static constexpr bool PERM = false, AFTER_DRAIN = false, MID = true, ROWSCALE = false;
    bf16_t* OUT; const bf16_t* F; int ldc, ldf;
    __device__ __forceinline__ void scale(f32x4 (&acc)[2][2][4][2], const Unit& u, int wr, int wc, int fr, int fq, int q) const {
        const bf16_t* fb = F + ((size_t)((u.pm * 4 + u.pn) * 4 + q) << 16) + (size_t)((wr * 4 + wc) * 8192 + (fq * 16 + fr) * 8);
        u32x4 gq[2][4][2];
#pragma unroll
        for (int ai = 0; ai < 2; ++ai)
#pragma unroll
            for (int m = 0; m < 4; ++m)
#pragma unroll
                for (int bj = 0; bj < 2; ++bj) gq[ai][m][bj] = *(const PG8_GAS u32x4*)(fb + ((ai * 4 + m) * 2 + bj) * 512);
#pragma unroll
        for (int ai = 0; ai < 2; ++ai)
#pragma unroll
            for (int m = 0; m < 4; ++m)
#pragma unroll
                for (int bj = 0; bj < 2; ++bj)
#pragma unroll
                    for (int n = 0; n < 2; ++n) { u32x2 w; w.x = n ? gq[ai][m][bj].z : gq[ai][m][bj].x; w.y = n ? gq[ai][m][bj].w : gq[ai][m][bj].y; f32x4 g; g[0] = __builtin_bit_cast(float, w.x << 16); g[1] = __builtin_bit_cast(float, w.x & 0xffff0000u); g[2] = __builtin_bit_cast(float, w.y << 16); g[3] = __builtin_bit_cast(float, w.y & 0xffff0000u);
                        acc[ai][bj][m][n] *= g; }
    }
    __device__ __forceinline__ void mid(f32x4 (&acc)[2][2][4][2], const Unit& u, int wr, int wc, int fr, int fq, int i) const { scale(acc, u, wr, wc, fr, fq, i); }
    __device__ __forceinline__ void operator()(f32x4 (&acc)[2][2][4][2], const Unit& u, int wr, int wc, int fr, int fq) const {
        scale(acc, u, wr, wc, fr, fq, 3);
        const int row0 = u.pm * BM + wr * 64 + fr, col0 = u.pn * BM + wc * 32 + 4 * fq;
#pragma unroll
        for (int ai = 0; ai < 2; ++ai)
#pragma unroll
            for (int m = 0; m < 4; ++m) { bf16_t* op = OUT + (size_t)(row0 + ai * HALF + m * 16) * ldc + col0;
#pragma unroll
                for (int bj = 0; bj < 2; ++bj)
#pragma unroll
                    for (int n = 0; n < 2; ++n) { const f32x4 v = acc[ai][bj][m][n]; u32x2 w; w.x = cvt_pk_bf16(v[0], v[1]); w.y = cvt_pk_bf16(v[2], v[3]); *(PG8_GAS u32x2*)(op + bj * HALF + n * 16) = w; } }
    }
};
struct EpiResid {
    static constexpr bool PERM = true, AFTER_DRAIN = false, MID = false, ROWSCALE = false;
    bf16_t* XB; float* SS4; float* Xout; PG8_LAS float* PS; int ldc; float s;
    __device__ __forceinline__ void operator()(const f32x4 (&acc)[2][2][4][2], const Unit& u, int wr, int wc, int fr, int fq) const {
        const int row0 = u.pm * BM + wr * 64 + fr, col0 = u.pn * BM + wc * 32 + 8 * fq; const int lane = fq * 16 + fr; const bool fin = Xout != nullptr;
#pragma unroll
        for (int ai = 0; ai < 2; ++ai)
#pragma unroll
            for (int m = 0; m < 4; ++m) { const size_t row = (size_t)(row0 + ai * HALF + m * 16); bf16_t* xb = XB + row * ldc + col0; float* xo = Xout + row * ldc + col0;
                u32x4 x[2];
#pragma unroll
                for (int bj = 0; bj < 2; ++bj) x[bj] = *(const PG8_GAS u32x4*)(xb + bj * HALF);
                float ss = 0.f;
#pragma unroll
                for (int bj = 0; bj < 2; ++bj) { f32x4 v0, v1;
                    v0[0] = __builtin_bit_cast(float, x[bj].x << 16); v0[1] = __builtin_bit_cast(float, x[bj].x & 0xffff0000u); v0[2] = __builtin_bit_cast(float, x[bj].y << 16); v0[3] = __builtin_bit_cast(float, x[bj].y & 0xffff0000u);
                    v1[0] = __builtin_bit_cast(float, x[bj].z << 16); v1[1] = __builtin_bit_cast(float, x[bj].z & 0xffff0000u); v1[2] = __builtin_bit_cast(float, x[bj].w << 16); v1[3] = __builtin_bit_cast(float, x[bj].w & 0xffff0000u);
                    v0 += acc[ai][bj][m][0] * s; v1 += acc[ai][bj][m][1] * s;
                    if (fin) { *(PG8_GAS f32x4*)(xo + bj * HALF) = v0; *(PG8_GAS f32x4*)(xo + bj * HALF + 4) = v1; }
                    else { u32x4 w; w.x = cvt_pk_bf16(v0[0], v0[1]); w.y = cvt_pk_bf16(v0[2], v0[3]); w.z = cvt_pk_bf16(v1[0], v1[1]); w.w = cvt_pk_bf16(v1[2], v1[3]); *(PG8_GAS u32x4*)(xb + bj * HALF) = w;
                        ss += ((v0[0] * v0[0] + v0[1] * v0[1]) + (v0[2] * v0[2] + v0[3] * v0[3])) + ((v1[0] * v1[0] + v1[1] * v1[1]) + (v1[2] * v1[2] + v1[3] * v1[3])); } }
                ss += __builtin_bit_cast(float, __builtin_amdgcn_ds_bpermute((lane ^ 16) << 2, __builtin_bit_cast(int, ss)));
                ss += __builtin_bit_cast(float, __builtin_amdgcn_ds_bpermute((lane ^ 32) << 2, __builtin_bit_cast(int, ss)));
                if (fq == 0) PS[(ai * HALF + wr * 64 + m * 16 + fr) * 4 + wc] = ss;
                if (m & 1) asm volatile("" ::: "memory"); }
        asm volatile("s_waitcnt lgkmcnt(0)" ::: "memory"); __builtin_amdgcn_s_barrier(); asm volatile("" ::: "memory");
        if (lane < 32 && !fin) { const int c8 = 2 * wc + (lane >> 4), rl = (c8 >> 2) * HALF + wr * 64 + (c8 & 3) * 16 + (lane & 15);
            const f32x4 q = *(const PG8_LAS f32x4*)(PS + rl * 4); ((PG8_GAS float*)SS4)[(size_t)(u.pm * BM + rl) * 4 + u.pn] = (q[0] + q[1]) + (q[2] + q[3]); }
    }
};
template <class Epi, class Sched, bool ALIGN_EPI = true>
__device__ __forceinline__ void gemm_phase(PG8_LAS unsigned char* lds_in, const Gemm g, const Sched& S, const Epi& E, int tid_in) {
    unsigned lb_ = (unsigned)(uintptr_t)lds_in; asm volatile("" : "+s"(lb_)); PG8_LAS unsigned char* lds = (PG8_LAS unsigned char*)(uintptr_t)lb_;
    int tid_ = tid_in; asm volatile("" : "+v"(tid_));
    const int tid = tid_, wid = __builtin_amdgcn_readfirstlane(tid >> 6), lane = tid & 63, wr = wid >> 2, wc = wid & 3, fr = lane & 15, fq = lane >> 4;
    const int K = g.K, nt = K / BK;
    unsigned voffA[2], voffB[2];
#pragma unroll
    for (int i = 0; i < 2; ++i) { int R, C; stage_rc(tid * 16 + i * 8192, R, C); const int Rb = Epi::PERM ? ((R & ~31) + perm32(R & 31)) : R;
        voffA[i] = (unsigned)(R * g.lda + C) * 2u; voffB[i] = (unsigned)(Rb * g.ldb + C) * 2u; }
    const size_t kstep = (size_t)(BK * 2);
    const size_t hA = (size_t)HALF * g.lda * 2, hB = (size_t)HALF * g.ldb * 2;
    const size_t tA = 2 * hA, tB = 2 * hB;
    const unsigned ldsw = (unsigned)wid * 1024u;
    const int aoff = lds_byte(wr * 64 + fr, fq * 8), boff = lds_byte(wc * 32 + fr, fq * 8);
#define PG8_SA(b, h) (((b) * 2 + (h)) * HTB)
#define PG8_SB(b, h) ((4 + (b) * 2 + (h)) * HTB)
#define PG8_STAGE(bufoff, gbase, voff) do { _Pragma("unroll") for (int _i = 0; _i < 2; ++_i) \
        __builtin_amdgcn_global_load_lds((const unsigned*)((const char*)(gbase) + (voff)[_i]), (PG8_LAS unsigned*)(lds + (bufoff) + ldsw + _i * 8192), 16, 0, 0); } while (0)
#define PG8_LDA(dst, b, h) do { _Pragma("unroll") for (int m = 0; m < 4; ++m) _Pragma("unroll") for (int k = 0; k < 2; ++k) dst[m][k] = *(const PG8_LAS bf16x8*)(lds + PG8_SA(b, h) + aoff + m * 2048 + k * 1024); } while (0)
#define PG8_LDB(dst, b, h) do { _Pragma("unroll") for (int n = 0; n < 2; ++n) _Pragma("unroll") for (int k = 0; k < 2; ++k) dst[n][k] = *(const PG8_LAS bf16x8*)(lds + PG8_SB(b, h) + boff + n * 2048 + k * 1024); } while (0)
#define PG8_MMA(ai, bj, At, Bt) do { __builtin_amdgcn_s_setprio(1); _Pragma("unroll") for (int m = 0; m < 4; ++m) _Pragma("unroll") for (int n = 0; n < 2; ++n) _Pragma("unroll") for (int k = 0; k < 2; ++k) \
        acc[ai][bj][m][n] = __builtin_amdgcn_mfma_f32_16x16x32_bf16(Bt[n][k], At[m][k], acc[ai][bj][m][n], 0, 0, 0); __builtin_amdgcn_s_setprio(0); } while (0)
#define PG8_WAIT_V(n) asm volatile("s_waitcnt vmcnt(" #n ")" ::: "memory")
#define PG8_WAIT_L(n) asm volatile("s_waitcnt lgkmcnt(" #n ")" ::: "memory")
#define PG8_BAR __builtin_amdgcn_s_barrier()
#define PG8_SCHED __builtin_amdgcn_sched_barrier(0)
    Unit cur, nxt; int ui = 0;
    float rsv[2][4]; int rs_pm = -1;
#pragma unroll
    for (int a = 0; a < 2; ++a)
#pragma unroll
        for (int m = 0; m < 4; ++m) rsv[a][m] = 0.f;
    if (!S.next(0, cur)) return;
    f32x4 acc[2][2][4][2];
#pragma unroll
    for (int a = 0; a < 2; ++a)
#pragma unroll
        for (int b = 0; b < 2; ++b)
#pragma unroll
            for (int m = 0; m < 4; ++m)
#pragma unroll
                for (int n = 0; n < 2; ++n) acc[a][b][m][n] = (f32x4){0.f, 0.f, 0.f, 0.f};
    bf16x8 At[4][2], B0[2][2], B1[2][2];
    const char* cA = (const char*)g.A + (size_t)cur.pm * tA; const char* cB = (const char*)g.Bt + (size_t)cur.pn * tB;
    S.a_ready(cur);
    PG8_STAGE(PG8_SB(0, 0), cB, voffB); PG8_STAGE(PG8_SB(0, 1), cB + hB, voffB); PG8_STAGE(PG8_SA(0, 0), cA, voffA); PG8_STAGE(PG8_SA(0, 1), cA + hA, voffA);
    if (wr == 1) PG8_BAR;
    PG8_WAIT_V(2); PG8_BAR;
    PG8_STAGE(PG8_SB(1, 0), cB + kstep, voffB); PG8_STAGE(PG8_SA(1, 0), cA + kstep, voffA); PG8_STAGE(PG8_SB(1, 1), cB + hB + kstep, voffB);
    PG8_WAIT_V(6); PG8_BAR;
    for (;;) {
        const bool has_next = S.next(ui + 1, nxt);
        const char* nA = has_next ? (const char*)g.A + (size_t)nxt.pm * tA : cA; const char* nB = has_next ? (const char*)g.Bt + (size_t)nxt.pn * tB : cB;
        for (int t = 0; t < nt; t += 2) {
            const bool last = (t == nt - 2);
            const char* a1 = cA + (size_t)(t + 1) * kstep;
            const char* a2 = last ? nA : cA + (size_t)(t + 2) * kstep; const char* b2 = last ? nB : cB + (size_t)(t + 2) * kstep;
            const char* a3 = a2 + kstep; const char* b3 = b2 + kstep;
            if (last && has_next) S.a_ready(nxt);
            PG8_LDB(B0, 0, 0); PG8_LDB(B1, 0, 1); PG8_SCHED; PG8_LDA(At, 0, 0); PG8_STAGE(PG8_SA(1, 1), a1 + hA, voffA);
            PG8_WAIT_V(8); PG8_WAIT_L(0); PG8_BAR; PG8_MMA(0, 0, At, B0); PG8_MMA(0, 1, At, B1); PG8_BAR; PG8_SCHED;
            PG8_LDA(At, 0, 1); PG8_STAGE(PG8_SB(0, 0), b2, voffB); PG8_STAGE(PG8_SB(0, 1), b2 + hB, voffB); PG8_STAGE(PG8_SA(0, 0), a2, voffA);
            PG8_WAIT_V(8); PG8_WAIT_L(0); PG8_BAR; PG8_MMA(1, 0, At, B0); PG8_MMA(1, 1, At, B1); PG8_BAR; PG8_SCHED;
            PG8_LDB(B0, 1, 0); PG8_LDB(B1, 1, 1); PG8_SCHED; PG8_LDA(At, 1, 0); PG8_STAGE(PG8_SA(0, 1), a2 + hA, voffA);
            PG8_WAIT_V(8); PG8_WAIT_L(0); PG8_BAR; PG8_MMA(0, 0, At, B0); PG8_MMA(0, 1, At, B1); PG8_BAR; PG8_SCHED;
            PG8_LDA(At, 1, 1); PG8_STAGE(PG8_SB(1, 0), b3, voffB); PG8_STAGE(PG8_SB(1, 1), b3 + hB, voffB); PG8_STAGE(PG8_SA(1, 0), a3, voffA);
            PG8_WAIT_V(8); PG8_WAIT_L(0); PG8_BAR; PG8_MMA(1, 0, At, B0); PG8_MMA(1, 1, At, B1); PG8_BAR; PG8_SCHED;
            if constexpr (Epi::MID) { const int tn = t + 2; if (tn <= 12 && (tn & 3) == 0) { E.mid(acc, cur, wr, wc, fr, fq, (tn >> 2) - 1); PG8_SCHED; } }
        }
        if constexpr (ALIGN_EPI) { if (wr == 0) PG8_BAR; }
        if constexpr (Epi::ROWSCALE) { if (cur.pm != rs_pm) { row_rscales(E.R, cur.pm * BM + wr * 64 + fr, rsv); rs_pm = cur.pm; }
            E(acc, cur, wr, wc, fr, fq, rsv); }
        else E(acc, cur, wr, wc, fr, fq);
        S.done(cur);
        if (!has_next) break;
#pragma unroll
        for (int a = 0; a < 2; ++a)
#pragma unroll
            for (int b = 0; b < 2; ++b)
#pragma unroll
                for (int m = 0; m < 4; ++m)
#pragma unroll
                    for (int n = 0; n < 2; ++n) acc[a][b][m][n] = (f32x4){0.f, 0.f, 0.f, 0.f};
        cur = nxt; cA = nA; cB = nB; ++ui;
        if constexpr (ALIGN_EPI) { if (wr == 1) PG8_BAR; }
    }
    PG8_WAIT_V(0);
    if constexpr (!ALIGN_EPI) { if (wr == 0) PG8_BAR; }
    PG8_BAR;
#undef PG8_SA
#undef PG8_SB
#undef PG8_STAGE
#undef PG8_LDA
#undef PG8_LDB
#undef PG8_MMA
#undef PG8_WAIT_V
#undef PG8_WAIT_L
#undef PG8_BAR
#undef PG8_SCHED
}
}
#include <cmath>
namespace attn_body {
using bf16=__hip_bfloat16;
using bf16x8=__attribute__((ext_vector_type(8)))short;
using s16x4=__attribute__((ext_vector_type(4)))short;
using f32x16=__attribute__((ext_vector_type(16)))float;
using u32x4=__attribute__((ext_vector_type(4)))unsigned;
constexpr int D=64,QKP=512,OP=1024;
constexpr int NW=8,QBLK=32,QB=QBLK*NW,KVBLK=64;
constexpr int ATTN_UNIT_ROWS=QB;
__device__ __forceinline__ int crow(int r,int hi){return (r&3)+8*(r>>2)+4*hi;}
#define SBAR() __builtin_amdgcn_sched_barrier(0)
__device__ __forceinline__ void cmask(f32x16&p0,f32x16&p1,int jb,int wid,int mode){
  const float NEG=-INFINITY;
  const bool m_all=(mode==0)?(jb>(wid>>1)):(jb==3);
  const bool m_hi=m_all||(mode!=0&&jb==2);
  #pragma unroll
  for(int r=0;r<16;++r){ p0[r]=((r>=8)?m_hi:m_all)?NEG:p0[r]; p1[r]=m_hi?NEG:p1[r]; }
}
constexpr int NSLOT=3, SLOTB=8192;
constexpr int LDS_K=0, LDS_V=NSLOT*SLOTB, LDS_WS=3*NSLOT*SLOTB, LDS_OST=0, LDS_BYTES=LDS_WS+NW*64*4;
constexpr float C2=0.125f*1.4426950408889634f;
__device__ __forceinline__ void glds16(const void*gsrc,unsigned lds_dst){unsigned keep;
  asm volatile("s_mov_b32 %0, m0\n\ts_mov_b32 m0, %2\n\ts_nop 0\n\tglobal_load_lds_dwordx4 %1, off\n\ts_mov_b32 m0, %0":"=&s"(keep):"v"(gsrc),"s"(lds_dst):"memory");}
__device__ __forceinline__ float max3f(float a,float b,float c){float r;asm("v_max3_f32 %0, %1, %2, %3":"=v"(r):"v"(a),"v"(b),"v"(c));return r;}
__device__ __forceinline__ float max2f(float a,float b){float r;asm("v_max_f32_e32 %0, %1, %2":"=v"(r):"v"(a),"v"(b));return r;}
__device__ __forceinline__ float fadd_s(float a,float b){float r;asm("v_add_f32_e32 %0, %1, %2":"=v"(r):"v"(a),"v"(b));return r;}
__device__ __forceinline__ float fsub_s(float a,float b){float r;asm("v_sub_f32_e32 %0, %1, %2":"=v"(r):"v"(a),"v"(b));return r;}
typedef float f32x2_t __attribute__((ext_vector_type(2))); typedef __bf16 bf16x2_t __attribute__((ext_vector_type(2)));
__device__ __forceinline__ unsigned cvtpk_s(float lo,float hi){f32x2_t v={lo,hi};bf16x2_t b=__builtin_convertvector(v,bf16x2_t);return __builtin_bit_cast(unsigned,b);}
#define WAIT_BAR(N) asm volatile("s_waitcnt vmcnt(" #N ") lgkmcnt(0)\n\ts_barrier":::"memory")

__device__ __forceinline__ void qkt(f32x16&p0,f32x16&p1,const char*Kslot,const bf16x8*qr,const f32x16&negm,int r32,int hi){
  const char*kb=Kslot+hi*1024+r32*16;
  #pragma unroll
  for(int d0=0;d0<4;++d0){
    const bf16x8 b0=*reinterpret_cast<const bf16x8*>(kb+d0*2048);
    const bf16x8 b1=*reinterpret_cast<const bf16x8*>(kb+d0*2048+512);
    if(d0==0){p0=__builtin_amdgcn_mfma_f32_32x32x16_bf16(b0,qr[0],negm,0,0,0);p1=__builtin_amdgcn_mfma_f32_32x32x16_bf16(b1,qr[0],negm,0,0,0);}
    else{p0=__builtin_amdgcn_mfma_f32_32x32x16_bf16(b0,qr[d0],p0,0,0,0);p1=__builtin_amdgcn_mfma_f32_32x32x16_bf16(b1,qr[d0],p1,0,0,0);}}
}
typedef __attribute__((address_space(3))) const char* lds_cptr;
typedef short v4i16_t __attribute__((ext_vector_type(4)));
__device__ __forceinline__ void kload8(bf16x8*kf,lds_cptr kp){
  kf[0]=*(const __attribute__((address_space(3))) bf16x8*)(kp);      kf[1]=*(const __attribute__((address_space(3))) bf16x8*)(kp+512);
  kf[2]=*(const __attribute__((address_space(3))) bf16x8*)(kp+2048); kf[3]=*(const __attribute__((address_space(3))) bf16x8*)(kp+2560);
  kf[4]=*(const __attribute__((address_space(3))) bf16x8*)(kp+4096); kf[5]=*(const __attribute__((address_space(3))) bf16x8*)(kp+4608);
  kf[6]=*(const __attribute__((address_space(3))) bf16x8*)(kp+6144); kf[7]=*(const __attribute__((address_space(3))) bf16x8*)(kp+6656);
}
__device__ __forceinline__ void kload2(bf16x8*kf,lds_cptr kp,int j){ kf[2*j]=*(const __attribute__((address_space(3))) bf16x8*)(kp+j*2048); kf[2*j+1]=*(const __attribute__((address_space(3))) bf16x8*)(kp+j*2048+512); }
__device__ __forceinline__ s16x4 vtr(lds_cptr p){ return __builtin_bit_cast(s16x4,__builtin_amdgcn_ds_read_tr16_b64_v4i16((__attribute__((address_space(3))) v4i16_t*)p)); }
__device__ __forceinline__ float rowmax(const f32x16&p0,const f32x16&p1){
  float a=max3f(p0[0],p0[1],p1[0]),b=max3f(p0[2],p0[3],p1[1]);a=max3f(a,p1[2],p1[3]);
  #pragma unroll
  for(int r=4;r<16;r+=4){a=max3f(a,p0[r],p0[r+1]);b=max3f(b,p0[r+2],p0[r+3]);a=max3f(a,p1[r],p1[r+1]);b=max3f(b,p1[r+2],p1[r+3]);}
  const float m=max2f(a,b);
  auto rr=__builtin_amdgcn_permlane32_swap(__float_as_uint(m),__float_as_uint(m),false,false);
  return max2f(__uint_as_float(rr[0]),__uint_as_float(rr[1]));
}
__device__ __forceinline__ void pv(f32x16*o,int vb,bf16x8 pa0,bf16x8 pa1,bf16x8 pa2,bf16x8 pa3){
  #pragma unroll
  for(int d0=0;d0<4;++d0){s16x4 lo[4],hi[4];
    #pragma unroll
    for(int ks=0;ks<4;++ks){
      asm volatile("ds_read_b64_tr_b16 %0,%1 offset:%c2":"=&v"(lo[ks]):"v"(vb),"i"(d0*4096+ks*1024):"memory");
      asm volatile("ds_read_b64_tr_b16 %0,%1 offset:%c2":"=&v"(hi[ks]):"v"(vb),"i"(d0*4096+ks*1024+512):"memory");}
    asm volatile("s_waitcnt lgkmcnt(0)":::"memory");SBAR();
    #define PK(k) (bf16x8){lo[k][0],lo[k][1],lo[k][2],lo[k][3],hi[k][0],hi[k][1],hi[k][2],hi[k][3]}
    o[d0]=__builtin_amdgcn_mfma_f32_32x32x16_bf16(pa0,PK(0),o[d0],0,0,0);
    o[d0]=__builtin_amdgcn_mfma_f32_32x32x16_bf16(pa1,PK(1),o[d0],0,0,0);
    o[d0]=__builtin_amdgcn_mfma_f32_32x32x16_bf16(pa2,PK(2),o[d0],0,0,0);
    o[d0]=__builtin_amdgcn_mfma_f32_32x32x16_bf16(pa3,PK(3),o[d0],0,0,0);
    #undef PK
  }
}

#ifndef ATTN_STORE16
#define ATTN_STORE16(p,v) (*(__attribute__((address_space(1))) u32x4*)(p)=(v))
#endif
template<int THRL> __device__ __forceinline__ void attn_unit(const bf16*Qw0,const bf16*__restrict__ Kh,const bf16*__restrict__ Vh,bf16*Ow0,const int NT,const int mode,char*shm,int tid_in){
  int tid_=tid_in; asm volatile("":"+v"(tid_)); const int tid=tid_,lane=tid&63,r32=lane&31,hi=lane>>5; const int wid=__builtin_amdgcn_readfirstlane(tid>>6);
  const bf16*Qw=Qw0+(long)wid*QBLK*QKP;
  const unsigned lds0=(unsigned)(uintptr_t)shm;
  float*wsf=(float*)(shm+LDS_WS)+wid*64;
  const bf16*ksrc=Kh+(long)lane*QKP+wid*8;
  const bf16*vsrc=Vh+(long)(16*(wid&3)+(lane>>2))*QKP+(wid>>2)*32+(lane&3)*8;
  const unsigned kdst=lds0+LDS_K+wid*1024, vdst=lds0+LDS_V+wid*1024;
  #define DMA_K(t,slot) glds16(ksrc+(long)(t)*KVBLK*QKP,(unsigned)__builtin_amdgcn_readfirstlane(kdst+(slot)))
  #define DMA_V(t,slot) do{ glds16(vsrc+(long)(t)*KVBLK*QKP,(unsigned)__builtin_amdgcn_readfirstlane(vdst+2*(slot))); glds16(vsrc+64+(long)(t)*KVBLK*QKP,(unsigned)__builtin_amdgcn_readfirstlane(vdst+2*(slot)+8192)); }while(0)
  const int vb0=(int)(lds0+LDS_V)+((lane>>4)&1)*32+(lane&3)*8+(4*hi+((lane&15)>>2))*64;
  const char*Kbase=shm+LDS_K; bf16x8 kf[8];
  const lds_cptr shm3=(lds_cptr)shm; const lds_cptr kp0=shm3+LDS_K+hi*1024+r32*16; const lds_cptr vp0=shm3+LDS_V+((lane>>4)&1)*32+(lane&3)*8+(4*hi+((lane&15)>>2))*64;
  DMA_K(0,0);DMA_V(0,0);DMA_K(1,SLOTB);
  bf16x8 qr[4];
  #pragma unroll
  for(int d0=0;d0<4;++d0)qr[d0]=*(const __attribute__((address_space(1))) bf16x8*)(&Qw[(long)r32*QKP+d0*16+hi*8]);
  float mhat=0.f,l_reg=0.f;f32x16 o[4];o[0]=f32x16{};o[1]=f32x16{};o[2]=f32x16{};o[3]=f32x16{};f32x16 negm=f32x16{};asm volatile("":"+v"(negm));
  #define CMASK(P0,P1,t) do{int jb_=(t)-(NT-4); if(jb_>=0)cmask(P0,P1,jb_,wid,mode);}while(0)
  bool resc=false;
  #define START(P0,P1) do{ const float rm=rowmax(P0,P1); resc=false; \
    { const float dl=rm; mhat=fadd_s(mhat,dl); \
      _Pragma("unroll") for(int r=0;r<16;++r){P0[r]=fsub_s(P0[r],dl);P1[r]=fsub_s(P1[r],dl);} \
      _Pragma("unroll") for(int r=0;r<16;++r)negm[r]=-mhat; asm volatile("":"+v"(negm)); } \
    _Pragma("unroll") for(int r=0;r<16;++r)P0[r]=__builtin_amdgcn_exp2f(P0[r]); }while(0)
  #define RESC() do{ if(resc){ asm volatile("s_waitcnt lgkmcnt(0)":::"memory"); \
      _Pragma("unroll") for(int d_=0;d_<4;++d_) _Pragma("unroll") for(int r=0;r<16;++r)o[d_][r]*=wsf[crow(r,hi)]; } }while(0)
  f32x16 pA0,pA1,pB0,pB1;
  int sl_prev=0,sl_cur=0,sl_next=SLOTB;
  #define ROT() do{sl_prev=sl_cur;sl_cur=sl_next;sl_next=(sl_next==(NSLOT-1)*SLOTB)?0:sl_next+SLOTB;}while(0)
  DMA_K(2,2*SLOTB);
  WAIT_BAR(3);
  qkt(pA0,pA1,Kbase,qr,negm,r32,hi);asm volatile("s_nop 15\n\ts_nop 7":"+v"(pA0),"+v"(pA1));CMASK(pA0,pA1,0);
  START(pA0,pA1);
  _Pragma("unroll") for(int r=0;r<16;++r)pA1[r]=__builtin_amdgcn_exp2f(pA1[r]);
  WAIT_BAR(0);
  DMA_K(3,0);DMA_V(1,SLOTB);
  ROT();
  kload8(kf,kp0+sl_cur);
  WAIT_BAR(3);
  s16x4 vlo[8],vhi[8]; u32x4 pw0,pw1,pw2,pw3;
  #define PKW(P,B) cvtpk_s(P[B],P[B+1])
  #define PAF(k) __builtin_bit_cast(bf16x8,pw##k)
  #define VFR(i) (bf16x8){vlo[i][0],vlo[i][1],vlo[i][2],vlo[i][3],vhi[i][0],vhi[i][1],vhi[i][2],vhi[i][3]}
  #define PIN(x) asm volatile("":"+v"(x))
  #define MX3(a,b,c) __builtin_fmaxf(__builtin_fmaxf((a),(b)),(c))
  #define GAPA(MF,A0,A1,A2,A3,W0,W1,PW) do{ MF; sacc+=A0; sacc+=A1; sacc+=A2; sacc+=A3; PIN(sacc); W0; W1; PIN(PW); SBAR(); }while(0)
  #define EX(v) __builtin_amdgcn_exp2f(v)
  #define GAPB(MF,X,B) do{ MF; X[B]=EX(X[B]); X[B+1]=EX(X[B+1]); X[B+2]=EX(X[B+2]); X[B+3]=EX(X[B+3]); PIN(X); SBAR(); }while(0)
  #define VRD(s,i) do{ vlo[s]=vtr(vp_+((i)*1024)); vhi[s]=vtr(vp_+((i)*1024+512)); }while(0)
  #define GAPB2(MF,X,B) do{ MF; X[B]=EX(X[B]); X[B+1]=EX(X[B+1]); PIN(X); SBAR(); }while(0)
  #define KRD(G,j) do{ if(G){ kload2(kf,kp0+sl_next,j); SBAR(); } }while(0)
  #define STEP(C0,C1,P0,P1,t,GK,GV,GL) do{ SBAR(); \
    const lds_cptr vp_=vp0+2*sl_prev; \
    VRD(0,0); SBAR(); float sacc=(P0[0]+P0[1]); \
    GAPA(C0=__builtin_amdgcn_mfma_f32_32x32x16_bf16(kf[0],qr[0],negm,0,0,0), P0[2],P0[3],P0[4],P0[5],     pw0[0]=PKW(P0,0), pw0[1]=PKW(P0,2), pw0); \
    VRD(1,4); SBAR(); GAPA(C1=__builtin_amdgcn_mfma_f32_32x32x16_bf16(kf[1],qr[0],negm,0,0,0), P0[6],P0[7],P0[8],P0[9],     pw0[2]=PKW(P0,4), pw0[3]=PKW(P0,6), pw0); \
    VRD(2,8); SBAR(); GAPA(C0=__builtin_amdgcn_mfma_f32_32x32x16_bf16(kf[2],qr[1],C0,0,0,0),   P0[10],P0[11],P0[12],P0[13], pw1[0]=PKW(P0,8), pw1[1]=PKW(P0,10), pw1); \
    VRD(3,12); SBAR(); GAPA(C1=__builtin_amdgcn_mfma_f32_32x32x16_bf16(kf[3],qr[1],C1,0,0,0),   P0[14],P0[15],P1[0],P1[1],   pw1[2]=PKW(P0,12),pw1[3]=PKW(P0,14), pw1); \
    VRD(4,1); SBAR(); GAPA(C0=__builtin_amdgcn_mfma_f32_32x32x16_bf16(kf[4],qr[2],C0,0,0,0),   P1[2],P1[3],P1[4],P1[5],     pw2[0]=PKW(P1,0), pw2[1]=PKW(P1,2), pw2); \
    VRD(5,5); SBAR(); GAPA(C1=__builtin_amdgcn_mfma_f32_32x32x16_bf16(kf[5],qr[2],C1,0,0,0),   P1[6],P1[7],P1[8],P1[9],     pw2[2]=PKW(P1,4), pw2[3]=PKW(P1,6), pw2); \
    VRD(6,9); SBAR(); GAPA(C0=__builtin_amdgcn_mfma_f32_32x32x16_bf16(kf[6],qr[3],C0,0,0,0),   P1[10],P1[11],P1[12],P1[13], pw3[0]=PKW(P1,8), pw3[1]=PKW(P1,10), pw3); \
    VRD(7,13); SBAR(); GAPA(C1=__builtin_amdgcn_mfma_f32_32x32x16_bf16(kf[7],qr[3],C1,0,0,0),   P1[14],P1[15],0.f,0.f,       pw3[2]=PKW(P1,12),pw3[3]=PKW(P1,14), pw3); \
    l_reg+=sacc; \
    if(GK){DMA_K((t)+3,sl_cur);} if(GV){DMA_V((t)+1,sl_next);} \
    CMASK(C0,C1,t); \
    { float a=MX3(C0[0],C0[1],C1[0]),b=MX3(C0[2],C0[3],C1[1]); a=MX3(a,C1[2],C1[3]); \
      _Pragma("unroll") for(int r=4;r<16;r+=4){a=MX3(a,C0[r],C0[r+1]);b=MX3(b,C0[r+2],C0[r+3]);a=MX3(a,C1[r],C1[r+1]);b=MX3(b,C1[r+2],C1[r+3]);} \
      float rm=__builtin_fmaxf(a,b); { auto rr=__builtin_amdgcn_permlane32_swap(__float_as_uint(rm),__float_as_uint(rm),false,false); rm=__builtin_fmaxf(__uint_as_float(rr[0]),__uint_as_float(rr[1])); } \
      resc=false; \
      if(__builtin_expect(__any(rm>(float)THRL),0)){ const float dl=__builtin_fmaxf(rm,0.f); mhat+=dl; \
        _Pragma("unroll") for(int r=0;r<16;++r){C0[r]-=dl;C1[r]-=dl;} \
        _Pragma("unroll") for(int r=0;r<16;++r)negm[r]=-mhat; asm volatile("":"+v"(negm)); \
        const float f=__builtin_amdgcn_exp2f(-dl); l_reg*=f; if(hi==0)wsf[r32]=f; resc=true; } } \
    SBAR(); \
    GAPB2(o[0]=__builtin_amdgcn_mfma_f32_32x32x16_bf16(PAF(0),VFR(0),o[0],0,0,0), C0,0); VRD(0,2); SBAR(); \
    GAPB2(o[1]=__builtin_amdgcn_mfma_f32_32x32x16_bf16(PAF(0),VFR(1),o[1],0,0,0), C0,2); VRD(1,6); SBAR(); \
    GAPB2(o[2]=__builtin_amdgcn_mfma_f32_32x32x16_bf16(PAF(0),VFR(2),o[2],0,0,0), C0,4); VRD(2,10); SBAR(); \
    GAPB2(o[3]=__builtin_amdgcn_mfma_f32_32x32x16_bf16(PAF(0),VFR(3),o[3],0,0,0), C0,6); VRD(3,14); SBAR(); \
    GAPB2(o[0]=__builtin_amdgcn_mfma_f32_32x32x16_bf16(PAF(1),VFR(4),o[0],0,0,0), C0,8); VRD(4,3); SBAR(); \
    GAPB2(o[1]=__builtin_amdgcn_mfma_f32_32x32x16_bf16(PAF(1),VFR(5),o[1],0,0,0), C0,10); VRD(5,7); SBAR(); \
    GAPB2(o[2]=__builtin_amdgcn_mfma_f32_32x32x16_bf16(PAF(1),VFR(6),o[2],0,0,0), C0,12); VRD(6,11); SBAR(); \
    GAPB2(o[3]=__builtin_amdgcn_mfma_f32_32x32x16_bf16(PAF(1),VFR(7),o[3],0,0,0), C0,14); VRD(7,15); SBAR(); \
    GAPB2(o[0]=__builtin_amdgcn_mfma_f32_32x32x16_bf16(PAF(2),VFR(0),o[0],0,0,0), C1,0); \
    GAPB2(o[1]=__builtin_amdgcn_mfma_f32_32x32x16_bf16(PAF(2),VFR(1),o[1],0,0,0), C1,2); \
    KRD(GL,0); GAPB2(o[2]=__builtin_amdgcn_mfma_f32_32x32x16_bf16(PAF(2),VFR(2),o[2],0,0,0), C1,4); \
    KRD(GL,1); GAPB2(o[3]=__builtin_amdgcn_mfma_f32_32x32x16_bf16(PAF(2),VFR(3),o[3],0,0,0), C1,6); \
    KRD(GL,2); GAPB2(o[0]=__builtin_amdgcn_mfma_f32_32x32x16_bf16(PAF(3),VFR(4),o[0],0,0,0), C1,8); \
    KRD(GL,3); GAPB2(o[1]=__builtin_amdgcn_mfma_f32_32x32x16_bf16(PAF(3),VFR(5),o[1],0,0,0), C1,10); \
    GAPB2(o[2]=__builtin_amdgcn_mfma_f32_32x32x16_bf16(PAF(3),VFR(6),o[2],0,0,0), C1,12); \
    GAPB2(o[3]=__builtin_amdgcn_mfma_f32_32x32x16_bf16(PAF(3),VFR(7),o[3],0,0,0), C1,14); \
    }while(0)
  int t=1;
  #undef CMASK
  #define CMASK(P0,P1,t) do{}while(0)
  for(;t+5<NT;t+=2){
    STEP(pB0,pB1,pA0,pA1,t,true,true,true);     WAIT_BAR(3); RESC(); ROT();
    STEP(pA0,pA1,pB0,pB1,t+1,true,true,true);   WAIT_BAR(3); RESC(); ROT();
  }
  #undef CMASK
  #define CMASK(P0,P1,t) do{int jb_=(t)-(NT-4); if(jb_>=0)cmask(P0,P1,jb_,wid,mode);}while(0)
  #define ENDW(tt) do{ if((tt)+3<NT){WAIT_BAR(3);} else if((tt)+2<NT){WAIT_BAR(2);} else {WAIT_BAR(0);} }while(0)
  for(;t+1<NT;t+=2){
    STEP(pB0,pB1,pA0,pA1,t,(t+3<NT),(t+1<NT),(t+1<NT));       ENDW(t);   RESC(); ROT();
    STEP(pA0,pA1,pB0,pB1,t+1,(t+4<NT),(t+2<NT),(t+2<NT));     ENDW(t+1); RESC(); ROT();
  }
  STEP(pB0,pB1,pA0,pA1,NT-1,false,false,false); RESC();
  { float sacc=pB0[0]+pB0[1]; _Pragma("unroll") for(int r=2;r<16;++r)sacc+=pB0[r]; _Pragma("unroll") for(int r=0;r<16;++r)sacc+=pB1[r]; l_reg+=sacc;
    pw0=(u32x4){PKW(pB0,0),PKW(pB0,2),PKW(pB0,4),PKW(pB0,6)};pw1=(u32x4){PKW(pB0,8),PKW(pB0,10),PKW(pB0,12),PKW(pB0,14)};pw2=(u32x4){PKW(pB1,0),PKW(pB1,2),PKW(pB1,4),PKW(pB1,6)};pw3=(u32x4){PKW(pB1,8),PKW(pB1,10),PKW(pB1,12),PKW(pB1,14)};
    SBAR(); pv(o,vb0+2*sl_cur,PAF(0),PAF(1),PAF(2),PAF(3)); }
  #undef PKW
  #undef PAF
  #undef VFR
  #undef PIN
  #undef MX3
  #undef GAPA
  #undef GAPB
  #undef EX
  #undef VRD
  #undef KRD
  #undef STEP
  #undef ENDW
  {auto rr=__builtin_amdgcn_permlane32_swap(__float_as_uint(l_reg),__float_as_uint(l_reg),false,false);l_reg=__uint_as_float(rr[0])+__uint_as_float(rr[1]);}
  if(hi==0)wsf[32+r32]=l_reg;asm volatile("s_waitcnt lgkmcnt(0)":::"memory");
  float rli[16];
  #pragma unroll
  for(int r=0;r<16;++r)rli[r]=__builtin_amdgcn_rcpf(wsf[32+crow(r,hi)]);
  bf16*Ow=Ow0+(long)wid*QBLK*OP;
  asm volatile("s_waitcnt lgkmcnt(0)\n\ts_barrier":::"memory");
  { bf16*stg=(bf16*)(shm+LDS_OST)+wid*4096;
    #pragma unroll
    for(int r=0;r<16;++r){const int orow=crow(r,hi);
      #pragma unroll
      for(int d0=0;d0<4;++d0)stg[orow*128+d0*32+r32]=__float2bfloat16(o[d0][r]*rli[r]);}
    asm volatile("s_waitcnt lgkmcnt(0)":::"memory");
    #pragma unroll
    for(int i=0;i<8;++i){const int row=i*4+(lane>>4),ch=lane&15; const u32x4 v=*(const u32x4*)(stg+row*128+ch*8); ATTN_STORE16(Ow+(long)row*OP+ch*8,v);} }
  asm volatile("s_waitcnt lgkmcnt(0)\n\ts_barrier":::"memory");
  #undef DMA_K
  #undef DMA_V
  #undef CMASK
  #undef START
  #undef RESC
  #undef ROT
}
constexpr int ATTN_LDS_BYTES=LDS_BYTES;
#undef SBAR
#undef WAIT_BAR
}
#ifndef CPU_TEST
namespace mixf {
typedef short bf16x8 __attribute__((ext_vector_type(8)));
typedef float f32x4 __attribute__((ext_vector_type(4)));
typedef unsigned u32x4 __attribute__((ext_vector_type(4)));
typedef unsigned u32x2 __attribute__((ext_vector_type(2)));
constexpr int DAB_LD = 264;
__device__ __forceinline__ float fsig(float x) { return __builtin_amdgcn_rcpf(1.0f + __expf(-x)); }
__device__ __forceinline__ float wsum(float v, int lane) {
#pragma unroll
    for (int o = 1; o < 64; o <<= 1) v += __builtin_bit_cast(float, __builtin_amdgcn_ds_bpermute((lane ^ o) << 2, __builtin_bit_cast(int, v)));
    return v;
}
__device__ __forceinline__ unsigned pk2f(float lo, float hi) { return f2bf(lo) | (f2bf(hi) << 16); }

__device__ __forceinline__ void unpack8(const u32x4 w, float* o) {
    o[0] = __builtin_bit_cast(float, w.x << 16); o[1] = __builtin_bit_cast(float, w.x & 0xffff0000u); o[2] = __builtin_bit_cast(float, w.y << 16); o[3] = __builtin_bit_cast(float, w.y & 0xffff0000u);
    o[4] = __builtin_bit_cast(float, w.z << 16); o[5] = __builtin_bit_cast(float, w.z & 0xffff0000u); o[6] = __builtin_bit_cast(float, w.w << 16); o[7] = __builtin_bit_cast(float, w.w & 0xffff0000u);
}
__device__ __forceinline__ u32x4 pack8(const float* v) { u32x4 w; w.x = pk2f(v[0], v[1]); w.y = pk2f(v[2], v[3]); w.z = pk2f(v[4], v[5]); w.w = pk2f(v[6], v[7]); return w; }
__device__ __forceinline__ void st8f(float* p, const float* v) { *(f32x4*)p = (f32x4){v[0], v[1], v[2], v[3]}; *(f32x4*)(p + 4) = (f32x4){v[4], v[5], v[6], v[7]}; }
__device__ __forceinline__ void ld8f(const float* p, float* v) { const f32x4 a = *(const f32x4*)p, c = *(const f32x4*)(p + 4); v[0] = a[0]; v[1] = a[1]; v[2] = a[2]; v[3] = a[3]; v[4] = c[0]; v[5] = c[1]; v[6] = c[2]; v[7] = c[3]; }
constexpr int TG_OFF = 0, TC_OFF = 62 * 512, TB_OFF = TC_OFF + 34 * 512, TU_OFF = TB_OFF + 32 * 512, DAB_OFF = TU_OFF + 47 * 512, MIX_LDS_END = DAB_OFF + 32 * DAB_LD * 2;
static_assert(MIX_LDS_END <= 131072 && (34 + 32) * 512 >= 32 * 1024, "mixer-prep LDS map");
template <int NR> __device__ __forceinline__ void item(const MixP& P, const MixItem& I, const bf16_t* __restrict__ WTg, int tid, LAS unsigned char* L) {
    constexpr int HR = NR / 2, RPT = NR / 16;
    LAS bf16_t* TG = (LAS bf16_t*)(L + TG_OFF); LAS bf16_t* TC = (LAS bf16_t*)(L + TC_OFF); LAS bf16_t* TB = (LAS bf16_t*)(L + TB_OFF); LAS bf16_t* TU = (LAS bf16_t*)(L + TU_OFF);
    LAS bf16_t* DAB = (LAS bf16_t*)(L + DAB_OFF); LAS float* cv = (LAS float*)(L + TC_OFF);
    const int ch = tid & 255, half = tid >> 8, lane = tid & 63, wid = tid >> 6, l = P.layer, b = I.b, t0 = I.t0;
    const int cg = tid & 31, rs = tid >> 5, ch0 = cg * 8;
    const bool smp = I.sample != 0;
    const size_t mb = smp ? (size_t)SEQ + (size_t)DECS * b : 0;
    const bf16_t* __restrict__ Z = P.Z;
    {
        u32x4 qa[4], qg[4], qc[3], qs[3], qu[3], qb[2];
        const u32x4 z4 = {0u, 0u, 0u, 0u};
#pragma unroll
        for (int k = 0; k < 4; ++k) { const int i = rs + 16 * k, t = t0 - 30 + i; qa[k] = z4; qg[k] = z4; if (i < NR + 30 && t >= 0) { const bf16_t* zr = Z + (mb + t) * ZW + ch0; qa[k] = *(const u32x4*)(zr + 1024); qg[k] = *(const u32x4*)(zr + 1280); } }
#pragma unroll
        for (int k = 0; k < 3; ++k) { const int i = rs + 16 * k, t = t0 - 2 + i; qc[k] = z4; qs[k] = z4; if (i < NR + 2 && t >= 0) { const bf16_t* zr = Z + (mb + t) * ZW + ch0; qc[k] = *(const u32x4*)(zr + 512); qs[k] = *(const u32x4*)(zr + 768); } }
#pragma unroll
        for (int k = 0; k < 3; ++k) { const int i = rs + 16 * k, t = t0 - 15 + i; qu[k] = z4; if (i < NR + 15 && t >= 0) qu[k] = *(const u32x4*)(Z + (mb + t) * ZW + ch0); }
#pragma unroll
        for (int k = 0; k < 2; ++k) { const int i = rs + 16 * k; qb[k] = z4; if (i < NR) qb[k] = *(const u32x4*)(Z + (mb + t0 + i) * ZW + 256 + ch0); }
#pragma unroll
        for (int k = 0; k < 4; ++k) { const int i = rs + 16 * k, t = t0 - 30 + i;
            if (i < NR + 30) { float v[8];
                if (t >= 0) { float a[8], g[8]; unpack8(qa[k], a); unpack8(qg[k], g);
#pragma unroll
                    for (int j = 0; j < 8; ++j) v[j] = a[j] * fsig(g[j]); }
                else if (smp) ld8f(P.st_cconv + ((size_t)b * 30 + (30 + t)) * 256 + ch0, v);
                else {
#pragma unroll
                    for (int j = 0; j < 8; ++j) v[j] = 0.f; }
                *(LAS u32x4*)(TG + i * 256 + ch0) = pack8(v);
                if (!smp) { if (t >= t0 && t >= SEQ - 30) st8f(P.out + O_CCP + ((size_t)l * 30 + (t - (SEQ - 30))) * 256 + ch0, v); }
                else { if (t + 14 >= 0) st8f(P.out + O_CCS + (((size_t)l * DECB + b) * 30 + (t + 14)) * 256 + ch0, v); } } }
#pragma unroll
        for (int k = 0; k < 3; ++k) { const int i = rs + 16 * k, t = t0 - 2 + i;
            if (i < NR + 2) { float v[8];
                if (t >= 0) { float a[8], g[8]; unpack8(qc[k], a); unpack8(qs[k], g);
#pragma unroll
                    for (int j = 0; j < 8; ++j) v[j] = a[j] * g[j]; }
                else if (smp) ld8f(P.st_sconv + ((size_t)b * 2 + (2 + t)) * 256 + ch0, v);
                else {
#pragma unroll
                    for (int j = 0; j < 8; ++j) v[j] = 0.f; }
                *(LAS u32x4*)(TC + i * 256 + ch0) = pack8(v);
                if (!smp) { if (t >= t0 && t >= SEQ - 2) st8f(P.out + O_SCP + ((size_t)l * 2 + (t - (SEQ - 2))) * 256 + ch0, v); }
                else { if (t >= DECS - 2) st8f(P.out + O_SCS + (((size_t)l * DECB + b) * 2 + (t - (DECS - 2))) * 256 + ch0, v); } } }
#pragma unroll
        for (int k = 0; k < 3; ++k) { const int i = rs + 16 * k, t = t0 - 15 + i;
            if (i < NR + 15) { float v[8];
                if (t >= 0) unpack8(qu[k], v);
                else if (smp) ld8f(P.st_pool + ((size_t)b * 15 + (15 + t)) * 256 + ch0, v);
                else {
#pragma unroll
                    for (int j = 0; j < 8; ++j) v[j] = 0.f; }
                *(LAS u32x4*)(TU + i * 256 + ch0) = (t >= 0) ? qu[k] : pack8(v);
                if (!smp) { if (t >= t0 && t >= SEQ - 15) st8f(P.out + O_POOLP + ((size_t)l * 15 + (t - (SEQ - 15))) * 256 + ch0, v); }
                else { if (t >= 1) st8f(P.out + O_POOLS + (((size_t)l * DECB + b) * 15 + (t - 1)) * 256 + ch0, v); } } }
#pragma unroll
        for (int k = 0; k < 2; ++k) { const int i = rs + 16 * k; if (i < NR) *(LAS u32x4*)(TB + i * 256 + ch0) = qb[k]; }
    }
    __syncthreads();
    {
        float w0[8], w1[8], w2[8]; ld8f(P.sconv_w + ch0, w0); ld8f(P.sconv_w + 256 + ch0, w1); ld8f(P.sconv_w + 512 + ch0, w2);
#pragma unroll
        for (int j = 0; j < RPT; ++j) { const int r = rs * RPT + j; float c0[8], c1[8], c2[8], zb[8], y[8];
            unpack8(*(const LAS u32x4*)(TC + r * 256 + ch0), c0); unpack8(*(const LAS u32x4*)(TC + (r + 1) * 256 + ch0), c1); unpack8(*(const LAS u32x4*)(TC + (r + 2) * 256 + ch0), c2);
            unpack8(*(const LAS u32x4*)(TB + r * 256 + ch0), zb);
#pragma unroll
            for (int q = 0; q < 8; ++q) y[q] = zb[q] * (w0[q] * c0[q] + w1[q] * c1[q] + w2[q] * c2[q]);
            *(u32x4*)(P.Y + (mb + t0 + r) * YW + 256 + ch0) = pack8(y); }
    }
    {
        float u[HR + 15];
#pragma unroll
        for (int i = 0; i < HR + 15; ++i) u[i] = bf2f(TU[(half * HR + i) * 256 + ch]);
        const int win = 2 << (ch >> 6);
#pragma unroll
        for (int r = 0; r < HR; ++r) { const int t = t0 + half * HR + r; float s = 0.f;
#pragma unroll
            for (int j = 0; j < 16; ++j) if (j < win) s += u[15 + r - j];
            const int pos = smp ? PAST + t : t; const int cnt = (pos + 1 < win) ? pos + 1 : win;
            DAB[(half * HR + r) * DAB_LD + ch] = (bf16_t)f2bf(s / (float)cnt - u[15 + r]); }
    }
    __syncthreads();
    {
        float g[HR + 30];
#pragma unroll
        for (int i = 0; i < HR + 30; ++i) g[i] = bf2f(TG[(half * HR + i) * 256 + ch]);
        float w[31];
#pragma unroll
        for (int j = 0; j < 31; ++j) w[j] = P.cconv_w[j * 256 + ch];
#pragma unroll
        for (int r = 0; r < HR; ++r) { float a = 0.f;
#pragma unroll
            for (int j = 0; j < 31; ++j) a += w[j] * g[r + j];
            cv[(half * HR + r) * 256 + ch] = a; }
    }
    {
        const int fr = lane & 15, fq = lane >> 4, g4 = wid >> 1, nt0 = (wid & 1) * 2;
        bf16x8 Bw[2][2], Ad[2][2];
#pragma unroll
        for (int nt = 0; nt < 2; ++nt)
#pragma unroll
            for (int ks = 0; ks < 2; ++ks) Bw[nt][ks] = *(const bf16x8*)(WTg + (size_t)(g4 * 64 + (nt0 + nt) * 16 + fr) * 64 + ks * 32 + fq * 8);
#pragma unroll
        for (int mt = 0; mt < NR / 16; ++mt)
#pragma unroll
            for (int ks = 0; ks < 2; ++ks) Ad[mt][ks] = *(const LAS bf16x8*)(DAB + (mt * 16 + fr) * DAB_LD + g4 * 64 + ks * 32 + fq * 8);
#pragma unroll
        for (int mt = 0; mt < NR / 16; ++mt)
#pragma unroll
            for (int nt = 0; nt < 2; ++nt) { f32x4 acc = {0.f, 0.f, 0.f, 0.f};
                acc = __builtin_amdgcn_mfma_f32_16x16x32_bf16(Bw[nt][0], Ad[mt][0], acc, 0, 0, 0);
                acc = __builtin_amdgcn_mfma_f32_16x16x32_bf16(Bw[nt][1], Ad[mt][1], acc, 0, 0, 0);
                const int col = g4 * 64 + (nt0 + nt) * 16 + 4 * fq; const f32x4 sc = *(const f32x4*)(P.pool_scale + col);
                u32x2 wv; wv.x = pk2f(acc[0] * sc[0], acc[1] * sc[1]); wv.y = pk2f(acc[2] * sc[2], acc[3] * sc[3]);
                *(u32x2*)(P.Y + (mb + t0 + mt * 16 + fr) * YW + col) = wv; }
    }
    __syncthreads();
    {
        const f32x4 bi = *(const f32x4*)(P.cconv_b + 4 * lane), lg = *(const f32x4*)(P.ln_g + 4 * lane), lb = *(const f32x4*)(P.ln_b + 4 * lane);
#pragma unroll
        for (int k = 0; k < NR / 8; ++k) { const int r = wid + 8 * k;
            f32x4 v = *(const LAS f32x4*)(cv + r * 256 + 4 * lane) + bi;
            const float mean = wsum((v[0] + v[1]) + (v[2] + v[3]), lane) * (1.f / 256.f);
            v = v - mean;
            const float rstd = 1.0f / sqrtf(wsum((v[0] * v[0] + v[1] * v[1]) + (v[2] * v[2] + v[3] * v[3]), lane) * (1.f / 256.f) + EPS);
            f32x4 y = v * rstd * lg + lb;
#pragma unroll
            for (int i = 0; i < 4; ++i) y[i] = y[i] * fsig(y[i]);
            u32x2 wv; wv.x = pk2f(y[0], y[1]); wv.y = pk2f(y[2], y[3]);
            *(u32x2*)(P.Y + (mb + t0 + r) * YW + 512 + 4 * lane) = wv; }
    }
    {
        const int map = lane >> 3, c8 = lane & 7, cm = c8 & 3;
        float gq[8], gk[8]; ld8f(P.qg + 8 * c8, gq); ld8f(P.kg + 8 * c8, gk);
        const float sgn = (c8 < 4) ? -1.0f : 1.0f;
#pragma unroll
        for (int k = 0; k < NR / 8; ++k) { const int rr = wid * (NR / 8) + k, t = t0 + rr; const int pos = smp ? PAST + t : t;
            float co[8], si[8]; ld8f(P.rope + (size_t)pos * 64 + 8 * cm, co); ld8f(P.rope + (size_t)pos * 64 + 32 + 8 * cm, si);
            const bf16_t* src = Z + (mb + t) * ZW + 1536 + lane * 8;
            const u32x4 wq = *(const u32x4*)src, wk = *(const u32x4*)(src + 512);
#pragma unroll
            for (int kind = 0; kind < 2; ++kind) { float v[8]; unpack8(kind ? wk : wq, v);
                float ss = 0.f;
#pragma unroll
                for (int j = 0; j < 8; ++j) ss += v[j] * v[j];
                ss += __builtin_bit_cast(float, __builtin_amdgcn_ds_bpermute((lane ^ 1) << 2, __builtin_bit_cast(int, ss)));
                ss += __builtin_bit_cast(float, __builtin_amdgcn_ds_bpermute((lane ^ 2) << 2, __builtin_bit_cast(int, ss)));
                ss += __builtin_bit_cast(float, __builtin_amdgcn_ds_bpermute((lane ^ 4) << 2, __builtin_bit_cast(int, ss)));
                const float rn = 1.0f / sqrtf(ss * (1.f / 64.f) + EPS);
                float a[8], o[8];
#pragma unroll
                for (int j = 0; j < 8; ++j) a[j] = v[j] * rn * (kind ? gk[j] : gq[j]);
#pragma unroll
                for (int j = 0; j < 8; ++j) { const float ap = __builtin_bit_cast(float, __builtin_amdgcn_ds_bpermute((lane ^ 4) << 2, __builtin_bit_cast(int, a[j])));
                    o[j] = a[j] * co[j] + sgn * ap * si[j]; }
                if (kind == 0) {
#pragma unroll
                    for (int j = 0; j < 8; ++j) o[j] *= C2;
                    bf16_t* dst = smp ? P.QS + ((size_t)b * QSROWS + t) * 512 + lane * 8 : P.Qp + (size_t)t * 512 + lane * 8;
                    *(u32x4*)dst = pack8(o);
                } else {
                    if (!smp) *(u32x4*)(P.Kp + (size_t)t * 512 + lane * 8) = pack8(o);
                    st8f(smp ? P.out + O_KS + (((size_t)l * DECB + b) * DECS + t) * 512 + lane * 8 : P.out + O_KP + ((size_t)l * SEQ + t) * 512 + lane * 8, o);
                }
            }
        }
#pragma unroll
        for (int k = 0; k < NR / 8; ++k) { const int idx = tid + 512 * k, r2 = idx >> 6, c8 = (idx & 63) * 8, t = t0 + r2;
            const u32x4 w = *(const u32x4*)(Z + (mb + t) * ZW + 2560 + c8);
            if (!smp) *(u32x4*)(P.Vp + (size_t)t * 512 + c8) = w;
            f32x4* od = (f32x4*)(smp ? P.out + O_VS + (((size_t)l * DECB + b) * DECS + t) * 512 + c8 : P.out + O_VP + ((size_t)l * SEQ + t) * 512 + c8);
            od[0] = (f32x4){__builtin_bit_cast(float, w.x << 16), __builtin_bit_cast(float, w.x & 0xffff0000u), __builtin_bit_cast(float, w.y << 16), __builtin_bit_cast(float, w.y & 0xffff0000u)};
            od[1] = (f32x4){__builtin_bit_cast(float, w.z << 16), __builtin_bit_cast(float, w.z & 0xffff0000u), __builtin_bit_cast(float, w.w << 16), __builtin_bit_cast(float, w.w & 0xffff0000u)}; }
    }
    __syncthreads();
}
}
#endif
#ifndef CPU_TEST_NEVER
namespace tailg {
#define TG_GAS __attribute__((address_space(1)))
typedef short bf16x8 __attribute__((ext_vector_type(8)));
typedef float f32x4 __attribute__((ext_vector_type(4)));
typedef unsigned u32x2 __attribute__((ext_vector_type(2)));
constexpr int TM = 32, TN = 64, NTILES = (MS / TM) * (D / TN);
template <int MODE> struct Tail {
    const bf16_t* A; const bf16_t* Bt;
    float* X; bf16_t* XB; float* SSP;
    bf16_t* OUT; const bf16_t* gate;
    int K, lda, ldb, ldg; float s; int pad;
};
template <int MODE> __device__ __forceinline__ void run(LAS unsigned char* lds, int tid, int bx, int G, const Tail<MODE>& t) {
    const int lane = tid & 63, w = __builtin_amdgcn_readfirstlane(tid >> 6), fr = lane & 15, fq = lane >> 4;
    LAS f32x4* RED = (LAS f32x4*)lds;
    const int nsteps = t.K / 32, per = nsteps / 8;
    for (int tile = bx; tile < NTILES; tile += G) {
        const int R0 = SEQ + (tile >> 4) * TM, C0 = (tile & 15) * TN;
        const bf16_t* ap = t.A + (size_t)(R0 + fr) * t.lda + fq * 8;
        const bf16_t* bp = t.Bt + (size_t)(C0 + fr) * t.ldb + fq * 8;
        f32x4 acc[2][4], tot[2][4];
#pragma unroll
        for (int m = 0; m < 2; ++m)
#pragma unroll
            for (int n = 0; n < 4; ++n) { acc[m][n] = (f32x4){0.f, 0.f, 0.f, 0.f}; tot[m][n] = (f32x4){0.f, 0.f, 0.f, 0.f}; }
        const int s0 = w * per;
        for (int sb = 0; sb < per; sb += 6) {
            bf16x8 af[6][2], bf[6][4];
#pragma unroll
            for (int j = 0; j < 6; ++j) if (sb + j < per) { const int k0 = (s0 + sb + j) * 32;
#pragma unroll
                for (int m = 0; m < 2; ++m) af[j][m] = *(const TG_GAS bf16x8*)(ap + (size_t)(m * 16) * t.lda + k0);
#pragma unroll
                for (int n = 0; n < 4; ++n) bf[j][n] = *(const TG_GAS bf16x8*)(bp + (size_t)(n * 16) * t.ldb + k0); }
#pragma unroll
            for (int j = 0; j < 6; ++j) if (sb + j < per) {
#pragma unroll
                for (int m = 0; m < 2; ++m)
#pragma unroll
                    for (int n = 0; n < 4; ++n) acc[m][n] = __builtin_amdgcn_mfma_f32_16x16x32_bf16(bf[j][n], af[j][m], acc[m][n], 0, 0, 0);
                if (MODE == 1) {
                    const int st = s0 + sb + j, br = st < 8 ? 0 : st < 16 ? 1 : st < 24 ? 2 : 3, nx = st + 1, brn = nx < 8 ? 0 : nx < 16 ? 1 : nx < 24 ? 2 : 3;
                    if (brn != br || sb + j + 1 == per) {
#pragma unroll
                        for (int m = 0; m < 2; ++m)
#pragma unroll
                            for (int n = 0; n < 4; ++n) { const bf16_t* fp = t.gate + (size_t)(R0 + m * 16 + fr) * t.ldg + C0 + n * 16 + 4 * fq;
                                f32x4 g = {1.f, 1.f, 1.f, 1.f};
#pragma unroll
                                for (int q = 3; q >= 0; --q) if (q >= br) { const u32x2 gw = *(const TG_GAS u32x2*)(fp + q * 1024);
                                    g[0] *= __builtin_bit_cast(float, gw.x << 16); g[1] *= __builtin_bit_cast(float, gw.x & 0xffff0000u); g[2] *= __builtin_bit_cast(float, gw.y << 16); g[3] *= __builtin_bit_cast(float, gw.y & 0xffff0000u); }
                                tot[m][n] += g * acc[m][n]; acc[m][n] = (f32x4){0.f, 0.f, 0.f, 0.f}; }
                    }
                }
            }
        }
#pragma unroll
        for (int m = 0; m < 2; ++m)
#pragma unroll
            for (int n = 0; n < 4; ++n) RED[(w * 8 + m * 4 + n) * 64 + lane] = (MODE == 1) ? tot[m][n] : acc[m][n];
        __syncthreads();
        f32x4 v = RED[(0 * 8 + w) * 64 + lane];
#pragma unroll
        for (int w2 = 1; w2 < 8; ++w2) v += RED[(w2 * 8 + w) * 64 + lane];
        const size_t row = (size_t)(R0 + (w >> 2) * 16 + fr); const int col = C0 + (w & 3) * 16 + 4 * fq;
        if (MODE == 0) { const u32x2 xw = *(const TG_GAS u32x2*)(t.XB + row * D + col);
            f32x4 xn; xn[0] = __builtin_bit_cast(float, xw.x << 16); xn[1] = __builtin_bit_cast(float, xw.x & 0xffff0000u); xn[2] = __builtin_bit_cast(float, xw.y << 16); xn[3] = __builtin_bit_cast(float, xw.y & 0xffff0000u);
            xn += v * t.s;
            if (t.X) *(TG_GAS f32x4*)(t.X + row * D + col) = xn;
            else { u32x2 o; o.x = f2bf(xn[0]) | (f2bf(xn[1]) << 16); o.y = f2bf(xn[2]) | (f2bf(xn[3]) << 16); *(TG_GAS u32x2*)(t.XB + row * D + col) = o; }
            float ss = (xn[0] * xn[0] + xn[1] * xn[1]) + (xn[2] * xn[2] + xn[3] * xn[3]);
            ss += __builtin_bit_cast(float, __builtin_amdgcn_ds_bpermute((lane ^ 16) << 2, __builtin_bit_cast(int, ss)));
            ss += __builtin_bit_cast(float, __builtin_amdgcn_ds_bpermute((lane ^ 32) << 2, __builtin_bit_cast(int, ss)));
            __syncthreads();
            LAS float* PS = (LAS float*)lds;
            if (fq == 0) PS[((w >> 2) * 16 + fr) * 4 + (w & 3)] = ss;
            __syncthreads();
            if (tid < TM) t.SSP[(size_t)(R0 - SEQ + tid) * 16 + (tile & 15)] = (PS[tid * 4] + PS[tid * 4 + 1]) + (PS[tid * 4 + 2] + PS[tid * 4 + 3]); }
        else { u32x2 o; o.x = f2bf(v[0]) | (f2bf(v[1]) << 16); o.y = f2bf(v[2]) | (f2bf(v[3]) << 16); *(TG_GAS u32x2*)(t.OUT + row * D + col) = o; }
        __syncthreads();
    }
}
}
#endif
#ifndef CPU_TEST
namespace sattn {
using attn_body::bf16x8; using attn_body::f32x16; using attn_body::s16x4; using attn_body::crow; using attn_body::vtr; using attn_body::lds_cptr; using attn_body::cvtpk_s;
typedef float f32x4 __attribute__((ext_vector_type(4)));
typedef float f32x2 __attribute__((ext_vector_type(2)));
typedef unsigned u32x4 __attribute__((ext_vector_type(4)));
#define SA_GAS __attribute__((address_space(1)))
constexpr int PART_LD = 132;
constexpr int N_ITEMS = DECB * 4 * 2;
__device__ __forceinline__ bf16x8 pack8f(const f32x4 a, const f32x4 c) { u32x4 w; w.x = cvtpk_s(a[0], a[1]); w.y = cvtpk_s(a[2], a[3]); w.z = cvtpk_s(c[0], c[1]); w.w = cvtpk_s(c[2], c[3]); return __builtin_bit_cast(bf16x8, w); }

__device__ __forceinline__ void item(int it, const float* __restrict__ ck, const float* __restrict__ cv, const float* __restrict__ knew, const float* __restrict__ vnew, const bf16_t* __restrict__ QS, float* PART,
                                     LAS unsigned char* lds, LAS float* ex, int tid) {
    const int lane = tid & 63, w = __builtin_amdgcn_readfirstlane(tid >> 6), r32 = lane & 31, hi = lane >> 5;
    const int b = it >> 3, h = (it >> 1) & 3, kh = it & 1;
    LAS float* EXM = ex; LAS float* wsf = ex + 512 + w * 32;
    bf16x8 qn[4]; const bool mp1 = (r32 >> 4) != 0;
    { const int q = r32 & 15, mp = r32 >> 4; const bf16_t* qrow = QS + ((size_t)b * QSROWS + q) * 512 + (2 * h + mp) * 64 + hi * 8;
#pragma unroll
      for (int j = 0; j < 4; ++j) qn[j] = *(const SA_GAS bf16x8*)(qrow + j * 16); }
    float m = -INFINITY, l = 0.f; f32x16 o[4];
#pragma unroll
    for (int d = 0; d < 4; ++d) o[d] = f32x16{};
    LAS unsigned char* vbuf = lds + w * 8192;
    const lds_cptr vp = (lds_cptr)vbuf + ((lane >> 4) & 1) * 32 + (lane & 3) * 8 + (4 * hi + ((lane & 15) >> 2)) * 64;
    const int nsteps = (kh == 1 && w == 7) ? 5 : 4;
    f32x4 ka[8], kc[8], va[2][4], vc[2][4];
#define SA_STEP_PTRS(ss, Kp_, Vp_, nv_) do { if ((ss) < 4) { const size_t k0_ = (size_t)b * PAST + 1024 * kh + 128 * w + 32 * (ss); Kp_ = ck + k0_ * 512 + h * 128; Vp_ = cv + k0_ * 512 + h * 128; nv_ = 32; } \
        else { Kp_ = knew + (size_t)b * DECS * 512 + h * 128; Vp_ = vnew + (size_t)b * DECS * 512 + h * 128; nv_ = DECS; } } while (0)
#define SA_LOAD_K(ss) do { const float* Kp_; const float* Vp_; int nv_; SA_STEP_PTRS(ss, Kp_, Vp_, nv_); (void)Vp_; int t_ = tid; asm volatile("" : "+v"(t_)); const int r_ = t_ & 31, h_ = (t_ >> 5) & 1; \
        const int krow_ = r_ < nv_ ? r_ : nv_ - 1; const SA_GAS f32x4* kp_ = (const SA_GAS f32x4*)(Kp_ + (size_t)krow_ * 512 + h_ * 8); \
        _Pragma("unroll") for (int j = 0; j < 8; ++j) { ka[j] = kp_[j * 4]; kc[j] = kp_[j * 4 + 1]; } } while (0)
#define SA_LOAD_V(ss) do { const float* Kp_; const float* Vp_; int nv_; SA_STEP_PTRS(ss, Kp_, Vp_, nv_); (void)Kp_; \
        int t_ = tid; asm volatile("" : "+v"(t_)); const int k16_ = (t_ & 63) >> 2, c4_ = t_ & 3; \
        _Pragma("unroll") for (int kq = 0; kq < 2; ++kq) { const int vr_ = kq * 16 + k16_, vrow_ = vr_ < nv_ ? vr_ : nv_ - 1; const SA_GAS f32x4* vpn_ = (const SA_GAS f32x4*)(Vp_ + (size_t)vrow_ * 512 + c4_ * 8); \
            _Pragma("unroll") for (int db = 0; db < 4; ++db) { va[kq][db] = vpn_[db * 8]; vc[kq][db] = vpn_[db * 8 + 1]; } } } while (0)
    SA_LOAD_K(0);
    for (int s = 0; s < nsteps; ++s) {
        const int nvalid = (s < 4) ? 32 : DECS;
        SA_LOAD_V(s);
        __builtin_amdgcn_sched_barrier(0);
        f32x16 S = f32x16{};
#pragma unroll
        for (int j = 0; j < 8; ++j) { const bf16x8 z8 = {0, 0, 0, 0, 0, 0, 0, 0}; const bf16x8 qb = ((j >= 4) == mp1) ? qn[j & 3] : z8; S = __builtin_amdgcn_mfma_f32_32x32x16_bf16(pack8f(ka[j], kc[j]), qb, S, 0, 0, 0); }
        if (nvalid < 32) {
#pragma unroll
            for (int r = 0; r < 16; ++r) if (crow(r, hi) >= nvalid) S[r] = -INFINITY; }
        float rm = S[0];
#pragma unroll
        for (int r = 1; r < 16; ++r) rm = fmaxf(rm, S[r]);
        { auto rr = __builtin_amdgcn_permlane32_swap(__float_as_uint(rm), __float_as_uint(rm), false, false); rm = fmaxf(__uint_as_float(rr[0]), __uint_as_float(rr[1])); }
        const float mn = fmaxf(m, rm), alpha = __builtin_amdgcn_exp2f(m - mn); m = mn;
        float ls = 0.f;
#pragma unroll
        for (int r = 0; r < 16; ++r) { S[r] = __builtin_amdgcn_exp2f(S[r] - mn); ls += S[r]; }
        l = l * alpha + ls;
        u32x4 pw0, pw1;
        pw0 = (u32x4){cvtpk_s(S[0], S[1]), cvtpk_s(S[2], S[3]), cvtpk_s(S[4], S[5]), cvtpk_s(S[6], S[7])};
        pw1 = (u32x4){cvtpk_s(S[8], S[9]), cvtpk_s(S[10], S[11]), cvtpk_s(S[12], S[13]), cvtpk_s(S[14], S[15])};
        if (hi == 0) wsf[r32] = alpha;
        __builtin_amdgcn_sched_barrier(0);
        if (s + 1 < nsteps) SA_LOAD_K(s + 1);
        __builtin_amdgcn_sched_barrier(0);
#pragma unroll
        for (int kq = 0; kq < 2; ++kq)
#pragma unroll
            for (int db = 0; db < 4; ++db) *(LAS bf16x8*)(vbuf + (db * 2 + kq) * 1024 + lane * 16) = pack8f(va[kq][db], vc[kq][db]);
        asm volatile("s_waitcnt lgkmcnt(0)" ::: "memory");
#pragma unroll
        for (int d = 0; d < 4; ++d)
#pragma unroll
            for (int r = 0; r < 16; ++r) o[d][r] *= wsf[crow(r, hi)];
#pragma unroll
        for (int kq = 0; kq < 2; ++kq)
#pragma unroll
            for (int db = 0; db < 4; ++db) { const s16x4 vlo = vtr(vp + (db * 2 + kq) * 1024), vhi = vtr(vp + (db * 2 + kq) * 1024 + 512);
                const bf16x8 vf = (bf16x8){vlo[0], vlo[1], vlo[2], vlo[3], vhi[0], vhi[1], vhi[2], vhi[3]};
                o[db] = __builtin_amdgcn_mfma_f32_32x32x16_bf16(__builtin_bit_cast(bf16x8, kq ? pw1 : pw0), vf, o[db], 0, 0, 0); }
        asm volatile("s_waitcnt lgkmcnt(0)" ::: "memory");
    }
#undef SA_STEP_PTRS
#undef SA_LOAD_K
#undef SA_LOAD_V
    int tidb = tid; asm volatile("" : "+v"(tidb)); const int laneb = tidb & 63, r32b = laneb & 31, hib = laneb >> 5;
    LAS float* wsfb = ex + 512 + w * 32;
    { auto rr = __builtin_amdgcn_permlane32_swap(__float_as_uint(l), __float_as_uint(l), false, false); l = __uint_as_float(rr[0]) + __uint_as_float(rr[1]); }
    if (hib == 0) { EXM[w * 64 + r32b] = m; EXM[w * 64 + 32 + r32b] = l; }
    __syncthreads();
    float Mx = EXM[r32b];
#pragma unroll
    for (int w2 = 1; w2 < 8; ++w2) Mx = fmaxf(Mx, EXM[w2 * 64 + r32b]);
    float Lx = 0.f;
#pragma unroll
    for (int w2 = 0; w2 < 8; ++w2) Lx += __builtin_amdgcn_exp2f(EXM[w2 * 64 + r32b] - Mx) * EXM[w2 * 64 + 32 + r32b];
    if (hib == 0) wsfb[r32b] = __builtin_amdgcn_exp2f(m - Mx);
    asm volatile("s_waitcnt lgkmcnt(0)" ::: "memory");
#pragma unroll
    for (int d = 0; d < 4; ++d)
#pragma unroll
        for (int r = 0; r < 16; ++r) o[d][r] *= wsfb[crow(r, hib)];
    __syncthreads();
    LAS float* OX = (LAS float*)lds;
#pragma unroll
    for (int d = 0; d < 4; ++d)
#pragma unroll
        for (int r = 0; r < 16; ++r) OX[(w * 32 + crow(r, hib)) * 128 + 32 * d + r32b] = o[d][r];
    __syncthreads();
#pragma unroll
    for (int k = 0; k < 4; ++k) { const int row = 4 * w + k; f32x2 acc = *(const LAS f32x2*)(OX + row * 128 + 2 * laneb);
#pragma unroll
        for (int w2 = 1; w2 < 8; ++w2) acc += *(const LAS f32x2*)(OX + (w2 * 32 + row) * 128 + 2 * laneb);
        *(SA_GAS f32x2*)(PART + ((size_t)it * 32 + row) * PART_LD + 2 * laneb) = acc; }
    if (hib == 0 && (r32b >> 2) == w) { SA_GAS float* pp = (SA_GAS float*)(PART + ((size_t)it * 32 + r32b) * PART_LD + 128); pp[0] = Mx; pp[1] = Lx; }
    __syncthreads();
}
__device__ __forceinline__ void post_sample(const float* PART, bf16_t* Ydst  , int b, int t, int h, float lam, float scale, const float* subln_g) {
    const SA_GAS float* p00 = (const SA_GAS float*)(PART + ((size_t)(((b * 4 + h) * 2 + 0) * 32) + t) * PART_LD);
    const SA_GAS float* p01 = p00 + 16 * PART_LD; const SA_GAS float* p10 = p00 + 32 * PART_LD; const SA_GAS float* p11 = p10 + 16 * PART_LD;
    float a0, a1, c0, c1;
    { const float M0 = p00[128], L0 = p00[129], M1 = p10[128], L1 = p10[129], Mx = fmaxf(M0, M1), f0 = __builtin_amdgcn_exp2f(M0 - Mx), f1 = __builtin_amdgcn_exp2f(M1 - Mx), inv = 1.0f / (f0 * L0 + f1 * L1); a0 = f0 * inv; a1 = f1 * inv; }
    { const float M0 = p01[128], L0 = p01[129], M1 = p11[128], L1 = p11[129], Mx = fmaxf(M0, M1), f0 = __builtin_amdgcn_exp2f(M0 - Mx), f1 = __builtin_amdgcn_exp2f(M1 - Mx), inv = 1.0f / (f0 * L0 + f1 * L1); c0 = f0 * inv; c1 = f1 * inv; }
    float ss = 0.f;
    for (int i = 0; i < 32; ++i) { const f32x4 x0 = *(const SA_GAS f32x4*)(p00 + 4 * i), x1 = *(const SA_GAS f32x4*)(p10 + 4 * i), y0 = *(const SA_GAS f32x4*)(p01 + 4 * i), y1 = *(const SA_GAS f32x4*)(p11 + 4 * i);
        const f32x4 ov = (x0 * a0 + x1 * a1) - lam * (y0 * c0 + y1 * c1); ss += (ov[0] * ov[0] + ov[1] * ov[1]) + (ov[2] * ov[2] + ov[3] * ov[3]); }
    const float rn = scale / sqrtf(ss * (1.f / 128.f) + EPS);
    for (int i = 0; i < 16; ++i) { float ob[8];
#pragma unroll
        for (int hh = 0; hh < 2; ++hh) { const int i4 = 2 * i + hh; const f32x4 x0 = *(const SA_GAS f32x4*)(p00 + 4 * i4), x1 = *(const SA_GAS f32x4*)(p10 + 4 * i4), y0 = *(const SA_GAS f32x4*)(p01 + 4 * i4), y1 = *(const SA_GAS f32x4*)(p11 + 4 * i4);
            const f32x4 ov = (x0 * a0 + x1 * a1) - lam * (y0 * c0 + y1 * c1);
#pragma unroll
            for (int j = 0; j < 4; ++j) ob[4 * hh + j] = ov[j] * rn * subln_g[8 * i + 4 * hh + j]; }
        st_bf16x8(Ydst + 8 * i, ob); }
}
__device__ __forceinline__ void post_sample_wave(const float* PART, bf16_t* Ydst  , int b, int t, int h, float lam, float scale, const float* subln_g, int lane) {
    const SA_GAS float* p00 = (const SA_GAS float*)(PART + ((size_t)(((b * 4 + h) * 2 + 0) * 32) + t) * PART_LD);
    const SA_GAS float* p01 = p00 + 16 * PART_LD; const SA_GAS float* p10 = p00 + 32 * PART_LD; const SA_GAS float* p11 = p10 + 16 * PART_LD;
    const f32x2 x0 = *(const SA_GAS f32x2*)(p00 + 2 * lane), x1 = *(const SA_GAS f32x2*)(p10 + 2 * lane), y0 = *(const SA_GAS f32x2*)(p01 + 2 * lane), y1 = *(const SA_GAS f32x2*)(p11 + 2 * lane);
    const f32x2 ml00 = *(const SA_GAS f32x2*)(p00 + 128), ml10 = *(const SA_GAS f32x2*)(p10 + 128), ml01 = *(const SA_GAS f32x2*)(p01 + 128), ml11 = *(const SA_GAS f32x2*)(p11 + 128);
    const f32x2 sg = *(const SA_GAS f32x2*)(subln_g + 2 * lane);
    float a0, a1, c0, c1;
    { const float Mx = fmaxf(ml00[0], ml10[0]), f0 = __builtin_amdgcn_exp2f(ml00[0] - Mx), f1 = __builtin_amdgcn_exp2f(ml10[0] - Mx), inv = 1.0f / (f0 * ml00[1] + f1 * ml10[1]); a0 = f0 * inv; a1 = f1 * inv; }
    { const float Mx = fmaxf(ml01[0], ml11[0]), f0 = __builtin_amdgcn_exp2f(ml01[0] - Mx), f1 = __builtin_amdgcn_exp2f(ml11[0] - Mx), inv = 1.0f / (f0 * ml01[1] + f1 * ml11[1]); c0 = f0 * inv; c1 = f1 * inv; }
    const f32x2 ov = (x0 * a0 + x1 * a1) - lam * (y0 * c0 + y1 * c1);
    const float ss = mixf::wsum(ov[0] * ov[0] + ov[1] * ov[1], lane);
    const float rn = scale / sqrtf(ss * (1.f / 128.f) + EPS);
    const unsigned w = f2bf(ov[0] * rn * sg[0]) | (f2bf(ov[1] * rn * sg[1]) << 16);
    *(SA_GAS unsigned*)(Ydst + 2 * lane) = w;
}
}
#endif
constexpr int NWAVES = 8;
static_assert(M % 256 == 0 && SEQ % 512 == 0 && PAST % 64 == 0 && KSROWS % 128 == 0, "shape assumptions of the GEMM / attention bodies");
constexpr size_t MiB = 1u << 20;
constexpr size_t alup(size_t x) { return (x + MiB - 1) / MiB * MiB; }
constexpr size_t LW_GU1 = 0, LW_D1 = LW_GU1 + (size_t)NGU * D * 2, LW_IN = LW_D1 + (size_t)D * FF * 2, LW_P = LW_IN + (size_t)ZW * D * 2, LW_O = LW_P + (size_t)D * YW * 2,
                 LW_GU2 = LW_O + (size_t)D * D * 2, LW_D2 = LW_GU2 + (size_t)NGU * D * 2, LW_BYTES = LW_D2 + (size_t)D * FF * 2;
constexpr size_t WS_CTL = 0, CTL_ZERO_BYTES = 1 * MiB;
constexpr size_t WS_ROPE = 1 * MiB;
constexpr size_t WS_PWT = alup(WS_ROPE + (size_t)ROPE_ROWS * 64 * 4);
constexpr size_t WS_W = alup(WS_PWT + (size_t)DEPTH * 256 * 64 * 2);
constexpr size_t WS_XN = alup(WS_W + (size_t)DEPTH * LW_BYTES);
constexpr size_t WS_ACT = alup(WS_XN + (size_t)M * D * 2);
constexpr size_t WS_Z = alup(WS_ACT + (size_t)M * FF * 2);
constexpr size_t WS_Y = alup(WS_Z + (size_t)M * ZW * 2);
constexpr size_t WS_QP = alup(WS_Y + (size_t)M * YW * 2);
constexpr size_t WS_KP = alup(WS_QP + (size_t)SEQ * 512 * 2);
constexpr size_t WS_VP = alup(WS_KP + (size_t)SEQ * 512 * 2);
constexpr size_t WS_OB = alup(WS_VP + (size_t)SEQ * 512 * 2);
constexpr size_t WS_QS = alup(WS_OB + (size_t)SEQ * 1024 * 2);
constexpr size_t WS_KS = alup(WS_QS + (size_t)DECB * QSROWS * 512 * 2);
constexpr size_t WS_VS = alup(WS_KS + (size_t)DECB * KSROWS * 512 * 2);
constexpr size_t WS_OS = alup(WS_VS + (size_t)DECB * KSROWS * 512 * 2);
constexpr size_t WS_MG = alup(WS_OS + (size_t)DECB * QSROWS * 1024 * 2);
constexpr size_t WS_MRG = alup(WS_MG + (size_t)M * D * 4);
constexpr size_t WS_SSP = alup(WS_MRG + (size_t)M * D * 2);
constexpr size_t WS_SS4 = alup(WS_SSP + (size_t)M * 16 * 4);
constexpr size_t WS_PART = alup(WS_SS4 + (size_t)SEQ * 4 * 4);
constexpr size_t WS_FAC = alup(WS_PART + (size_t)DECB * 8 * 32 * 132 * 4);
constexpr size_t WS_END = alup(WS_FAC + (size_t)(SEQ / 256) * 4 * 4 * 131072);
constexpr int CW_TMO = 0, CW_BAR = 4096;

constexpr int RING_OFF = 0, RING_BYTES = 131072;
constexpr int LDSCTL_OFF = RING_BYTES, MISC_OFF = LDSCTL_OFF + 320;
constexpr int LDS_BYTES = 147456;

typedef unsigned v4u __attribute__((ext_vector_type(4)));
typedef unsigned v2u __attribute__((ext_vector_type(2)));
typedef float f32x4 __attribute__((ext_vector_type(4)));
#define LDS_WAIT() asm volatile("s_waitcnt lgkmcnt(0)" ::: "memory")
#define VM_WAIT() asm volatile("s_waitcnt vmcnt(0)" ::: "memory")
__device__ __forceinline__ unsigned pk2(float lo, float hi) { return f2bf(lo) | (f2bf(hi) << 16); }

__device__ __forceinline__ int tid_now(int wv) { int z = 0; asm volatile("" : "+v"(z)); return wv * 64 + (int)__builtin_amdgcn_mbcnt_hi(~0u, __builtin_amdgcn_mbcnt_lo(~0u, (unsigned)z)); }
#define XB_TMO      128
#define XB_XCNT(j)  (256  + 64 * (j))
#define XB_XSUB(j)  (1280 + 64 * (j))
#define XB_XGEN(j)  (2304 + 64 * (j))
#define XB_TOP      3328
#define XB_TOPGEN   3392
#define XCD_BAR_WORDS 3456
#define XB_SPIN_CAP (1u << 18)
__device__ __forceinline__ unsigned xb_ld(unsigned* p)              { return __hip_atomic_load(p, __ATOMIC_RELAXED, __HIP_MEMORY_SCOPE_AGENT); }
__device__ __forceinline__ unsigned xb_add(unsigned* p, unsigned v) { return __hip_atomic_fetch_add(p, v, __ATOMIC_RELAXED, __HIP_MEMORY_SCOPE_AGENT); }
__device__ __forceinline__ unsigned xb_xcc_id() { return (unsigned)__builtin_amdgcn_s_getreg((3 << 11) | 20) & 0xFu; }
#define XB_SPIN(cond, bar) do { unsigned _sp = 0; while (cond) { __builtin_amdgcn_s_sleep(1); \
    if ((++_sp & 255u) == 0u) { if (xb_ld(&(bar)[XB_TMO])) break; if (_sp > XB_SPIN_CAP) { atomicAdd(&(bar)[XB_TMO], 1u); break; } } } } while (0)
struct XcdBarrier { unsigned* bar; unsigned x; volatile LAS unsigned* st; };
__device__ __forceinline__ XcdBarrier xcd_barrier_post(unsigned* bar, volatile LAS unsigned* st, int wv) {
    XcdBarrier b; b.bar = bar; b.x = xb_xcc_id(); b.st = st;
    if (tid_now(wv) == 0) (void)xb_add(&bar[XB_XCNT(b.x)], 1u);
    return b;
}
__device__ __forceinline__ void xcd_barrier_complete(unsigned* bar, unsigned x, unsigned& nloc, unsigned& nx) {
    const unsigned G = gridDim.x * gridDim.y * gridDim.z;
    unsigned sum, cnt, mine, sp = 0u;
    for (;;) {
        sum = 0u; cnt = 0u; mine = 0u;
#pragma unroll
        for (unsigned j = 0; j < 16; ++j) { const unsigned c = xb_ld(&bar[XB_XCNT(j)]); sum += c; cnt += (c > 0u) ? 1u : 0u; mine = (j == x) ? c : mine; }
        if (sum == G) break;
        __builtin_amdgcn_s_sleep(1);
        if ((++sp & 255u) == 0u) { if (xb_ld(&bar[XB_TMO])) break; if (sp > XB_SPIN_CAP) { atomicAdd(&bar[XB_TMO], 1u); break; } }
    }
    nloc = mine > 0u ? mine : 1u; nx = cnt > 0u ? cnt : 1u;
}
__device__ __forceinline__ void xcd_barrier(const XcdBarrier& b, int wv) {
    asm volatile("s_waitcnt vmcnt(0)" ::: "memory");
    __syncthreads();
    if (tid_now(wv) == 0) {
        unsigned* bar = b.bar; asm volatile("" : "+s"(bar));
        unsigned bx_ = b.x; asm volatile("" : "+s"(bx_));
        __builtin_amdgcn_s_waitcnt(0);
        unsigned nloc = b.st[0], nx = b.st[1];
        if (nloc == 0u) { xcd_barrier_complete(bar, bx_, nloc, nx); b.st[0] = nloc; b.st[1] = nx; }
        const unsigned old = xb_add(&bar[XB_XSUB(bx_)], 1u);
        const unsigned gen = old / nloc;
        if (old + 1u == (gen + 1u) * nloc) {
            __builtin_amdgcn_fence(__ATOMIC_RELEASE, "agent");
            asm volatile("s_waitcnt vmcnt(0)" ::: "memory");
            const unsigned og = xb_add(&bar[XB_TOP], 1u);
            const unsigned tg = og / nx;
            if (og + 1u == (tg + 1u) * nx) xb_add(&bar[XB_TOPGEN], 1u);
            else XB_SPIN(xb_ld(&bar[XB_TOPGEN]) == tg, bar);
            __builtin_amdgcn_fence(__ATOMIC_ACQUIRE, "agent");
            xb_add(&bar[XB_XGEN(bx_)], 1u);
            asm volatile("s_waitcnt vmcnt(0)" ::: "memory");
        } else {
            XB_SPIN(xb_ld(&bar[XB_XGEN(bx_)]) == gen, bar);
            __builtin_amdgcn_fence(__ATOMIC_ACQUIRE, "agent");
            asm volatile("s_waitcnt vmcnt(0)" ::: "memory");
        }
    }
    __syncthreads();
}

__device__ __forceinline__ float wave_sum(float v, int lane) {
#pragma unroll
    for (int o = 1; o < 64; o <<= 1) v += __builtin_bit_cast(float, __builtin_amdgcn_ds_bpermute((lane ^ o) << 2, __builtin_bit_cast(int, v)));
    return v;
}
__device__ __forceinline__ void transpose_item(const float* W, int K, int N, bf16_t* WT, int ldk, int koff, int mode, LAS float* scr, int item, int lane, const float* gk = nullptr) {
    const int nblk = N / 32, kb = item / nblk, nb = item % nblk, k0 = 64 * kb, n0 = 32 * nb;
    const int drow0 = (mode == 0 || mode == 3) ? n0 : ((n0 >> 7) * 256 + (mode - 1) * 128 + (n0 & 127));
    float wv_[32];
#pragma unroll
    for (int i = 0; i < 32; ++i) wv_[i] = W[(size_t)(k0 + 2 * i + (lane >> 5)) * N + n0 + (lane & 31)];
#pragma unroll
    for (int i = 0; i < 32; ++i) scr[(2 * i + (lane >> 5)) * 33 + (lane & 31)] = wv_[i];
    LDS_WAIT(); asm volatile("" ::: "memory");
    const int c = lane & 7;
    f32x4 ga = {1.f, 1.f, 1.f, 1.f}, gb = {1.f, 1.f, 1.f, 1.f}; if (gk) { ga = *(const f32x4*)(gk + k0 + 8 * c); gb = *(const f32x4*)(gk + k0 + 8 * c + 4); }
#pragma unroll
    for (int j = 0; j < 4; ++j) { const int n = (lane >> 3) + 8 * j; const LAS float* s = scr + (8 * c) * 33 + n;
        v4u o; o.x = pk2(s[0 * 33] * ga[0], s[1 * 33] * ga[1]); o.y = pk2(s[2 * 33] * ga[2], s[3 * 33] * ga[3]); o.z = pk2(s[4 * 33] * gb[0], s[5 * 33] * gb[1]); o.w = pk2(s[6 * 33] * gb[2], s[7 * 33] * gb[3]);
        int drow = drow0 + n;
        if (mode == 3 && n0 >= 3072) { const int gi = n0 + n - 3072, br = gi >> 10, oc = gi & 1023, r6 = oc & 63; drow = (12 + (oc >> 6)) * 256 + 128 * (br >> 1) + 32 * (r6 >> 4) + 8 * ((r6 & 15) >> 2) + 4 * (br & 1) + (oc & 3); }
        *(v4u*)(WT + (size_t)drow * ldk + koff + k0 + 8 * c) = o; }
    LDS_WAIT(); asm volatile("" ::: "memory");
}
__device__ __forceinline__ void sincos_d(double a, float& s_out, float& c_out) {
    const double k = rint(a * 0.63661977236758134308);
    double r = fma(-k, 1.57079632679489655800e+00, a); r = fma(-k, 6.12323399573676603587e-17, r);
    const double r2 = r * r;
    const double sp = r * (1.0 + r2 * (-1.0 / 6 + r2 * (1.0 / 120 + r2 * (-1.0 / 5040 + r2 * (1.0 / 362880 + r2 * (-1.0 / 39916800 + r2 * (1.0 / 6227020800.0)))))));
    const double cp = 1.0 + r2 * (-0.5 + r2 * (1.0 / 24 + r2 * (-1.0 / 720 + r2 * (1.0 / 40320 + r2 * (-1.0 / 3628800 + r2 * (1.0 / 479001600 + r2 * (-1.0 / 87178291200.0)))))));
    const int q = (int)((long long)k & 3);
    const double s = (q == 0) ? sp : (q == 1) ? cp : (q == 2) ? -sp : -cp;
    const double c = (q == 0) ? cp : (q == 1) ? -sp : (q == 2) ? -cp : sp;
    s_out = (float)s; c_out = (float)c;
}

struct Args { const float* in[36]; float* out; unsigned char* ws; float inv_freq[32]; float lam_init[4]; };

#define LAUNDER_V(x) asm volatile("" : "+v"(x))
#define LAUNDER_S(x) asm volatile("" : "+s"(x))
struct Ctx { LAS unsigned char* lds; int tid, lane, wave, bx, vcu, G, gtid, GT; };
__device__ __forceinline__ Ctx mkctx(LAS unsigned char* lds, int wv) {
    Ctx c; c.lds = lds; int tid = tid_now(wv); LAUNDER_V(tid); int bx = blockIdx.x; LAUNDER_S(bx); int G = gridDim.x; LAUNDER_S(G);
    c.tid = tid; c.lane = tid & 63; c.wave = __builtin_amdgcn_readfirstlane(tid >> 6); c.bx = bx; c.G = G; c.vcu = (G % 8 == 0) ? (bx % 8) * (G / 8) + bx / 8 : bx;
    c.gtid = bx * (NWAVES * 64) + tid; c.GT = G * NWAVES * 64; return c;
}
#define GAS __attribute__((address_space(1)))
template <class T> __device__ __forceinline__ T* lp(T* q) { asm volatile("" : "+s"(q)); return (T*)(GAS T*)q; }
__device__ __forceinline__ const float* inptr(LAS unsigned char* lds, int i) {
    int ii = i; LAUNDER_S(ii);
    const LAS unsigned* t = (const LAS unsigned*)(lds + LDSCTL_OFF) + 2 * ii; const unsigned lo = __builtin_amdgcn_readfirstlane(t[0]), hi = __builtin_amdgcn_readfirstlane(t[1]);
    return (const float*)(GAS const float*)(((unsigned long long)hi << 32) | lo);
}

__device__ __forceinline__ void norm_phase(LAS unsigned char* lds, int wv, const float* X, const float* g, bf16_t* XN) {
    const Ctx c = mkctx(lds, wv);
    const int gw = c.vcu * NWAVES + c.wave, NGW = c.G * NWAVES;
    f32x4 gv[4];
#pragma unroll
    for (int j = 0; j < 4; ++j) gv[j] = *((const f32x4*)g + c.lane + 64 * j);
    for (int m = gw; m < M; m += NGW) {
        const f32x4* xr = (const f32x4*)(X + (size_t)m * D) + c.lane;
        f32x4 v[4]; float s = 0.f;
#pragma unroll
        for (int j = 0; j < 4; ++j) { v[j] = xr[64 * j]; s += (v[j].x * v[j].x + v[j].y * v[j].y) + (v[j].z * v[j].z + v[j].w * v[j].w); }
        const float r = 1.0f / sqrtf(wave_sum(s, c.lane) * (1.f / D) + EPS);
        v2u* o8 = (v2u*)(XN + (size_t)m * D) + c.lane;
#pragma unroll
        for (int j = 0; j < 4; ++j) { v2u w; w.x = pk2(v[j].x * r * gv[j].x, v[j].y * r * gv[j].y); w.y = pk2(v[j].z * r * gv[j].z, v[j].w * r * gv[j].w); o8[64 * j] = w; }
    }
}

constexpr int I_G = (D / 64) * (FF / 32), I_D = (FF / 64) * (D / 32), I_IN = (D / 64) * (ZW / 32), I_PA = (256 / 64) * (D / 32), I_PD = (512 / 64) * (D / 32), I_O = (D / 64) * (D / 32);
constexpr int I_LAYER = 6 * I_G + I_IN + 3 * I_PA + I_PD + I_O; static_assert(I_G == I_D, "item counts");
__device__ __forceinline__ void weight_item(LAS unsigned char* lds, unsigned char* ws, LAS float* scr, int l, int r, int lane) {
    unsigned char* wl = ws + WS_W + (size_t)l * LW_BYTES;
    if (r < I_G) { transpose_item(inptr(lds, 8) + (size_t)l * D * FF, D, FF, (bf16_t*)(wl + LW_GU1), D, 0, 1, scr, r, lane, inptr(lds, 7) + (size_t)l * D); return; } r -= I_G;
    if (r < I_G) { transpose_item(inptr(lds, 9) + (size_t)l * D * FF, D, FF, (bf16_t*)(wl + LW_GU1), D, 0, 2, scr, r, lane, inptr(lds, 7) + (size_t)l * D); return; } r -= I_G;
    if (r < I_D) { transpose_item(inptr(lds, 10) + (size_t)l * FF * D, FF, D, (bf16_t*)(wl + LW_D1), FF, 0, 0, scr, r, lane); return; } r -= I_D;
    if (r < I_IN) { transpose_item(inptr(lds, 12) + (size_t)l * D * ZW, D, ZW, (bf16_t*)(wl + LW_IN), D, 0, 3, scr, r, lane, inptr(lds, 11) + (size_t)l * D); return; } r -= I_IN;
    if (r < I_PA) { transpose_item(inptr(lds, 27) + (size_t)l * 256 * D, 256, D, (bf16_t*)(wl + LW_P), YW, 0, 0, scr, r, lane); return; } r -= I_PA;
    if (r < I_PA) { transpose_item(inptr(lds, 28) + (size_t)l * 256 * D, 256, D, (bf16_t*)(wl + LW_P), YW, 256, 0, scr, r, lane); return; } r -= I_PA;
    if (r < I_PA) { transpose_item(inptr(lds, 29) + (size_t)l * 256 * D, 256, D, (bf16_t*)(wl + LW_P), YW, 512, 0, scr, r, lane); return; } r -= I_PA;
    if (r < I_PD) { transpose_item(inptr(lds, 30) + (size_t)l * 512 * D, 512, D, (bf16_t*)(wl + LW_P), YW, 768, 0, scr, r, lane); return; } r -= I_PD;
    if (r < I_O) { transpose_item(inptr(lds, 31) + (size_t)l * D * D, D, D, (bf16_t*)(wl + LW_O), D, 0, 0, scr, r, lane); return; } r -= I_O;
    if (r < I_G) { transpose_item(inptr(lds, 33) + (size_t)l * D * FF, D, FF, (bf16_t*)(wl + LW_GU2), D, 0, 1, scr, r, lane, inptr(lds, 32) + (size_t)l * D); return; } r -= I_G;
    if (r < I_G) { transpose_item(inptr(lds, 34) + (size_t)l * D * FF, D, FF, (bf16_t*)(wl + LW_GU2), D, 0, 2, scr, r, lane, inptr(lds, 32) + (size_t)l * D); return; } r -= I_G;
    transpose_item(inptr(lds, 35) + (size_t)l * FF * D, FF, D, (bf16_t*)(wl + LW_D2), FF, 0, 0, scr, r, lane);
}
constexpr int NU_GU = (M / 256) * (NGU / 256), NU_IN = (M / 256) * (ZW / 256);
constexpr int IDLE_GU = 256 - NU_GU % 256, IDLE_IN = 256 - NU_IN % 256, IDLE_ALL = 2 * IDLE_GU + IDLE_IN;
constexpr int WS1 = (int)((long)I_LAYER * IDLE_GU / IDLE_ALL), WS2 = WS1 + (int)((long)I_LAYER * IDLE_IN / IDLE_ALL);
static_assert(NU_GU % 256 != 0 && NU_IN % 256 != 0 && WS2 < I_LAYER, "idle-slot weight conversion needs idle workgroups in those phases");
__device__ __forceinline__ void weight_slice(LAS unsigned char* lds, int wv, unsigned char* ws, int l, int beg, int end, int nbusy) {
    const Ctx c = mkctx(lds, wv);
    if (c.G != 256 || l >= DEPTH || c.bx < nbusy) return;
    LAS float* scr = (LAS float*)(lds + RING_OFF + c.wave * 16384);
    const int nset = 256 - nbusy, iset = c.bx - nbusy;
    for (int it = beg + iset * NWAVES + c.wave; it < end; it += nset * NWAVES) weight_item(lds, ws, scr, l, it, c.lane);
}

__device__ __forceinline__ void prologue_phase(LAS unsigned char* lds, int wv, unsigned char* ws, float* X, const Args& args) {
    const Ctx c = mkctx(lds, wv);
    LAS float* scr = (LAS float*)(lds + RING_OFF + c.wave * 16384);
    const int gw = c.vcu * NWAVES + c.wave, NGW = c.G * NWAVES;
    { const int nl = (c.G == 256) ? 1 : DEPTH;
      for (int it = gw; it < nl * I_LAYER; it += NGW) weight_item(lds, ws, scr, it / I_LAYER, it % I_LAYER, c.lane); }
    { const float* s0 = inptr(lds, 0); const float* s1 = inptr(lds, 1); bf16_t* XB = (bf16_t*)(ws + WS_XN); float* SSP = (float*)(ws + WS_SSP); float* SS4 = (float*)(ws + WS_SS4);
      for (int m = gw; m < M; m += NGW) { const f32x4* xr = (const f32x4*)((m < SEQ) ? s0 + (size_t)m * D : s1 + (size_t)(m - SEQ) * D) + c.lane;
          v2u* o8 = (v2u*)(XB + (size_t)m * D) + c.lane; float ss = 0.f;
#pragma unroll
          for (int j = 0; j < 4; ++j) { const f32x4 v = xr[64 * j]; v2u w; w.x = pk2(v.x, v.y); w.y = pk2(v.z, v.w); o8[64 * j] = w; ss += (v.x * v.x + v.y * v.y) + (v.z * v.z + v.w * v.w); }
          ss = wave_sum(ss, c.lane);
          if (m < SEQ) { if (c.lane < 4) SS4[(size_t)m * 4 + c.lane] = (c.lane == 0) ? ss : 0.f; } else if (c.lane < 16) SSP[(size_t)(m - SEQ) * 16 + c.lane] = (c.lane == 0) ? ss : 0.f; } }
    { bf16_t* QS = (bf16_t*)(ws + WS_QS); v4u z = {0u, 0u, 0u, 0u};
      for (size_t i = c.gtid; i < (size_t)DECB * QSROWS * 512 / 8; i += c.GT) ((v4u*)QS)[i] = z;
    }
    { bf16_t* wt = (bf16_t*)(ws + WS_PWT); const float* pw = inptr(lds, 13);
      for (int i = c.gtid; i < DEPTH * 4 * 64 * 64; i += c.GT) { const int k = i & 63, n = (i >> 6) & 63, g = (i >> 12) & 3, l = i >> 14; wt[i] = (bf16_t)f2bf(pw[(((size_t)l * 4 + g) * 64 + k) * 64 + n]); } }
    { float* rope = (float*)(ws + WS_ROPE);
      for (int i = c.gtid; i < ROPE_ROWS * 32; i += c.GT) { const int p = i >> 5, j = i & 31; const float ang = (float)p * args.inv_freq[j]; float s, co; sincos_d((double)ang, s, co); rope[(size_t)p * 64 + j] = co; rope[(size_t)p * 64 + 32 + j] = s; } }
}

__device__ __forceinline__ void mix_phase(LAS unsigned char* lds, int wv, unsigned char* ws, float* out, int l) {
    const Ctx c = mkctx(lds, wv);
    MixP P; P.Z = (const bf16_t*)(ws + WS_Z); P.Y = (bf16_t*)(ws + WS_Y); P.Qp = (bf16_t*)(ws + WS_QP); P.Kp = (bf16_t*)(ws + WS_KP); P.Vp = (bf16_t*)(ws + WS_VP);
    P.QS = (bf16_t*)(ws + WS_QS); P.KS = (bf16_t*)(ws + WS_KS); P.VS = (bf16_t*)(ws + WS_VS); P.out = out;
    P.st_pool = inptr(lds, 4) + (size_t)l * DECB * 15 * 256; P.st_sconv = inptr(lds, 5) + (size_t)l * DECB * 2 * 256; P.st_cconv = inptr(lds, 6) + (size_t)l * DECB * 30 * 256;
    P.pool_w = inptr(lds, 13) + (size_t)l * 4 * 64 * 64; P.pool_scale = inptr(lds, 14) + (size_t)l * 256; P.sconv_w = inptr(lds, 15) + (size_t)l * 3 * 256; P.cconv_w = inptr(lds, 16) + (size_t)l * 31 * 256;
    P.cconv_b = inptr(lds, 17) + (size_t)l * 256; P.ln_g = inptr(lds, 18) + (size_t)l * 256; P.ln_b = inptr(lds, 19) + (size_t)l * 256; P.qg = inptr(lds, 20) + (size_t)l * 64; P.kg = inptr(lds, 21) + (size_t)l * 64;
    P.rope = (const float*)(ws + WS_ROPE); P.layer = l;
    const bf16_t* WTg = (const bf16_t*)(ws + WS_PWT) + (size_t)l * 256 * 64;
    for (int it = c.bx + ((N_MIX_ITEMS - 1 - c.bx) / c.G) * c.G; it >= c.bx; it -= c.G) { const MixItem I = mix_item(it);
        int tl = c.tid; LAUNDER_V(tl);
        if (I.nrows == 32) mixf::item<32>(P, I, WTg, tl, lds + RING_OFF); else mixf::item<16>(P, I, WTg, tl, lds + RING_OFF); }
}

__device__ __forceinline__ void attn_phase(unsigned char* lds_generic, LAS unsigned char* lds, int wv, unsigned char* ws, float* out, int l) {
    const Ctx c = mkctx(lds, wv);
    typedef attn_body::bf16 abf;
    constexpr int NQB = SEQ / 256, NPAIR = 8 * (NQB / 2);
    const abf* QP = (const abf*)(ws + WS_QP); const abf* KP = (const abf*)(ws + WS_KP); const abf* VP = (const abf*)(ws + WS_VP); abf* OB = (abf*)(ws + WS_OB);
    int p = c.vcu, half = 0;
    while (p < NPAIR) { const int map = p / (NQB / 2), s = p % (NQB / 2), qb = half ? NQB - 1 - s : s;
        attn_body::attn_unit<8>(QP + (size_t)qb * 256 * 512 + map * 64, KP + map * 64, VP + (map >> 1) * 128, OB + (size_t)qb * 256 * 1024 + map * 128, 4 * qb + 4, 0, (char*)lds_generic + RING_OFF, c.tid);
        if (half) { p += c.G; half = 0; } else half = 1; }
    const float* ck = inptr(lds, 2) + (size_t)l * DECB * PAST * 512; const float* cv = inptr(lds, 3) + (size_t)l * DECB * PAST * 512;
    const float* knew = out + O_KS + (size_t)l * MS * 512; const float* vnew = out + O_VS + (size_t)l * MS * 512;
    for (int it = c.vcu; it < sattn::N_ITEMS; it += c.G)
        sattn::item(it, ck, cv, knew, vnew, (const bf16_t*)(ws + WS_QS), (float*)(ws + WS_PART), lds + RING_OFF, (LAS float*)(lds + LDSCTL_OFF + 1024), c.tid);
}

__device__ __forceinline__ void post_phase(LAS unsigned char* lds, int wv, unsigned char* ws, int l) {
    const Ctx c = mkctx(lds, wv);
    const LAS float* LAMF = (const LAS float*)(lds + MISC_OFF + 64);
    const float lam = LAMF[l], sc = LAMF[4 + l]; const float* sg = inptr(lds, 26) + (size_t)l * 128;
    const bf16_t* OB = (const bf16_t*)(ws + WS_OB); bf16_t* Y = (bf16_t*)(ws + WS_Y);
    { const int gw = c.vcu * NWAVES + c.wave, NGW = c.G * NWAVES, lane = c.lane, odd = (lane >> 3) & 1, hh = lane >> 4, eo = 16 * (lane & 7) + 8 * odd;
      const f32x4 ga = *(const GAS f32x4*)(sg + eo), gb = *(const GAS f32x4*)(sg + eo + 4);
      for (int m = gw; m < SEQ; m += NGW) { const GAS v4u* src = (const GAS v4u*)(OB + (size_t)m * 1024) + 2 * lane; const v4u w0 = src[0], w1 = src[1];
          float v[16];
          v[0] = __builtin_bit_cast(float, w0.x << 16); v[1] = __builtin_bit_cast(float, w0.x & 0xffff0000u); v[2] = __builtin_bit_cast(float, w0.y << 16); v[3] = __builtin_bit_cast(float, w0.y & 0xffff0000u);
          v[4] = __builtin_bit_cast(float, w0.z << 16); v[5] = __builtin_bit_cast(float, w0.z & 0xffff0000u); v[6] = __builtin_bit_cast(float, w0.w << 16); v[7] = __builtin_bit_cast(float, w0.w & 0xffff0000u);
          v[8] = __builtin_bit_cast(float, w1.x << 16); v[9] = __builtin_bit_cast(float, w1.x & 0xffff0000u); v[10] = __builtin_bit_cast(float, w1.y << 16); v[11] = __builtin_bit_cast(float, w1.y & 0xffff0000u);
          v[12] = __builtin_bit_cast(float, w1.z << 16); v[13] = __builtin_bit_cast(float, w1.z & 0xffff0000u); v[14] = __builtin_bit_cast(float, w1.w << 16); v[15] = __builtin_bit_cast(float, w1.w & 0xffff0000u);
          float o[8], ss = 0.f;
#pragma unroll
          for (int j = 0; j < 8; ++j) { const float send = odd ? v[j] : v[8 + j];
              const float recv = __builtin_bit_cast(float, __builtin_amdgcn_ds_bpermute((lane ^ 8) << 2, __builtin_bit_cast(int, send)));
              o[j] = odd ? (recv - lam * v[8 + j]) : (v[j] - lam * recv); ss += o[j] * o[j]; }
#pragma unroll
          for (int x = 1; x < 16; x <<= 1) ss += __builtin_bit_cast(float, __builtin_amdgcn_ds_bpermute((lane ^ x) << 2, __builtin_bit_cast(int, ss)));
          const float rn = sc / sqrtf(ss * (1.f / 128.f) + EPS);
          v4u wo; wo.x = pk2(o[0] * rn * ga[0], o[1] * rn * ga[1]); wo.y = pk2(o[2] * rn * ga[2], o[3] * rn * ga[3]); wo.z = pk2(o[4] * rn * gb[0], o[5] * rn * gb[1]); wo.w = pk2(o[6] * rn * gb[2], o[7] * rn * gb[3]);
          *(GAS v4u*)(Y + (size_t)m * YW + 768 + hh * 128 + eo) = wo; } }
    for (int idx = c.vcu * NWAVES + c.wave; idx < MS * 4; idx += c.G * NWAVES) { const int ms = idx >> 2, h = idx & 3;
        sattn::post_sample_wave((const float*)(ws + WS_PART), Y + (size_t)(SEQ + ms) * YW + 768 + h * 128, ms / DECS, ms % DECS, h, lam, sc, sg, c.lane); }
}

template <class Epi> __device__ __forceinline__ void gemm_call(LAS unsigned char* lds, int wv, int Mrows, const bf16_t* A, const bf16_t* Bt, int N, int K, int lda, int ldb, const Epi& E) {
    int bx = blockIdx.x; LAUNDER_S(bx); int G = gridDim.x; LAUNDER_S(G);
    pg8::Gemm g{A, Bt, Mrows, N, K, lda, ldb}; pg8::StaticOrder S; S.init(Mrows, N, G, bx);
    pg8::gemm_phase<Epi, pg8::StaticOrder>(lds + RING_OFF, g, S, E, tid_now(wv));
}
template <int MODE> __device__ __forceinline__ void tail_call(LAS unsigned char* lds, int wv, const tailg::Tail<MODE>& t) {
    int bx = blockIdx.x; LAUNDER_S(bx); int G = gridDim.x; LAUNDER_S(G); int tid = tid_now(wv); LAUNDER_V(tid);
    tailg::run<MODE>(lds + RING_OFF, tid, bx, G, t);
}

__global__ void __launch_bounds__(NWAVES * 64, 2) enc_fwd(Args args) {
    extern __shared__ __attribute__((aligned(16))) unsigned char lds_raw[];
    LAS unsigned char* lds = (LAS unsigned char*)lds_raw;
    unsigned char* const ws = args.ws;
    float* const X = args.out;
    int wv;
    {
        const int tid = threadIdx.x;
        wv = __builtin_amdgcn_readfirstlane(tid >> 6);
        for (int u = tid; u < (LDS_BYTES - LDSCTL_OFF) / 4; u += NWAVES * 64) ((LAS unsigned*)(lds + LDSCTL_OFF))[u] = 0u;
        __syncthreads();
        if (tid < 36) ((LAS unsigned long long*)(lds + LDSCTL_OFF))[tid] = (unsigned long long)args.in[tid];
        LAS float* LAMF = (LAS float*)(lds + MISC_OFF + 64);
        if (tid >= 64 && tid < 64 + DEPTH) { const int l = tid - 64; float d1 = 0.f, d2 = 0.f;
            const float* q1 = args.in[22] + l * 64; const float* k1 = args.in[23] + l * 64; const float* q2 = args.in[24] + l * 64; const float* k2 = args.in[25] + l * 64;
            for (int i = 0; i < 64; ++i) { d1 += q1[i] * k1[i]; d2 += q2[i] * k2[i]; }
            LAMF[l] = expf(d1) - expf(d2) + args.lam_init[l]; LAMF[4 + l] = 1.0f - args.lam_init[l]; }
        __syncthreads();
    }
    XcdBarrier bar = xcd_barrier_post((unsigned*)(ws + WS_CTL) + CW_BAR, (volatile LAS unsigned*)(lds + MISC_OFF) + 8, wv);
#define GRID_BAR() xcd_barrier(bar, wv)
    asm volatile("; MARK P0");
    prologue_phase(lds, wv, ws, X, args);
    GRID_BAR();

    for (int l = 0; l < DEPTH; ++l) {
#define WSP(T, off) ((T*)(lp(ws) + (off)))
#define WLP(off) ((const bf16_t*)(lp(ws) + WS_W + (size_t)l * LW_BYTES + (off)))
        asm volatile("; MARK FFN1");
        gemm_call(lds, wv, M, WSP(bf16_t, WS_XN), WLP(LW_GU1), NGU, D, D, D, pg8::EpiSwiGLU{WSP(bf16_t, WS_ACT), pg8::RowScale{WSP(float, WS_SS4), WSP(float, WS_SSP), SEQ}, FF, 0});
        weight_slice(lds, wv, lp(ws), l + 1, 0, WS1, NU_GU % 256); GRID_BAR();
        gemm_call(lds, wv, SEQ, WSP(bf16_t, WS_ACT), WLP(LW_D1), D, FF, FF, FF, pg8::EpiResid{WSP(bf16_t, WS_XN), WSP(float, WS_SS4), (l == DEPTH - 1 && false) ? lp(X) : nullptr, (LAS float*)(lds + LDSCTL_OFF + 1024), D, 0.5f});
        tail_call<0>(lds, wv, tailg::Tail<0>{WSP(bf16_t, WS_ACT), WLP(LW_D1), nullptr, WSP(bf16_t, WS_XN), WSP(float, WS_SSP), nullptr, nullptr, FF, FF, FF, 0, 0.5f, 0}); GRID_BAR();
        asm volatile("; MARK NORM2");
        gemm_call(lds, wv, M, WSP(bf16_t, WS_XN), WLP(LW_IN), ZW, D, D, D, pg8::EpiZ{WSP(bf16_t, WS_Z), WSP(bf16_t, WS_FAC), pg8::RowScale{WSP(float, WS_SS4), WSP(float, WS_SSP), SEQ}, ZW, 12, SEQ / 256, 0});
        weight_slice(lds, wv, lp(ws), l + 1, WS1, WS2, NU_IN % 256); GRID_BAR();
        asm volatile("; MARK MIX");
        mix_phase(lds, wv, lp(ws), lp(X), l); GRID_BAR();
        asm volatile("; MARK ATTN");
        attn_phase(lds_raw, lds, wv, lp(ws), lp(X), l); GRID_BAR();
        asm volatile("; MARK POST");
        post_phase(lds, wv, lp(ws), l); GRID_BAR();
        asm volatile("; MARK MERGE");
        gemm_call(lds, wv, SEQ, WSP(bf16_t, WS_Y), WLP(LW_P), D, YW, YW, YW, pg8::EpiMerged{WSP(bf16_t, WS_MRG), WSP(bf16_t, WS_FAC), D, ZW});
        tail_call<1>(lds, wv, tailg::Tail<1>{WSP(bf16_t, WS_Y), WLP(LW_P), nullptr, nullptr, nullptr, WSP(bf16_t, WS_MRG), WSP(bf16_t, WS_Z) + 3072, YW, YW, YW, ZW, 0.f, 0}); GRID_BAR();
        gemm_call(lds, wv, SEQ, WSP(bf16_t, WS_MRG), WLP(LW_O), D, D, D, D, pg8::EpiResid{WSP(bf16_t, WS_XN), WSP(float, WS_SS4), nullptr, (LAS float*)(lds + LDSCTL_OFF + 1024), D, 1.0f});
        tail_call<0>(lds, wv, tailg::Tail<0>{WSP(bf16_t, WS_MRG), WLP(LW_O), nullptr, WSP(bf16_t, WS_XN), WSP(float, WS_SSP), nullptr, nullptr, D, D, D, 0, 1.0f, 0}); GRID_BAR();
        asm volatile("; MARK FFN2");
        gemm_call(lds, wv, M, WSP(bf16_t, WS_XN), WLP(LW_GU2), NGU, D, D, D, pg8::EpiSwiGLU{WSP(bf16_t, WS_ACT), pg8::RowScale{WSP(float, WS_SS4), WSP(float, WS_SSP), SEQ}, FF, 0});
        weight_slice(lds, wv, lp(ws), l + 1, WS2, I_LAYER, NU_GU % 256); GRID_BAR();
        gemm_call(lds, wv, SEQ, WSP(bf16_t, WS_ACT), WLP(LW_D2), D, FF, FF, FF, pg8::EpiResid{WSP(bf16_t, WS_XN), WSP(float, WS_SS4), (l == DEPTH - 1 && true) ? lp(X) : nullptr, (LAS float*)(lds + LDSCTL_OFF + 1024), D, 0.5f});
        tail_call<0>(lds, wv, tailg::Tail<0>{WSP(bf16_t, WS_ACT), WLP(LW_D2), (l == DEPTH - 1) ? lp(X) : nullptr, WSP(bf16_t, WS_XN), WSP(float, WS_SSP), nullptr, nullptr, FF, FF, FF, 0, 0.5f, 0}); GRID_BAR();
#undef WSP
#undef WLP
    }
#undef GRID_BAR
}

extern "C" void kernel_launch(void* const* d_in, const int* in_sizes, int n_in, void* d_out, int out_size, void* d_ws, size_t ws_size, hipStream_t stream) {
    static int grid = 0;
    if (grid == 0) {
        if (n_in != 36 || in_sizes[0] != SEQ * D || (size_t)out_size != O_END || ws_size < WS_END) { fprintf(stderr, "kernel_launch: unexpected shapes (n_in %d, in0 %d, out %d, ws %zu need %zu)\n", n_in, n_in > 0 ? in_sizes[0] : -1, out_size, ws_size, (size_t)WS_END); grid = -1; return; }
        int dev = 0, cus = 0, per_cu = 0;
        if (hipGetDevice(&dev) != hipSuccess || hipDeviceGetAttribute(&cus, hipDeviceAttributeMultiprocessorCount, dev) != hipSuccess) { grid = -1; return; }
        if (hipFuncSetAttribute((const void*)enc_fwd, hipFuncAttributeMaxDynamicSharedMemorySize, LDS_BYTES) != hipSuccess) { fprintf(stderr, "kernel_launch: hipFuncSetAttribute failed\n"); grid = -1; return; }
        if (hipOccupancyMaxActiveBlocksPerMultiprocessor(&per_cu, (const void*)enc_fwd, NWAVES * 64, LDS_BYTES) != hipSuccess || per_cu < 1) fprintf(stderr, "kernel_launch: occupancy query reports %d\n", per_cu);
        (void)hipGetLastError();
        grid = cus;
    }
    if (grid < 0) return;
    if (hipMemsetAsync((char*)d_ws + WS_CTL, 0, CTL_ZERO_BYTES, stream) != hipSuccess) return;
    Args a; memset(&a, 0, sizeof(a));
    for (int i = 0; i < 36; ++i) a.in[i] = (const float*)d_in[i];
    a.out = (float*)d_out; a.ws = (unsigned char*)d_ws;
    for (int i = 0; i < 32; ++i) a.inv_freq[i] = (float)pow(10000.0, -(double)i / 32.0);
    for (int l = 0; l < 4; ++l) a.lam_init[l] = (float)(0.8 - 0.6 * exp(-0.3 * l));
    hipLaunchKernelGGL(enc_fwd, dim3(grid), dim3(NWAVES * 64), LDS_BYTES, stream, a);
    const hipError_t le = hipPeekAtLastError();
    if (le != hipSuccess) fprintf(stderr, "kernel_launch: launch failed: %s\n", hipGetErrorName(le));
}
#endif
```

```cpp
#ifndef CPU_TEST
#include <hip/hip_runtime.h>
#include <hip/hip_bf16.h>
#endif
#include <cstdio>
#include <cstdint>
#include <cmath>
#include <cstring>

#ifndef CFG_SEQ
#define CFG_SEQ 16384
#endif
#ifndef CFG_DEPTH
#define CFG_DEPTH 4
#endif
#ifndef CFG_DECB
#define CFG_DECB 32
#endif
#ifndef CFG_PAST
#define CFG_PAST 2048
#endif
constexpr int D = 1024, SEQ = CFG_SEQ, DEPTH = CFG_DEPTH, DECB = CFG_DECB, DECS = 16, PAST = CFG_PAST;
constexpr int MS = DECB * DECS, M = SEQ + MS;
constexpr int FF = 2816, NGU = 2 * FF, ZW = 7168, YW = 1280;
constexpr int KSROWS = PAST + 128;
constexpr int QSROWS = 256;
constexpr int ROPE_ROWS = (SEQ > PAST + DECS) ? SEQ : (PAST + DECS);
constexpr float EPS = 1e-6f;
constexpr float C2 = 0.125f * 1.4426950408889634f;

constexpr size_t O_YP = 0, O_YS = O_YP + (size_t)SEQ * D, O_KP = O_YS + (size_t)MS * D, O_VP = O_KP + (size_t)DEPTH * SEQ * 512,
                 O_POOLP = O_VP + (size_t)DEPTH * SEQ * 512, O_SCP = O_POOLP + (size_t)DEPTH * 15 * 256, O_CCP = O_SCP + (size_t)DEPTH * 2 * 256,
                 O_KS = O_CCP + (size_t)DEPTH * 30 * 256, O_VS = O_KS + (size_t)DEPTH * MS * 512, O_POOLS = O_VS + (size_t)DEPTH * MS * 512,
                 O_SCS = O_POOLS + (size_t)DEPTH * DECB * 15 * 256, O_CCS = O_SCS + (size_t)DEPTH * DECB * 2 * 256, O_END = O_CCS + (size_t)DEPTH * DECB * 30 * 256;

typedef unsigned short bf16_t;
#ifdef CPU_TEST
#define HD inline
#define LDSF float*
#else
#define HD __device__ __forceinline__
#define LAS __attribute__((address_space(3)))
#define LDSF LAS float*
#endif
#ifdef CPU_TEST
#define CBAR()
#else
#define CBAR() asm volatile("" ::: "memory")
#endif
HD unsigned f2bf(float f) { unsigned u = __builtin_bit_cast(unsigned, f); return (u + 0x7fffu + ((u >> 16) & 1u)) >> 16; }
HD float bf2f(bf16_t b) { return __builtin_bit_cast(float, (unsigned)b << 16); }
HD float sigmoid_f(float x) { return 1.0f / (1.0f + expf(-x)); }

HD void ld_bf16x8(const bf16_t* p, float* o) {
#ifdef CPU_TEST
    for (int i = 0; i < 8; ++i) o[i] = bf2f(p[i]);
#else
    typedef unsigned u4 __attribute__((ext_vector_type(4)));
    const u4 w = *(const u4*)p;
    o[0] = __builtin_bit_cast(float, w.x << 16); o[1] = __builtin_bit_cast(float, w.x & 0xffff0000u);
    o[2] = __builtin_bit_cast(float, w.y << 16); o[3] = __builtin_bit_cast(float, w.y & 0xffff0000u);
    o[4] = __builtin_bit_cast(float, w.z << 16); o[5] = __builtin_bit_cast(float, w.z & 0xffff0000u);
    o[6] = __builtin_bit_cast(float, w.w << 16); o[7] = __builtin_bit_cast(float, w.w & 0xffff0000u);
#endif
}
HD void st_bf16x8(bf16_t* p, const float* v) {
#ifdef CPU_TEST
    for (int i = 0; i < 8; ++i) p[i] = (bf16_t)f2bf(v[i]);
#else
    typedef unsigned u4 __attribute__((ext_vector_type(4)));
    u4 w; w.x = f2bf(v[0]) | (f2bf(v[1]) << 16); w.y = f2bf(v[2]) | (f2bf(v[3]) << 16); w.z = f2bf(v[4]) | (f2bf(v[5]) << 16); w.w = f2bf(v[6]) | (f2bf(v[7]) << 16);
    *(u4*)p = w;
#endif
}

struct MixP {
    const bf16_t* Z; bf16_t* Y;
    bf16_t *Qp, *Kp, *Vp;
    bf16_t *QS, *KS, *VS;
    float* out;
    const float *st_pool, *st_sconv, *st_cconv;
    const float *pool_w, *pool_scale, *sconv_w, *cconv_w, *cconv_b, *ln_g, *ln_b, *qg, *kg;
    const float* rope;
    int layer;
};
struct MixItem { int sample, b, t0, nrows; };
constexpr int MIX_PROWS = 32, N_MIX_PROMPT = SEQ / MIX_PROWS, N_MIX_ITEMS = N_MIX_PROMPT + DECB;
HD MixItem mix_item(int it) { MixItem I; if (it < N_MIX_PROMPT) { I.sample = 0; I.b = 0; I.t0 = it * MIX_PROWS; I.nrows = MIX_PROWS; } else { I.sample = 1; I.b = it - N_MIX_PROMPT; I.t0 = 0; I.nrows = DECS; } return I; }

HD void mix_c_fill(const MixP& P, const MixItem& I, int tid, LDSF T) {
    const int ch = tid & 255, half = tid >> 8, l = P.layer, b = I.b; const size_t mb = I.sample ? (size_t)SEQ + (size_t)DECS * b : 0;
    for (int i = half; i < I.nrows + 30; i += 2) { const int t = I.t0 - 30 + i; float v;
        if (t >= 0) { const bf16_t* zr = P.Z + (mb + t) * ZW; v = bf2f(zr[1024 + ch]) * sigmoid_f(bf2f(zr[1280 + ch])); }
        else v = I.sample ? P.st_cconv[((size_t)b * 30 + (30 + t)) * 256 + ch] : 0.f;
        T[i * 256 + ch] = v;
        if (!I.sample) { if (t >= I.t0 && t >= SEQ - 30) P.out[O_CCP + ((size_t)l * 30 + (t - (SEQ - 30))) * 256 + ch] = v; }
        else { if (t + 14 >= 0) P.out[O_CCS + (((size_t)l * DECB + b) * 30 + (t + 14)) * 256 + ch] = v; } }
}
HD void mix_c_conv(const MixP& P, const MixItem& I, int tid, LDSF T, LDSF cv) {
    const int ch = tid & 255, half = tid >> 8;
    float w[31];
#pragma unroll
    for (int j = 0; j < 31; ++j) w[j] = P.cconv_w[j * 256 + ch];
    for (int r = half; r < I.nrows; r += 2) { float a = 0.f;
#pragma unroll
        for (int j = 0; j < 31; ++j) a += w[j] * T[(r + j) * 256 + ch];
        cv[r * 256 + ch] = a; }
}
HD void mix_b_fill(const MixP& P, const MixItem& I, int tid, LDSF T) {
    const int ch = tid & 255, half = tid >> 8, l = P.layer, b = I.b; const size_t mb = I.sample ? (size_t)SEQ + (size_t)DECS * b : 0;
    for (int i = half; i < I.nrows + 2; i += 2) { const int t = I.t0 - 2 + i; float v;
        if (t >= 0) { const bf16_t* zr = P.Z + (mb + t) * ZW; v = bf2f(zr[512 + ch]) * bf2f(zr[768 + ch]); }
        else v = I.sample ? P.st_sconv[((size_t)b * 2 + (2 + t)) * 256 + ch] : 0.f;
        T[i * 256 + ch] = v;
        if (!I.sample) { if (t >= I.t0 && t >= SEQ - 2) P.out[O_SCP + ((size_t)l * 2 + (t - (SEQ - 2))) * 256 + ch] = v; }
        else { if (t >= DECS - 2) P.out[O_SCS + (((size_t)l * DECB + b) * 2 + (t - (DECS - 2))) * 256 + ch] = v; } }
}
HD void mix_b_conv(const MixP& P, const MixItem& I, int tid, LDSF T) {
    const int ch = tid & 255, half = tid >> 8; const size_t mb = I.sample ? (size_t)SEQ + (size_t)DECS * I.b : 0;
    const float w0 = P.sconv_w[ch], w1 = P.sconv_w[256 + ch], w2 = P.sconv_w[512 + ch];
    for (int r = half; r < I.nrows; r += 2) { const int t = I.t0 + r; const float y = w0 * T[r * 256 + ch] + w1 * T[(r + 1) * 256 + ch] + w2 * T[(r + 2) * 256 + ch];
        const float zb = bf2f(P.Z[(mb + t) * ZW + 256 + ch]);
        P.Y[(mb + t) * YW + 256 + ch] = (bf16_t)f2bf(zb * y); }
}
HD void mix_a_fill(const MixP& P, const MixItem& I, int tid, LDSF T) {
    const int ch = tid & 255, half = tid >> 8, l = P.layer, b = I.b; const size_t mb = I.sample ? (size_t)SEQ + (size_t)DECS * b : 0;
    for (int i = half; i < I.nrows + 15; i += 2) { const int t = I.t0 - 15 + i;
        const float v = (t >= 0) ? bf2f(P.Z[(mb + t) * ZW + ch]) : (I.sample ? P.st_pool[((size_t)b * 15 + (15 + t)) * 256 + ch] : 0.f);
        T[i * 256 + ch] = v;
        if (!I.sample) { if (t >= I.t0 && t >= SEQ - 15) P.out[O_POOLP + ((size_t)l * 15 + (t - (SEQ - 15))) * 256 + ch] = v; }
        else { if (t >= 1) P.out[O_POOLS + (((size_t)l * DECB + b) * 15 + (t - 1)) * 256 + ch] = v; } }
}
HD void mix_a_pool(const MixP& P, const MixItem& I, int tid, LDSF T, LDSF dA) {
    const int ch = tid & 255, half = tid >> 8; const int win = 2 << (ch >> 6);
    for (int r = half; r < I.nrows; r += 2) { const int t = I.t0 + r; float s = 0.f;
        for (int j = 0; j < win; ++j) s += T[(15 + r - j) * 256 + ch];
        const int pos = I.sample ? PAST + t : t; const int cnt = (pos + 1 < win) ? pos + 1 : win;
        dA[r * 256 + ch] = s / (float)cnt - T[(15 + r) * 256 + ch]; }
}
HD void mix_s2(const MixP& P, const MixItem& I, int tid, LDSF cv, LDSF dA, LDSF st) {
    const int ch = tid & 255, half = tid >> 8, g = ch >> 6, dd = ch & 63;
    const size_t mb = I.sample ? (size_t)SEQ + (size_t)DECS * I.b : 0;
    float acc[16];
#pragma unroll
    for (int k = 0; k < 16; ++k) acc[k] = 0.f;
    for (int c = 0; c < 64; ++c) { const float w = P.pool_w[(g * 64 + c) * 64 + dd];
#pragma unroll
        for (int k = 0; k < 16; ++k) acc[k] += dA[(half + 2 * k) * 256 + g * 64 + c] * w; }
    const float sc = P.pool_scale[ch];
#pragma unroll
    for (int k = 0; k < 16; ++k) { const int r = half + 2 * k; if (r < I.nrows) P.Y[(mb + I.t0 + r) * YW + ch] = (bf16_t)f2bf(acc[k] * sc); }
    if (tid < I.nrows) { float s = 0.f;
        for (int c = 0; c < 256; ++c) s += cv[tid * 256 + c] + P.cconv_b[c];
        const float mean = s * (1.f / 256.f); float q = 0.f;
        for (int c = 0; c < 256; ++c) { const float d = cv[tid * 256 + c] + P.cconv_b[c] - mean; q += d * d; }
        st[2 * tid] = mean; st[2 * tid + 1] = 1.0f / sqrtf(q * (1.f / 256.f) + EPS); }
}
HD void mix_s3(const MixP& P, const MixItem& I, int tid, LDSF cv, LDSF st) {
    const int ch = tid & 255, half = tid >> 8;
    const size_t mb = I.sample ? (size_t)SEQ + (size_t)DECS * I.b : 0;
    const float bi = P.cconv_b[ch], lg = P.ln_g[ch], lb = P.ln_b[ch];
    for (int r = half; r < I.nrows; r += 2) { const float v = (cv[r * 256 + ch] + bi - st[2 * r]) * st[2 * r + 1] * lg + lb;
        P.Y[(mb + I.t0 + r) * YW + 512 + ch] = (bf16_t)f2bf(v * sigmoid_f(v)); }
}
HD void mix_s4(const MixP& P, const MixItem& I, int tid) {
    const int kind = tid >> 8, rr = (tid >> 3) & 31, map = tid & 7, l = P.layer, b = I.b;
    const size_t mb = I.sample ? (size_t)SEQ + (size_t)DECS * b : 0;
    if (rr < I.nrows) {
        const int t = I.t0 + rr; const bf16_t* src = P.Z + (mb + t) * ZW + 1536 + kind * 512 + map * 64;
        float v[64];
#pragma unroll
        for (int i = 0; i < 8; ++i) ld_bf16x8(src + 8 * i, v + 8 * i);
        float ss = 0.f;
#pragma unroll
        for (int i = 0; i < 64; ++i) ss += v[i] * v[i];
        const float rn = 1.0f / sqrtf(ss * (1.f / 64.f) + EPS);
        const float* gp = kind ? P.kg : P.qg;
        const int pos = I.sample ? PAST + t : t; const float* rp = P.rope + (size_t)pos * 64;
        float o[64];
#pragma unroll
        for (int i = 0; i < 32; ++i) { const float a = v[i] * rn * gp[i], c = v[i + 32] * rn * gp[i + 32], co = rp[i], si = rp[32 + i];
            o[i] = a * co - c * si; o[i + 32] = c * co + a * si; }
        if (kind == 0) {
            bf16_t* dst = I.sample ? P.QS + ((size_t)b * QSROWS + t) * 512 + map * 64 : P.Qp + (size_t)t * 512 + map * 64;
#pragma unroll
            for (int i = 0; i < 64; ++i) o[i] *= C2;
#pragma unroll
            for (int i = 0; i < 8; ++i) st_bf16x8(dst + 8 * i, o + 8 * i);
        } else {
            bf16_t* dst = I.sample ? P.KS + ((size_t)b * KSROWS + PAST + t) * 512 + map * 64 : P.Kp + (size_t)t * 512 + map * 64;
#pragma unroll
            for (int i = 0; i < 8; ++i) st_bf16x8(dst + 8 * i, o + 8 * i);
            float* od = I.sample ? P.out + O_KS + (((size_t)l * DECB + b) * DECS + t) * 512 + map * 64 : P.out + O_KP + ((size_t)l * SEQ + t) * 512 + map * 64;
#pragma unroll
            for (int i = 0; i < 64; ++i) od[i] = o[i];
        }
    }
    for (int idx = tid; idx < I.nrows * 512; idx += 512) { const int r2 = idx >> 9, c = idx & 511, t = I.t0 + r2;
        const bf16_t val = P.Z[(mb + t) * ZW + 2560 + c];
        if (I.sample) { P.VS[((size_t)b * KSROWS + PAST + t) * 512 + c] = val; P.out[O_VS + (((size_t)l * DECB + b) * DECS + t) * 512 + c] = bf2f(val); }
        else { P.Vp[(size_t)t * 512 + c] = val; P.out[O_VP + ((size_t)l * SEQ + t) * 512 + c] = bf2f(val); } }
}
HD void post_thread(const bf16_t* Orow  , bf16_t* Ydst  , int h, float lam, float scale, const float* subln_g) {
    const bf16_t* a = Orow + (2 * h) * 128; const bf16_t* c = a + 128; float ss = 0.f;
    for (int i = 0; i < 16; ++i) { float x[8], y[8]; ld_bf16x8(a + 8 * i, x); ld_bf16x8(c + 8 * i, y);
#pragma unroll
        for (int j = 0; j < 8; ++j) { const float o = x[j] - lam * y[j]; ss += o * o; } }
    const float rn = scale / sqrtf(ss * (1.f / 128.f) + EPS);
    for (int i = 0; i < 16; ++i) { float x[8], y[8], o[8]; ld_bf16x8(a + 8 * i, x); ld_bf16x8(c + 8 * i, y);
#pragma unroll
        for (int j = 0; j < 8; ++j) o[j] = (x[j] - lam * y[j]) * rn * subln_g[8 * i + j];
        st_bf16x8(Ydst + h * 128 + 8 * i, o); }
}
#ifndef CPU_TEST
namespace pg8 {
#define PG8_LAS __attribute__((address_space(3)))
#define PG8_GAS __attribute__((address_space(1)))
typedef short bf16x8 __attribute__((ext_vector_type(8)));
typedef float f32x4 __attribute__((ext_vector_type(4)));
typedef float f32x2 __attribute__((ext_vector_type(2)));
typedef unsigned u32x4 __attribute__((ext_vector_type(4)));
typedef unsigned u32x2 __attribute__((ext_vector_type(2)));
constexpr int BM = 256, BK = 64, HALF = 128, HTB = HALF * BK * 2  , STAGE_BYTES = 8 * HTB, NXCD = 8, WGM = 8;

__host__ __device__ __forceinline__ int lds_byte(int r, int c) { const int st = (r >> 4) * 2 + (c >> 5), rr = r & 15, cc = c & 31, ob = rr * 64 + cc * 2; return st * 1024 + (ob ^ (((ob >> 9) & 1) << 5)); }
__host__ __device__ __forceinline__ void stage_rc(int b, int& R, int& C) { const int st = b / 1024, sb = b % 1024, swz = sb ^ (((sb >> 9) & 1) << 5); R = (st >> 1) * 16 + swz / 64; C = (st & 1) * 32 + (swz % 64) / 2; }
__host__ __device__ __forceinline__ int perm32(int rho) { const int n = rho >> 4, i = rho & 15; return 8 * (i >> 2) + 4 * n + (i & 3); }

struct Unit { int pm, pn; };
struct Gemm { const bf16_t* A; const bf16_t* Bt; int M, N, K, lda, ldb; };

struct StaticOrder {
    int nM, nN, nwg, G, c;
    __host__ __device__ void init(int M_, int N_, int G_, int c_) { nM = M_ / BM; nN = N_ / BM; nwg = nM * nN; G = G_; c = c_; }
    __host__ __device__ bool next(int i, Unit& u) const {
        const long L = (long)i * G + c; if (L >= nwg) return false;
        int wgid = (int)L; { const int q = nwg / NXCD, r = nwg % NXCD, xcd = wgid % NXCD, off = wgid / NXCD; wgid = (xcd < r ? xcd * (q + 1) : r * (q + 1) + (xcd - r) * q) + off; }
        const int nig = WGM * nN, gid = wgid / nig, fm = gid * WGM, gsz = (nM - fm) < WGM ? (nM - fm) : WGM;
        u.pm = fm + ((wgid % nig) % gsz); u.pn = (wgid % nig) / gsz; return true;
    }
    __device__ __forceinline__ void a_ready(const Unit&) const {}
    __device__ __forceinline__ void done(const Unit&) const {}
};

typedef __bf16 bf16x2_v __attribute__((ext_vector_type(2)));
__device__ __forceinline__ unsigned cvt_pk_bf16(float lo, float hi) { f32x2 v = {lo, hi}; const bf16x2_v b = __builtin_convertvector(v, bf16x2_v); return __builtin_bit_cast(unsigned, b); }
__device__ __forceinline__ float fast_sigmoid(float x) { return __builtin_amdgcn_rcpf(1.0f + __expf(-x)); }

struct RowScale { const float* SS4; const float* SS16; int nfast; };
__device__ __forceinline__ void row_rscales(const RowScale& R, int row0, float (&rs)[2][4]) {
    if (row0 < R.nfast) { f32x4 q[2][4];
#pragma unroll
        for (int ai = 0; ai < 2; ++ai)
#pragma unroll
            for (int m = 0; m < 4; ++m) q[ai][m] = *(const PG8_GAS f32x4*)(R.SS4 + (size_t)(row0 + ai * HALF + m * 16) * 4);
#pragma unroll
        for (int ai = 0; ai < 2; ++ai)
#pragma unroll
            for (int m = 0; m < 4; ++m) rs[ai][m] = 1.0f / sqrtf(((q[ai][m][0] + q[ai][m][1]) + (q[ai][m][2] + q[ai][m][3])) * (1.0f / 1024.0f) + 1e-6f);
    } else {
#pragma unroll
        for (int ai = 0; ai < 2; ++ai)
#pragma unroll
            for (int m = 0; m < 4; ++m) { const PG8_GAS f32x4* p = (const PG8_GAS f32x4*)(R.SS16 + (size_t)(row0 + ai * HALF + m * 16 - R.nfast) * 16); const f32x4 a = p[0], b = p[1], c = p[2], d = p[3];
                const float ss = ((a[0] + a[1]) + (a[2] + a[3])) + ((b[0] + b[1]) + (b[2] + b[3])) + ((c[0] + c[1]) + (c[2] + c[3])) + ((d[0] + d[1]) + (d[2] + d[3]));
                rs[ai][m] = 1.0f / sqrtf(ss * (1.0f / 1024.0f) + 1e-6f); }
    }
}
struct EpiSwiGLU {
    static constexpr bool PERM = true, AFTER_DRAIN = false, MID = false, ROWSCALE = true;
    bf16_t* O; RowScale R; int ldc, pad;
    __device__ __forceinline__ void operator()(const f32x4 (&acc)[2][2][4][2], const Unit& u, int wr, int wc, int fr, int fq, const float (&rsv)[2][4]) const {
        const int row0 = u.pm * BM + wr * 64 + fr, col0 = u.pn * HALF + wc * 32 + 8 * fq;
#pragma unroll
        for (int ai = 0; ai < 2; ++ai)
#pragma unroll
            for (int m = 0; m < 4; ++m) { bf16_t* rowp = O + (size_t)(row0 + ai * HALF + m * 16) * ldc + col0; const float rs = rsv[ai][m];
                float v[8];
#pragma unroll
                for (int n = 0; n < 2; ++n)
#pragma unroll
                    for (int i = 0; i < 4; ++i) { const float g = acc[ai][0][m][n][i] * rs, up = acc[ai][1][m][n][i] * rs; v[4 * n + i] = g * fast_sigmoid(g) * up; }
                u32x4 w; w.x = cvt_pk_bf16(v[0], v[1]); w.y = cvt_pk_bf16(v[2], v[3]); w.z = cvt_pk_bf16(v[4], v[5]); w.w = cvt_pk_bf16(v[6], v[7]);
                *(PG8_GAS u32x4*)rowp = w; }
    }
};
struct EpiZ {
    static constexpr bool PERM = true, AFTER_DRAIN = false, MID = false, ROWSCALE = true;
    bf16_t* O; bf16_t* FAC; RowScale R; int ldc, sig_from, nfp, pad;
    __device__ __forceinline__ void operator()(const f32x4 (&acc)[2][2][4][2], const Unit& u, int wr, int wc, int fr, int fq, const float (&rsv)[2][4]) const {
        const int row0 = u.pm * BM + wr * 64 + fr;
        if (u.pn < sig_from) { const int col0 = u.pn * BM + wc * 32 + 8 * fq;
#pragma unroll
            for (int ai = 0; ai < 2; ++ai)
#pragma unroll
                for (int m = 0; m < 4; ++m) { bf16_t* rowp = O + (size_t)(row0 + ai * HALF + m * 16) * ldc + col0; const float rs = rsv[ai][m];
#pragma unroll
                    for (int bj = 0; bj < 2; ++bj) { const f32x4 v0 = acc[ai][bj][m][0] * rs, v1 = acc[ai][bj][m][1] * rs;
                        u32x4 w; w.x = cvt_pk_bf16(v0[0], v0[1]); w.y = cvt_pk_bf16(v0[2], v0[3]); w.z = cvt_pk_bf16(v1[0], v1[1]); w.w = cvt_pk_bf16(v1[2], v1[3]);
                        *(PG8_GAS u32x4*)(rowp + bj * HALF) = w; } }
        } else { const int j = u.pn - sig_from, oc = j * 64 + wc * 16 + 4 * fq; const int g0c = sig_from * BM;
            const bool blk = u.pm < nfp;
            bf16_t* const fb = FAC + ((size_t)(u.pm * 4 + (j >> 2)) << 18) + (size_t)((wr * 4 + ((j & 1) << 1) + (wc >> 1)) * 8192 + ((j >> 1) & 1) * 512 + (fq * 16 + fr) * 8 + (wc & 1) * 4);
#pragma unroll
            for (int ai = 0; ai < 2; ++ai)
#pragma unroll
                for (int m = 0; m < 4; ++m) { bf16_t* rowp = blk ? fb + (ai * 4 + m) * 1024 : O + (size_t)(row0 + ai * HALF + m * 16) * ldc + g0c + oc; const int qs = blk ? 65536 : 1024; const float rs = rsv[ai][m];
                    f32x4 e[4];
#pragma unroll
                    for (int b = 0; b < 4; ++b)
#pragma unroll
                        for (int i = 0; i < 4; ++i) e[b][i] = 1.0f + __expf(-acc[ai][b >> 1][m][b & 1][i] * rs);
#pragma unroll
                    for (int q = 0; q < 4; ++q) { f32x4 v;
#pragma unroll
                        for (int i = 0; i < 4; ++i) { const float rq = __builtin_amdgcn_rcpf(e[q][i]); v[i] = (q < 3 && blk) ? e[q + 1 > 3 ? 3 : q + 1][i] * rq : rq; }
                        u32x2 w; w.x = cvt_pk_bf16(v[0], v[1]); w.y = cvt_pk_bf16(v[2], v[3]); *(PG8_GAS u32x2*)(rowp + q * qs) = w; } }
        }
    }
};
struct EpiMerged {
    static constexpr bool PERM = false, AFTER_DRAIN = false, MID = true, ROWSCALE = false;
    bf16_t* OUT; const bf16_t* F; int ldc, ldf;
    __device__ __forceinline__ void scale(f32x4 (&acc)[2][2][4][2], const Unit& u, int wr, int wc, int fr, int fq, int q) const {
        const bf16_t* fb = F + ((size_t)((u.pm * 4 + u.pn) * 4 + q) << 16) + (size_t)((wr * 4 + wc) * 8192 + (fq * 16 + fr) * 8);
        u32x4 gq[2][4][2];
#pragma unroll
        for (int ai = 0; ai < 2; ++ai)
#pragma unroll
            for (int m = 0; m < 4; ++m)
#pragma unroll
                for (int bj = 0; bj < 2; ++bj) gq[ai][m][bj] = *(const PG8_GAS u32x4*)(fb + ((ai * 4 + m) * 2 + bj) * 512);
#pragma unroll
        for (int ai = 0; ai < 2; ++ai)
#pragma unroll
            for (int m = 0; m < 4; ++m)
#pragma unroll
                for (int bj = 0; bj < 2; ++bj)
#pragma unroll
                    for (int n = 0; n < 2; ++n) { u32x2 w; w.x = n ? gq[ai][m][bj].z : gq[ai][m][bj].x; w.y = n ? gq[ai][m][bj].w : gq[ai][m][bj].y; f32x4 g; g[0] = __builtin_bit_cast(float, w.x << 16); g[1] = __builtin_bit_cast(float, w.x & 0xffff0000u); g[2] = __builtin_bit_cast(float, w.y << 16); g[3] = __builtin_bit_cast(float, w.y & 0xffff0000u);
                        acc[ai][bj][m][n] *= g; }
    }
    __device__ __forceinline__ void mid(f32x4 (&acc)[2][2][4][2], const Unit& u, int wr, int wc, int fr, int fq, int i) const { scale(acc, u, wr, wc, fr, fq, i); }
    __device__ __forceinline__ void operator()(f32x4 (&acc)[2][2][4][2], const Unit& u, int wr, int wc, int fr, int fq) const {
        scale(acc, u, wr, wc, fr, fq, 3);
        const int row0 = u.pm * BM + wr * 64 + fr, col0 = u.pn * BM + wc * 32 + 4 * fq;
#pragma unroll
        for (int ai = 0; ai < 2; ++ai)
#pragma unroll
            for (int m = 0; m < 4; ++m) { bf16_t* op = OUT + (size_t)(row0 + ai * HALF + m * 16) * ldc + col0;
#pragma unroll
                for (int bj = 0; bj < 2; ++bj)
#pragma unroll
                    for (int n = 0; n < 2; ++n) { const f32x4 v = acc[ai][bj][m][n]; u32x2 w; w.x = cvt_pk_bf16(v[0], v[1]); w.y = cvt_pk_bf16(v[2], v[3]); *(PG8_GAS u32x2*)(op + bj * HALF + n * 16) = w; } }
    }
};
struct EpiResid {
    static constexpr bool PERM = true, AFTER_DRAIN = false, MID = false, ROWSCALE = false;
    bf16_t* XB; float* SS4; float* Xout; PG8_LAS float* PS; int ldc; float s;
    __device__ __forceinline__ void operator()(const f32x4 (&acc)[2][2][4][2], const Unit& u, int wr, int wc, int fr, int fq) const {
        const int row0 = u.pm * BM + wr * 64 + fr, col0 = u.pn * BM + wc * 32 + 8 * fq; const int lane = fq * 16 + fr; const bool fin = Xout != nullptr;
#pragma unroll
        for (int ai = 0; ai < 2; ++ai)
#pragma unroll
            for (int m = 0; m < 4; ++m) { const size_t row = (size_t)(row0 + ai * HALF + m * 16); bf16_t* xb = XB + row * ldc + col0; float* xo = Xout + row * ldc + col0;
                u32x4 x[2];
#pragma unroll
                for (int bj = 0; bj < 2; ++bj) x[bj] = *(const PG8_GAS u32x4*)(xb + bj * HALF);
                float ss = 0.f;
#pragma unroll
                for (int bj = 0; bj < 2; ++bj) { f32x4 v0, v1;
                    v0[0] = __builtin_bit_cast(float, x[bj].x << 16); v0[1] = __builtin_bit_cast(float, x[bj].x & 0xffff0000u); v0[2] = __builtin_bit_cast(float, x[bj].y << 16); v0[3] = __builtin_bit_cast(float, x[bj].y & 0xffff0000u);
                    v1[0] = __builtin_bit_cast(float, x[bj].z << 16); v1[1] = __builtin_bit_cast(float, x[bj].z & 0xffff0000u); v1[2] = __builtin_bit_cast(float, x[bj].w << 16); v1[3] = __builtin_bit_cast(float, x[bj].w & 0xffff0000u);
                    v0 += acc[ai][bj][m][0] * s; v1 += acc[ai][bj][m][1] * s;
                    if (fin) { *(PG8_GAS f32x4*)(xo + bj * HALF) = v0; *(PG8_GAS f32x4*)(xo + bj * HALF + 4) = v1; }
                    else { u32x4 w; w.x = cvt_pk_bf16(v0[0], v0[1]); w.y = cvt_pk_bf16(v0[2], v0[3]); w.z = cvt_pk_bf16(v1[0], v1[1]); w.w = cvt_pk_bf16(v1[2], v1[3]); *(PG8_GAS u32x4*)(xb + bj * HALF) = w;
                        ss += ((v0[0] * v0[0] + v0[1] * v0[1]) + (v0[2] * v0[2] + v0[3] * v0[3])) + ((v1[0] * v1[0] + v1[1] * v1[1]) + (v1[2] * v1[2] + v1[3] * v1[3])); } }
                ss += __builtin_bit_cast(float, __builtin_amdgcn_ds_bpermute((lane ^ 16) << 2, __builtin_bit_cast(int, ss)));
                ss += __builtin_bit_cast(float, __builtin_amdgcn_ds_bpermute((lane ^ 32) << 2, __builtin_bit_cast(int, ss)));
                if (fq == 0) PS[(ai * HALF + wr * 64 + m * 16 + fr) * 4 + wc] = ss;
                if (m & 1) asm volatile("" ::: "memory"); }
        asm volatile("s_waitcnt lgkmcnt(0)" ::: "memory"); __builtin_amdgcn_s_barrier(); asm volatile("" ::: "memory");
        if (lane < 32 && !fin) { const int c8 = 2 * wc + (lane >> 4), rl = (c8 >> 2) * HALF + wr * 64 + (c8 & 3) * 16 + (lane & 15);
            const f32x4 q = *(const PG8_LAS f32x4*)(PS + rl * 4); ((PG8_GAS float*)SS4)[(size_t)(u.pm * BM + rl) * 4 + u.pn] = (q[0] + q[1]) + (q[2] + q[3]); }
    }
};
template <class Epi, class Sched, bool ALIGN_EPI = true>
__device__ __forceinline__ void gemm_phase(PG8_LAS unsigned char* lds_in, const Gemm g, const Sched& S, const Epi& E, int tid_in) {
    unsigned lb_ = (unsigned)(uintptr_t)lds_in; asm volatile("" : "+s"(lb_)); PG8_LAS unsigned char* lds = (PG8_LAS unsigned char*)(uintptr_t)lb_;
    int tid_ = tid_in; asm volatile("" : "+v"(tid_));
    const int tid = tid_, wid = __builtin_amdgcn_readfirstlane(tid >> 6), lane = tid & 63, wr = wid >> 2, wc = wid & 3, fr = lane & 15, fq = lane >> 4;
    const int K = g.K, nt = K / BK;
    unsigned voffA[2], voffB[2];
#pragma unroll
    for (int i = 0; i < 2; ++i) { int R, C; stage_rc(tid * 16 + i * 8192, R, C); const int Rb = Epi::PERM ? ((R & ~31) + perm32(R & 31)) : R;
        voffA[i] = (unsigned)(R * g.lda + C) * 2u; voffB[i] = (unsigned)(Rb * g.ldb + C) * 2u; }
    const size_t kstep = (size_t)(BK * 2);
    const size_t hA = (size_t)HALF * g.lda * 2, hB = (size_t)HALF * g.ldb * 2;
    const size_t tA = 2 * hA, tB = 2 * hB;
    const unsigned ldsw = (unsigned)wid * 1024u;
    const int aoff = lds_byte(wr * 64 + fr, fq * 8), boff = lds_byte(wc * 32 + fr, fq * 8);
#define PG8_SA(b, h) (((b) * 2 + (h)) * HTB)
#define PG8_SB(b, h) ((4 + (b) * 2 + (h)) * HTB)
#define PG8_STAGE(bufoff, gbase, voff) do { _Pragma("unroll") for (int _i = 0; _i < 2; ++_i) \
        __builtin_amdgcn_global_load_lds((const unsigned*)((const char*)(gbase) + (voff)[_i]), (PG8_LAS unsigned*)(lds + (bufoff) + ldsw + _i * 8192), 16, 0, 0); } while (0)
#define PG8_LDA(dst, b, h) do { _Pragma("unroll") for (int m = 0; m < 4; ++m) _Pragma("unroll") for (int k = 0; k < 2; ++k) dst[m][k] = *(const PG8_LAS bf16x8*)(lds + PG8_SA(b, h) + aoff + m * 2048 + k * 1024); } while (0)
#define PG8_LDB(dst, b, h) do { _Pragma("unroll") for (int n = 0; n < 2; ++n) _Pragma("unroll") for (int k = 0; k < 2; ++k) dst[n][k] = *(const PG8_LAS bf16x8*)(lds + PG8_SB(b, h) + boff + n * 2048 + k * 1024); } while (0)
#define PG8_MMA(ai, bj, At, Bt) do { __builtin_amdgcn_s_setprio(1); _Pragma("unroll") for (int m = 0; m < 4; ++m) _Pragma("unroll") for (int n = 0; n < 2; ++n) _Pragma("unroll") for (int k = 0; k < 2; ++k) \
        acc[ai][bj][m][n] = __builtin_amdgcn_mfma_f32_16x16x32_bf16(Bt[n][k], At[m][k], acc[ai][bj][m][n], 0, 0, 0); __builtin_amdgcn_s_setprio(0); } while (0)
#define PG8_WAIT_V(n) asm volatile("s_waitcnt vmcnt(" #n ")" ::: "memory")
#define PG8_WAIT_L(n) asm volatile("s_waitcnt lgkmcnt(" #n ")" ::: "memory")
#define PG8_BAR __builtin_amdgcn_s_barrier()
#define PG8_SCHED __builtin_amdgcn_sched_barrier(0)
    Unit cur, nxt; int ui = 0;
    float rsv[2][4]; int rs_pm = -1;
#pragma unroll
    for (int a = 0; a < 2; ++a)
#pragma unroll
        for (int m = 0; m < 4; ++m) rsv[a][m] = 0.f;
    if (!S.next(0, cur)) return;
    f32x4 acc[2][2][4][2];
#pragma unroll
    for (int a = 0; a < 2; ++a)
#pragma unroll
        for (int b = 0; b < 2; ++b)
#pragma unroll
            for (int m = 0; m < 4; ++m)
#pragma unroll
                for (int n = 0; n < 2; ++n) acc[a][b][m][n] = (f32x4){0.f, 0.f, 0.f, 0.f};
    bf16x8 At[4][2], B0[2][2], B1[2][2];
    const char* cA = (const char*)g.A + (size_t)cur.pm * tA; const char* cB = (const char*)g.Bt + (size_t)cur.pn * tB;
    S.a_ready(cur);
    PG8_STAGE(PG8_SB(0, 0), cB, voffB); PG8_STAGE(PG8_SB(0, 1), cB + hB, voffB); PG8_STAGE(PG8_SA(0, 0), cA, voffA); PG8_STAGE(PG8_SA(0, 1), cA + hA, voffA);
    if (wr == 1) PG8_BAR;
    PG8_WAIT_V(2); PG8_BAR;
    PG8_STAGE(PG8_SB(1, 0), cB + kstep, voffB); PG8_STAGE(PG8_SA(1, 0), cA + kstep, voffA); PG8_STAGE(PG8_SB(1, 1), cB + hB + kstep, voffB);
    PG8_WAIT_V(6); PG8_BAR;
    for (;;) {
        const bool has_next = S.next(ui + 1, nxt);
        const char* nA = has_next ? (const char*)g.A + (size_t)nxt.pm * tA : cA; const char* nB = has_next ? (const char*)g.Bt + (size_t)nxt.pn * tB : cB;
        for (int t = 0; t < nt; t += 2) {
            const bool last = (t == nt - 2);
            const char* a1 = cA + (size_t)(t + 1) * kstep;
            const char* a2 = last ? nA : cA + (size_t)(t + 2) * kstep; const char* b2 = last ? nB : cB + (size_t)(t + 2) * kstep;
            const char* a3 = a2 + kstep; const char* b3 = b2 + kstep;
            if (last && has_next) S.a_ready(nxt);
            PG8_LDB(B0, 0, 0); PG8_LDB(B1, 0, 1); PG8_SCHED; PG8_LDA(At, 0, 0); PG8_STAGE(PG8_SA(1, 1), a1 + hA, voffA);
            PG8_WAIT_V(8); PG8_WAIT_L(0); PG8_BAR; PG8_MMA(0, 0, At, B0); PG8_MMA(0, 1, At, B1); PG8_BAR; PG8_SCHED;
            PG8_LDA(At, 0, 1); PG8_STAGE(PG8_SB(0, 0), b2, voffB); PG8_STAGE(PG8_SB(0, 1), b2 + hB, voffB); PG8_STAGE(PG8_SA(0, 0), a2, voffA);
            PG8_WAIT_V(8); PG8_WAIT_L(0); PG8_BAR; PG8_MMA(1, 0, At, B0); PG8_MMA(1, 1, At, B1); PG8_BAR; PG8_SCHED;
            PG8_LDB(B0, 1, 0); PG8_LDB(B1, 1, 1); PG8_SCHED; PG8_LDA(At, 1, 0); PG8_STAGE(PG8_SA(0, 1), a2 + hA, voffA);
            PG8_WAIT_V(8); PG8_WAIT_L(0); PG8_BAR; PG8_MMA(0, 0, At, B0); PG8_MMA(0, 1, At, B1); PG8_BAR; PG8_SCHED;
            PG8_LDA(At, 1, 1); PG8_STAGE(PG8_SB(1, 0), b3, voffB); PG8_STAGE(PG8_SB(1, 1), b3 + hB, voffB); PG8_STAGE(PG8_SA(1, 0), a3, voffA);
            PG8_WAIT_V(8); PG8_WAIT_L(0); PG8_BAR; PG8_MMA(1, 0, At, B0); PG8_MMA(1, 1, At, B1); PG8_BAR; PG8_SCHED;
            if constexpr (Epi::MID) { const int tn = t + 2; if (tn <= 12 && (tn & 3) == 0) { E.mid(acc, cur, wr, wc, fr, fq, (tn >> 2) - 1); PG8_SCHED; } }
        }
        if constexpr (ALIGN_EPI) { if (wr == 0) PG8_BAR; }
        if constexpr (Epi::ROWSCALE) { if (cur.pm != rs_pm) { row_rscales(E.R, cur.pm * BM + wr * 64 + fr, rsv); rs_pm = cur.pm; }
            E(acc, cur, wr, wc, fr, fq, rsv); }
        else E(acc, cur, wr, wc, fr, fq);
        S.done(cur);
        if (!has_next) break;
#pragma unroll
        for (int a = 0; a < 2; ++a)
#pragma unroll
            for (int b = 0; b < 2; ++b)
#pragma unroll
                for (int m = 0; m < 4; ++m)
#pragma unroll
                    for (int n = 0; n < 2; ++n) acc[a][b][m][n] = (f32x4){0.f, 0.f, 0.f, 0.f};
        cur = nxt; cA = nA; cB = nB; ++ui;
        if constexpr (ALIGN_EPI) { if (wr == 1) PG8_BAR; }
    }
    PG8_WAIT_V(0);
    if constexpr (!ALIGN_EPI) { if (wr == 0) PG8_BAR; }
    PG8_BAR;
#undef PG8_SA
#undef PG8_SB
#undef PG8_STAGE
#undef PG8_LDA
#undef PG8_LDB
#undef PG8_MMA
#undef PG8_WAIT_V
#undef PG8_WAIT_L
#undef PG8_BAR
#undef PG8_SCHED
}
}
#include <cmath>
namespace attn_body {
using bf16=__hip_bfloat16;
using bf16x8=__attribute__((ext_vector_type(8)))short;
using s16x4=__attribute__((ext_vector_type(4)))short;
using f32x16=__attribute__((ext_vector_type(16)))float;
using u32x4=__attribute__((ext_vector_type(4)))unsigned;
constexpr int D=64,QKP=512,OP=1024;
constexpr int NW=8,QBLK=32,QB=QBLK*NW,KVBLK=64;
constexpr int ATTN_UNIT_ROWS=QB;
__device__ __forceinline__ int crow(int r,int hi){return (r&3)+8*(r>>2)+4*hi;}
#define SBAR() __builtin_amdgcn_sched_barrier(0)
__device__ __forceinline__ void cmask(f32x16&p0,f32x16&p1,int jb,int wid,int mode){
  const float NEG=-INFINITY;
  const bool m_all=(mode==0)?(jb>(wid>>1)):(jb==3);
  const bool m_hi=m_all||(mode!=0&&jb==2);
  #pragma unroll
  for(int r=0;r<16;++r){ p0[r]=((r>=8)?m_hi:m_all)?NEG:p0[r]; p1[r]=m_hi?NEG:p1[r]; }
}
constexpr int NSLOT=3, SLOTB=8192;
constexpr int LDS_K=0, LDS_V=NSLOT*SLOTB, LDS_WS=3*NSLOT*SLOTB, LDS_OST=0, LDS_BYTES=LDS_WS+NW*64*4;
constexpr float C2=0.125f*1.4426950408889634f;
__device__ __forceinline__ void glds16(const void*gsrc,unsigned lds_dst){unsigned keep;
  asm volatile("s_mov_b32 %0, m0\n\ts_mov_b32 m0, %2\n\ts_nop 0\n\tglobal_load_lds_dwordx4 %1, off\n\ts_mov_b32 m0, %0":"=&s"(keep):"v"(gsrc),"s"(lds_dst):"memory");}
__device__ __forceinline__ float max3f(float a,float b,float c){float r;asm("v_max3_f32 %0, %1, %2, %3":"=v"(r):"v"(a),"v"(b),"v"(c));return r;}
__device__ __forceinline__ float max2f(float a,float b){float r;asm("v_max_f32_e32 %0, %1, %2":"=v"(r):"v"(a),"v"(b));return r;}
__device__ __forceinline__ float fadd_s(float a,float b){float r;asm("v_add_f32_e32 %0, %1, %2":"=v"(r):"v"(a),"v"(b));return r;}
__device__ __forceinline__ float fsub_s(float a,float b){float r;asm("v_sub_f32_e32 %0, %1, %2":"=v"(r):"v"(a),"v"(b));return r;}
typedef float f32x2_t __attribute__((ext_vector_type(2))); typedef __bf16 bf16x2_t __attribute__((ext_vector_type(2)));
__device__ __forceinline__ unsigned cvtpk_s(float lo,float hi){f32x2_t v={lo,hi};bf16x2_t b=__builtin_convertvector(v,bf16x2_t);return __builtin_bit_cast(unsigned,b);}
#define WAIT_BAR(N) asm volatile("s_waitcnt vmcnt(" #N ") lgkmcnt(0)\n\ts_barrier":::"memory")

__device__ __forceinline__ void qkt(f32x16&p0,f32x16&p1,const char*Kslot,const bf16x8*qr,const f32x16&negm,int r32,int hi){
  const char*kb=Kslot+hi*1024+r32*16;
  #pragma unroll
  for(int d0=0;d0<4;++d0){
    const bf16x8 b0=*reinterpret_cast<const bf16x8*>(kb+d0*2048);
    const bf16x8 b1=*reinterpret_cast<const bf16x8*>(kb+d0*2048+512);
    if(d0==0){p0=__builtin_amdgcn_mfma_f32_32x32x16_bf16(b0,qr[0],negm,0,0,0);p1=__builtin_amdgcn_mfma_f32_32x32x16_bf16(b1,qr[0],negm,0,0,0);}
    else{p0=__builtin_amdgcn_mfma_f32_32x32x16_bf16(b0,qr[d0],p0,0,0,0);p1=__builtin_amdgcn_mfma_f32_32x32x16_bf16(b1,qr[d0],p1,0,0,0);}}
}
typedef __attribute__((address_space(3))) const char* lds_cptr;
typedef short v4i16_t __attribute__((ext_vector_type(4)));
__device__ __forceinline__ void kload8(bf16x8*kf,lds_cptr kp){
  kf[0]=*(const __attribute__((address_space(3))) bf16x8*)(kp);      kf[1]=*(const __attribute__((address_space(3))) bf16x8*)(kp+512);
  kf[2]=*(const __attribute__((address_space(3))) bf16x8*)(kp+2048); kf[3]=*(const __attribute__((address_space(3))) bf16x8*)(kp+2560);
  kf[4]=*(const __attribute__((address_space(3))) bf16x8*)(kp+4096); kf[5]=*(const __attribute__((address_space(3))) bf16x8*)(kp+4608);
  kf[6]=*(const __attribute__((address_space(3))) bf16x8*)(kp+6144); kf[7]=*(const __attribute__((address_space(3))) bf16x8*)(kp+6656);
}
__device__ __forceinline__ void kload2(bf16x8*kf,lds_cptr kp,int j){ kf[2*j]=*(const __attribute__((address_space(3))) bf16x8*)(kp+j*2048); kf[2*j+1]=*(const __attribute__((address_space(3))) bf16x8*)(kp+j*2048+512); }
__device__ __forceinline__ s16x4 vtr(lds_cptr p){ return __builtin_bit_cast(s16x4,__builtin_amdgcn_ds_read_tr16_b64_v4i16((__attribute__((address_space(3))) v4i16_t*)p)); }
__device__ __forceinline__ float rowmax(const f32x16&p0,const f32x16&p1){
  float a=max3f(p0[0],p0[1],p1[0]),b=max3f(p0[2],p0[3],p1[1]);a=max3f(a,p1[2],p1[3]);
  #pragma unroll
  for(int r=4;r<16;r+=4){a=max3f(a,p0[r],p0[r+1]);b=max3f(b,p0[r+2],p0[r+3]);a=max3f(a,p1[r],p1[r+1]);b=max3f(b,p1[r+2],p1[r+3]);}
  const float m=max2f(a,b);
  auto rr=__builtin_amdgcn_permlane32_swap(__float_as_uint(m),__float_as_uint(m),false,false);
  return max2f(__uint_as_float(rr[0]),__uint_as_float(rr[1]));
}
__device__ __forceinline__ void pv(f32x16*o,int vb,bf16x8 pa0,bf16x8 pa1,bf16x8 pa2,bf16x8 pa3){
  #pragma unroll
  for(int d0=0;d0<4;++d0){s16x4 lo[4],hi[4];
    #pragma unroll
    for(int ks=0;ks<4;++ks){
      asm volatile("ds_read_b64_tr_b16 %0,%1 offset:%c2":"=&v"(lo[ks]):"v"(vb),"i"(d0*4096+ks*1024):"memory");
      asm volatile("ds_read_b64_tr_b16 %0,%1 offset:%c2":"=&v"(hi[ks]):"v"(vb),"i"(d0*4096+ks*1024+512):"memory");}
    asm volatile("s_waitcnt lgkmcnt(0)":::"memory");SBAR();
    #define PK(k) (bf16x8){lo[k][0],lo[k][1],lo[k][2],lo[k][3],hi[k][0],hi[k][1],hi[k][2],hi[k][3]}
    o[d0]=__builtin_amdgcn_mfma_f32_32x32x16_bf16(pa0,PK(0),o[d0],0,0,0);
    o[d0]=__builtin_amdgcn_mfma_f32_32x32x16_bf16(pa1,PK(1),o[d0],0,0,0);
    o[d0]=__builtin_amdgcn_mfma_f32_32x32x16_bf16(pa2,PK(2),o[d0],0,0,0);
    o[d0]=__builtin_amdgcn_mfma_f32_32x32x16_bf16(pa3,PK(3),o[d0],0,0,0);
    #undef PK
  }
}

#ifndef ATTN_STORE16
#define ATTN_STORE16(p,v) (*(__attribute__((address_space(1))) u32x4*)(p)=(v))
#endif
template<int THRL> __device__ __forceinline__ void attn_unit(const bf16*Qw0,const bf16*__restrict__ Kh,const bf16*__restrict__ Vh,bf16*Ow0,const int NT,const int mode,char*shm,int tid_in){
  int tid_=tid_in; asm volatile("":"+v"(tid_)); const int tid=tid_,lane=tid&63,r32=lane&31,hi=lane>>5; const int wid=__builtin_amdgcn_readfirstlane(tid>>6);
  const bf16*Qw=Qw0+(long)wid*QBLK*QKP;
  const unsigned lds0=(unsigned)(uintptr_t)shm;
  float*wsf=(float*)(shm+LDS_WS)+wid*64;
  const bf16*ksrc=Kh+(long)lane*QKP+wid*8;
  const bf16*vsrc=Vh+(long)(16*(wid&3)+(lane>>2))*QKP+(wid>>2)*32+(lane&3)*8;
  const unsigned kdst=lds0+LDS_K+wid*1024, vdst=lds0+LDS_V+wid*1024;
  #define DMA_K(t,slot) glds16(ksrc+(long)(t)*KVBLK*QKP,(unsigned)__builtin_amdgcn_readfirstlane(kdst+(slot)))
  #define DMA_V(t,slot) do{ glds16(vsrc+(long)(t)*KVBLK*QKP,(unsigned)__builtin_amdgcn_readfirstlane(vdst+2*(slot))); glds16(vsrc+64+(long)(t)*KVBLK*QKP,(unsigned)__builtin_amdgcn_readfirstlane(vdst+2*(slot)+8192)); }while(0)
  const int vb0=(int)(lds0+LDS_V)+((lane>>4)&1)*32+(lane&3)*8+(4*hi+((lane&15)>>2))*64;
  const char*Kbase=shm+LDS_K; bf16x8 kf[8];
  const lds_cptr shm3=(lds_cptr)shm; const lds_cptr kp0=shm3+LDS_K+hi*1024+r32*16; const lds_cptr vp0=shm3+LDS_V+((lane>>4)&1)*32+(lane&3)*8+(4*hi+((lane&15)>>2))*64;
  DMA_K(0,0);DMA_V(0,0);DMA_K(1,SLOTB);
  bf16x8 qr[4];
  #pragma unroll
  for(int d0=0;d0<4;++d0)qr[d0]=*(const __attribute__((address_space(1))) bf16x8*)(&Qw[(long)r32*QKP+d0*16+hi*8]);
  float mhat=0.f,l_reg=0.f;f32x16 o[4];o[0]=f32x16{};o[1]=f32x16{};o[2]=f32x16{};o[3]=f32x16{};f32x16 negm=f32x16{};asm volatile("":"+v"(negm));
  #define CMASK(P0,P1,t) do{int jb_=(t)-(NT-4); if(jb_>=0)cmask(P0,P1,jb_,wid,mode);}while(0)
  bool resc=false;
  #define START(P0,P1) do{ const float rm=rowmax(P0,P1); resc=false; \
    { const float dl=rm; mhat=fadd_s(mhat,dl); \
      _Pragma("unroll") for(int r=0;r<16;++r){P0[r]=fsub_s(P0[r],dl);P1[r]=fsub_s(P1[r],dl);} \
      _Pragma("unroll") for(int r=0;r<16;++r)negm[r]=-mhat; asm volatile("":"+v"(negm)); } \
    _Pragma("unroll") for(int r=0;r<16;++r)P0[r]=__builtin_amdgcn_exp2f(P0[r]); }while(0)
  #define RESC() do{ if(resc){ asm volatile("s_waitcnt lgkmcnt(0)":::"memory"); \
      _Pragma("unroll") for(int d_=0;d_<4;++d_) _Pragma("unroll") for(int r=0;r<16;++r)o[d_][r]*=wsf[crow(r,hi)]; } }while(0)
  f32x16 pA0,pA1,pB0,pB1;
  int sl_prev=0,sl_cur=0,sl_next=SLOTB;
  #define ROT() do{sl_prev=sl_cur;sl_cur=sl_next;sl_next=(sl_next==(NSLOT-1)*SLOTB)?0:sl_next+SLOTB;}while(0)
  DMA_K(2,2*SLOTB);
  WAIT_BAR(3);
  qkt(pA0,pA1,Kbase,qr,negm,r32,hi);asm volatile("s_nop 15\n\ts_nop 7":"+v"(pA0),"+v"(pA1));CMASK(pA0,pA1,0);
  START(pA0,pA1);
  _Pragma("unroll") for(int r=0;r<16;++r)pA1[r]=__builtin_amdgcn_exp2f(pA1[r]);
  WAIT_BAR(0);
  DMA_K(3,0);DMA_V(1,SLOTB);
  ROT();
  kload8(kf,kp0+sl_cur);
  WAIT_BAR(3);
  s16x4 vlo[8],vhi[8]; u32x4 pw0,pw1,pw2,pw3;
  #define PKW(P,B) cvtpk_s(P[B],P[B+1])
  #define PAF(k) __builtin_bit_cast(bf16x8,pw##k)
  #define VFR(i) (bf16x8){vlo[i][0],vlo[i][1],vlo[i][2],vlo[i][3],vhi[i][0],vhi[i][1],vhi[i][2],vhi[i][3]}
  #define PIN(x) asm volatile("":"+v"(x))
  #define MX3(a,b,c) __builtin_fmaxf(__builtin_fmaxf((a),(b)),(c))
  #define GAPA(MF,A0,A1,A2,A3,W0,W1,PW) do{ MF; sacc+=A0; sacc+=A1; sacc+=A2; sacc+=A3; PIN(sacc); W0; W1; PIN(PW); SBAR(); }while(0)
  #define EX(v) __builtin_amdgcn_exp2f(v)
  #define GAPB(MF,X,B) do{ MF; X[B]=EX(X[B]); X[B+1]=EX(X[B+1]); X[B+2]=EX(X[B+2]); X[B+3]=EX(X[B+3]); PIN(X); SBAR(); }while(0)
  #define VRD(s,i) do{ vlo[s]=vtr(vp_+((i)*1024)); vhi[s]=vtr(vp_+((i)*1024+512)); }while(0)
  #define GAPB2(MF,X,B) do{ MF; X[B]=EX(X[B]); X[B+1]=EX(X[B+1]); PIN(X); SBAR(); }while(0)
  #define KRD(G,j) do{ if(G){ kload2(kf,kp0+sl_next,j); SBAR(); } }while(0)
  #define STEP(C0,C1,P0,P1,t,GK,GV,GL) do{ SBAR(); \
    const lds_cptr vp_=vp0+2*sl_prev; \
    VRD(0,0); SBAR(); float sacc=(P0[0]+P0[1]); \
    GAPA(C0=__builtin_amdgcn_mfma_f32_32x32x16_bf16(kf[0],qr[0],negm,0,0,0), P0[2],P0[3],P0[4],P0[5],     pw0[0]=PKW(P0,0), pw0[1]=PKW(P0,2), pw0); \
    VRD(1,4); SBAR(); GAPA(C1=__builtin_amdgcn_mfma_f32_32x32x16_bf16(kf[1],qr[0],negm,0,0,0), P0[6],P0[7],P0[8],P0[9],     pw0[2]=PKW(P0,4), pw0[3]=PKW(P0,6), pw0); \
    VRD(2,8); SBAR(); GAPA(C0=__builtin_amdgcn_mfma_f32_32x32x16_bf16(kf[2],qr[1],C0,0,0,0),   P0[10],P0[11],P0[12],P0[13], pw1[0]=PKW(P0,8), pw1[1]=PKW(P0,10), pw1); \
    VRD(3,12); SBAR(); GAPA(C1=__builtin_amdgcn_mfma_f32_32x32x16_bf16(kf[3],qr[1],C1,0,0,0),   P0[14],P0[15],P1[0],P1[1],   pw1[2]=PKW(P0,12),pw1[3]=PKW(P0,14), pw1); \
    VRD(4,1); SBAR(); GAPA(C0=__builtin_amdgcn_mfma_f32_32x32x16_bf16(kf[4],qr[2],C0,0,0,0),   P1[2],P1[3],P1[4],P1[5],     pw2[0]=PKW(P1,0), pw2[1]=PKW(P1,2), pw2); \
    VRD(5,5); SBAR(); GAPA(C1=__builtin_amdgcn_mfma_f32_32x32x16_bf16(kf[5],qr[2],C1,0,0,0),   P1[6],P1[7],P1[8],P1[9],     pw2[2]=PKW(P1,4), pw2[3]=PKW(P1,6), pw2); \
    VRD(6,9); SBAR(); GAPA(C0=__builtin_amdgcn_mfma_f32_32x32x16_bf16(kf[6],qr[3],C0,0,0,0),   P1[10],P1[11],P1[12],P1[13], pw3[0]=PKW(P1,8), pw3[1]=PKW(P1,10), pw3); \
    VRD(7,13); SBAR(); GAPA(C1=__builtin_amdgcn_mfma_f32_32x32x16_bf16(kf[7],qr[3],C1,0,0,0),   P1[14],P1[15],0.f,0.f,       pw3[2]=PKW(P1,12),pw3[3]=PKW(P1,14), pw3); \
    l_reg+=sacc; \
    if(GK){DMA_K((t)+3,sl_cur);} if(GV){DMA_V((t)+1,sl_next);} \
    CMASK(C0,C1,t); \
    { float a=MX3(C0[0],C0[1],C1[0]),b=MX3(C0[2],C0[3],C1[1]); a=MX3(a,C1[2],C1[3]); \
      _Pragma("unroll") for(int r=4;r<16;r+=4){a=MX3(a,C0[r],C0[r+1]);b=MX3(b,C0[r+2],C0[r+3]);a=MX3(a,C1[r],C1[r+1]);b=MX3(b,C1[r+2],C1[r+3]);} \
      float rm=__builtin_fmaxf(a,b); { auto rr=__builtin_amdgcn_permlane32_swap(__float_as_uint(rm),__float_as_uint(rm),false,false); rm=__builtin_fmaxf(__uint_as_float(rr[0]),__uint_as_float(rr[1])); } \
      resc=false; \
      if(__builtin_expect(__any(rm>(float)THRL),0)){ const float dl=__builtin_fmaxf(rm,0.f); mhat+=dl; \
        _Pragma("unroll") for(int r=0;r<16;++r){C0[r]-=dl;C1[r]-=dl;} \
        _Pragma("unroll") for(int r=0;r<16;++r)negm[r]=-mhat; asm volatile("":"+v"(negm)); \
        const float f=__builtin_amdgcn_exp2f(-dl); l_reg*=f; if(hi==0)wsf[r32]=f; resc=true; } } \
    SBAR(); \
    GAPB2(o[0]=__builtin_amdgcn_mfma_f32_32x32x16_bf16(PAF(0),VFR(0),o[0],0,0,0), C0,0); VRD(0,2); SBAR(); \
    GAPB2(o[1]=__builtin_amdgcn_mfma_f32_32x32x16_bf16(PAF(0),VFR(1),o[1],0,0,0), C0,2); VRD(1,6); SBAR(); \
    GAPB2(o[2]=__builtin_amdgcn_mfma_f32_32x32x16_bf16(PAF(0),VFR(2),o[2],0,0,0), C0,4); VRD(2,10); SBAR(); \
    GAPB2(o[3]=__builtin_amdgcn_mfma_f32_32x32x16_bf16(PAF(0),VFR(3),o[3],0,0,0), C0,6); VRD(3,14); SBAR(); \
    GAPB2(o[0]=__builtin_amdgcn_mfma_f32_32x32x16_bf16(PAF(1),VFR(4),o[0],0,0,0), C0,8); VRD(4,3); SBAR(); \
    GAPB2(o[1]=__builtin_amdgcn_mfma_f32_32x32x16_bf16(PAF(1),VFR(5),o[1],0,0,0), C0,10); VRD(5,7); SBAR(); \
    GAPB2(o[2]=__builtin_amdgcn_mfma_f32_32x32x16_bf16(PAF(1),VFR(6),o[2],0,0,0), C0,12); VRD(6,11); SBAR(); \
    GAPB2(o[3]=__builtin_amdgcn_mfma_f32_32x32x16_bf16(PAF(1),VFR(7),o[3],0,0,0), C0,14); VRD(7,15); SBAR(); \
    GAPB2(o[0]=__builtin_amdgcn_mfma_f32_32x32x16_bf16(PAF(2),VFR(0),o[0],0,0,0), C1,0); \
    GAPB2(o[1]=__builtin_amdgcn_mfma_f32_32x32x16_bf16(PAF(2),VFR(1),o[1],0,0,0), C1,2); \
    KRD(GL,0); GAPB2(o[2]=__builtin_amdgcn_mfma_f32_32x32x16_bf16(PAF(2),VFR(2),o[2],0,0,0), C1,4); \
    KRD(GL,1); GAPB2(o[3]=__builtin_amdgcn_mfma_f32_32x32x16_bf16(PAF(2),VFR(3),o[3],0,0,0), C1,6); \
    KRD(GL,2); GAPB2(o[0]=__builtin_amdgcn_mfma_f32_32x32x16_bf16(PAF(3),VFR(4),o[0],0,0,0), C1,8); \
    KRD(GL,3); GAPB2(o[1]=__builtin_amdgcn_mfma_f32_32x32x16_bf16(PAF(3),VFR(5),o[1],0,0,0), C1,10); \
    GAPB2(o[2]=__builtin_amdgcn_mfma_f32_32x32x16_bf16(PAF(3),VFR(6),o[2],0,0,0), C1,12); \
    GAPB2(o[3]=__builtin_amdgcn_mfma_f32_32x32x16_bf16(PAF(3),VFR(7),o[3],0,0,0), C1,14); \
    }while(0)
  int t=1;
  #undef CMASK
  #define CMASK(P0,P1,t) do{}while(0)
  for(;t+5<NT;t+=2){
    STEP(pB0,pB1,pA0,pA1,t,true,true,true);     WAIT_BAR(3); RESC(); ROT();
    STEP(pA0,pA1,pB0,pB1,t+1,true,true,true);   WAIT_BAR(3); RESC(); ROT();
  }
  #undef CMASK
  #define CMASK(P0,P1,t) do{int jb_=(t)-(NT-4); if(jb_>=0)cmask(P0,P1,jb_,wid,mode);}while(0)
  #define ENDW(tt) do{ if((tt)+3<NT){WAIT_BAR(3);} else if((tt)+2<NT){WAIT_BAR(2);} else {WAIT_BAR(0);} }while(0)
  for(;t+1<NT;t+=2){
    STEP(pB0,pB1,pA0,pA1,t,(t+3<NT),(t+1<NT),(t+1<NT));       ENDW(t);   RESC(); ROT();
    STEP(pA0,pA1,pB0,pB1,t+1,(t+4<NT),(t+2<NT),(t+2<NT));     ENDW(t+1); RESC(); ROT();
  }
  STEP(pB0,pB1,pA0,pA1,NT-1,false,false,false); RESC();
  { float sacc=pB0[0]+pB0[1]; _Pragma("unroll") for(int r=2;r<16;++r)sacc+=pB0[r]; _Pragma("unroll") for(int r=0;r<16;++r)sacc+=pB1[r]; l_reg+=sacc;
    pw0=(u32x4){PKW(pB0,0),PKW(pB0,2),PKW(pB0,4),PKW(pB0,6)};pw1=(u32x4){PKW(pB0,8),PKW(pB0,10),PKW(pB0,12),PKW(pB0,14)};pw2=(u32x4){PKW(pB1,0),PKW(pB1,2),PKW(pB1,4),PKW(pB1,6)};pw3=(u32x4){PKW(pB1,8),PKW(pB1,10),PKW(pB1,12),PKW(pB1,14)};
    SBAR(); pv(o,vb0+2*sl_cur,PAF(0),PAF(1),PAF(2),PAF(3)); }
  #undef PKW
  #undef PAF
  #undef VFR
  #undef PIN
  #undef MX3
  #undef GAPA
  #undef GAPB
  #undef EX
  #undef VRD
  #undef KRD
  #undef STEP
  #undef ENDW
  {auto rr=__builtin_amdgcn_permlane32_swap(__float_as_uint(l_reg),__float_as_uint(l_reg),false,false);l_reg=__uint_as_float(rr[0])+__uint_as_float(rr[1]);}
  if(hi==0)wsf[32+r32]=l_reg;asm volatile("s_waitcnt lgkmcnt(0)":::"memory");
  float rli[16];
  #pragma unroll
  for(int r=0;r<16;++r)rli[r]=__builtin_amdgcn_rcpf(wsf[32+crow(r,hi)]);
  bf16*Ow=Ow0+(long)wid*QBLK*OP;
  asm volatile("s_waitcnt lgkmcnt(0)\n\ts_barrier":::"memory");
  { bf16*stg=(bf16*)(shm+LDS_OST)+wid*4096;
    #pragma unroll
    for(int r=0;r<16;++r){const int orow=crow(r,hi);
      #pragma unroll
      for(int d0=0;d0<4;++d0)stg[orow*128+d0*32+r32]=__float2bfloat16(o[d0][r]*rli[r]);}
    asm volatile("s_waitcnt lgkmcnt(0)":::"memory");
    #pragma unroll
    for(int i=0;i<8;++i){const int row=i*4+(lane>>4),ch=lane&15; const u32x4 v=*(const u32x4*)(stg+row*128+ch*8); ATTN_STORE16(Ow+(long)row*OP+ch*8,v);} }
  asm volatile("s_waitcnt lgkmcnt(0)\n\ts_barrier":::"memory");
  #undef DMA_K
  #undef DMA_V
  #undef CMASK
  #undef START
  #undef RESC
  #undef ROT
}
constexpr int ATTN_LDS_BYTES=LDS_BYTES;
#undef SBAR
#undef WAIT_BAR
}
#ifndef CPU_TEST
namespace mixf {
typedef short bf16x8 __attribute__((ext_vector_type(8)));
typedef float f32x4 __attribute__((ext_vector_type(4)));
typedef unsigned u32x4 __attribute__((ext_vector_type(4)));
typedef unsigned u32x2 __attribute__((ext_vector_type(2)));
constexpr int DAB_LD = 264;
__device__ __forceinline__ float fsig(float x) { return __builtin_amdgcn_rcpf(1.0f + __expf(-x)); }
__device__ __forceinline__ float wsum(float v, int lane) {
#pragma unroll
    for (int o = 1; o < 64; o <<= 1) v += __builtin_bit_cast(float, __builtin_amdgcn_ds_bpermute((lane ^ o) << 2, __builtin_bit_cast(int, v)));
    return v;
}
__device__ __forceinline__ unsigned pk2f(float lo, float hi) { return f2bf(lo) | (f2bf(hi) << 16); }

__device__ __forceinline__ void unpack8(const u32x4 w, float* o) {
    o[0] = __builtin_bit_cast(float, w.x << 16); o[1] = __builtin_bit_cast(float, w.x & 0xffff0000u); o[2] = __builtin_bit_cast(float, w.y << 16); o[3] = __builtin_bit_cast(float, w.y & 0xffff0000u);
    o[4] = __builtin_bit_cast(float, w.z << 16); o[5] = __builtin_bit_cast(float, w.z & 0xffff0000u); o[6] = __builtin_bit_cast(float, w.w << 16); o[7] = __builtin_bit_cast(float, w.w & 0xffff0000u);
}
__device__ __forceinline__ u32x4 pack8(const float* v) { u32x4 w; w.x = pk2f(v[0], v[1]); w.y = pk2f(v[2], v[3]); w.z = pk2f(v[4], v[5]); w.w = pk2f(v[6], v[7]); return w; }
__device__ __forceinline__ void st8f(float* p, const float* v) { *(f32x4*)p = (f32x4){v[0], v[1], v[2], v[3]}; *(f32x4*)(p + 4) = (f32x4){v[4], v[5], v[6], v[7]}; }
__device__ __forceinline__ void ld8f(const float* p, float* v) { const f32x4 a = *(const f32x4*)p, c = *(const f32x4*)(p + 4); v[0] = a[0]; v[1] = a[1]; v[2] = a[2]; v[3] = a[3]; v[4] = c[0]; v[5] = c[1]; v[6] = c[2]; v[7] = c[3]; }
constexpr int TG_OFF = 0, TC_OFF = 62 * 512, TB_OFF = TC_OFF + 34 * 512, TU_OFF = TB_OFF + 32 * 512, DAB_OFF = TU_OFF + 47 * 512, MIX_LDS_END = DAB_OFF + 32 * DAB_LD * 2;
static_assert(MIX_LDS_END <= 131072 && (34 + 32) * 512 >= 32 * 1024, "mixer-prep LDS map");
template <int NR> __device__ __forceinline__ void item(const MixP& P, const MixItem& I, const bf16_t* __restrict__ WTg, int tid, LAS unsigned char* L) {
    constexpr int HR = NR / 2, RPT = NR / 16;
    LAS bf16_t* TG = (LAS bf16_t*)(L + TG_OFF); LAS bf16_t* TC = (LAS bf16_t*)(L + TC_OFF); LAS bf16_t* TB = (LAS bf16_t*)(L + TB_OFF); LAS bf16_t* TU = (LAS bf16_t*)(L + TU_OFF);
    LAS bf16_t* DAB = (LAS bf16_t*)(L + DAB_OFF); LAS float* cv = (LAS float*)(L + TC_OFF);
    const int ch = tid & 255, half = tid >> 8, lane = tid & 63, wid = tid >> 6, l = P.layer, b = I.b, t0 = I.t0;
    const int cg = tid & 31, rs = tid >> 5, ch0 = cg * 8;
    const bool smp = I.sample != 0;
    const size_t mb = smp ? (size_t)SEQ + (size_t)DECS * b : 0;
    const bf16_t* __restrict__ Z = P.Z;
    {
        u32x4 qa[4], qg[4], qc[3], qs[3], qu[3], qb[2];
        const u32x4 z4 = {0u, 0u, 0u, 0u};
#pragma unroll
        for (int k = 0; k < 4; ++k) { const int i = rs + 16 * k, t = t0 - 30 + i; qa[k] = z4; qg[k] = z4; if (i < NR + 30 && t >= 0) { const bf16_t* zr = Z + (mb + t) * ZW + ch0; qa[k] = *(const u32x4*)(zr + 1024); qg[k] = *(const u32x4*)(zr + 1280); } }
#pragma unroll
        for (int k = 0; k < 3; ++k) { const int i = rs + 16 * k, t = t0 - 2 + i; qc[k] = z4; qs[k] = z4; if (i < NR + 2 && t >= 0) { const bf16_t* zr = Z + (mb + t) * ZW + ch0; qc[k] = *(const u32x4*)(zr + 512); qs[k] = *(const u32x4*)(zr + 768); } }
#pragma unroll
        for (int k = 0; k < 3; ++k) { const int i = rs + 16 * k, t = t0 - 15 + i; qu[k] = z4; if (i < NR + 15 && t >= 0) qu[k] = *(const u32x4*)(Z + (mb + t) * ZW + ch0); }
#pragma unroll
        for (int k = 0; k < 2; ++k) { const int i = rs + 16 * k; qb[k] = z4; if (i < NR) qb[k] = *(const u32x4*)(Z + (mb + t0 + i) * ZW + 256 + ch0); }
#pragma unroll
        for (int k = 0; k < 4; ++k) { const int i = rs + 16 * k, t = t0 - 30 + i;
            if (i < NR + 30) { float v[8];
                if (t >= 0) { float a[8], g[8]; unpack8(qa[k], a); unpack8(qg[k], g);
#pragma unroll
                    for (int j = 0; j < 8; ++j) v[j] = a[j] * fsig(g[j]); }
                else if (smp) ld8f(P.st_cconv + ((size_t)b * 30 + (30 + t)) * 256 + ch0, v);
                else {
#pragma unroll
                    for (int j = 0; j < 8; ++j) v[j] = 0.f; }
                *(LAS u32x4*)(TG + i * 256 + ch0) = pack8(v);
                if (!smp) { if (t >= t0 && t >= SEQ - 30) st8f(P.out + O_CCP + ((size_t)l * 30 + (t - (SEQ - 30))) * 256 + ch0, v); }
                else { if (t + 14 >= 0) st8f(P.out + O_CCS + (((size_t)l * DECB + b) * 30 + (t + 14)) * 256 + ch0, v); } } }
#pragma unroll
        for (int k = 0; k < 3; ++k) { const int i = rs + 16 * k, t = t0 - 2 + i;
            if (i < NR + 2) { float v[8];
                if (t >= 0) { float a[8], g[8]; unpack8(qc[k], a); unpack8(qs[k], g);
#pragma unroll
                    for (int j = 0; j < 8; ++j) v[j] = a[j] * g[j]; }
                else if (smp) ld8f(P.st_sconv + ((size_t)b * 2 + (2 + t)) * 256 + ch0, v);
                else {
#pragma unroll
                    for (int j = 0; j < 8; ++j) v[j] = 0.f; }
                *(LAS u32x4*)(TC + i * 256 + ch0) = pack8(v);
                if (!smp) { if (t >= t0 && t >= SEQ - 2) st8f(P.out + O_SCP + ((size_t)l * 2 + (t - (SEQ - 2))) * 256 + ch0, v); }
                else { if (t >= DECS - 2) st8f(P.out + O_SCS + (((size_t)l * DECB + b) * 2 + (t - (DECS - 2))) * 256 + ch0, v); } } }
#pragma unroll
        for (int k = 0; k < 3; ++k) { const int i = rs + 16 * k, t = t0 - 15 + i;
            if (i < NR + 15) { float v[8];
                if (t >= 0) unpack8(qu[k], v);
                else if (smp) ld8f(P.st_pool + ((size_t)b * 15 + (15 + t)) * 256 + ch0, v);
                else {
#pragma unroll
                    for (int j = 0; j < 8; ++j) v[j] = 0.f; }
                *(LAS u32x4*)(TU + i * 256 + ch0) = (t >= 0) ? qu[k] : pack8(v);
                if (!smp) { if (t >= t0 && t >= SEQ - 15) st8f(P.out + O_POOLP + ((size_t)l * 15 + (t - (SEQ - 15))) * 256 + ch0, v); }
                else { if (t >= 1) st8f(P.out + O_POOLS + (((size_t)l * DECB + b) * 15 + (t - 1)) * 256 + ch0, v); } } }
#pragma unroll
        for (int k = 0; k < 2; ++k) { const int i = rs + 16 * k; if (i < NR) *(LAS u32x4*)(TB + i * 256 + ch0) = qb[k]; }
    }
    __syncthreads();
    {
        float w0[8], w1[8], w2[8]; ld8f(P.sconv_w + ch0, w0); ld8f(P.sconv_w + 256 + ch0, w1); ld8f(P.sconv_w + 512 + ch0, w2);
#pragma unroll
        for (int j = 0; j < RPT; ++j) { const int r = rs * RPT + j; float c0[8], c1[8], c2[8], zb[8], y[8];
            unpack8(*(const LAS u32x4*)(TC + r * 256 + ch0), c0); unpack8(*(const LAS u32x4*)(TC + (r + 1) * 256 + ch0), c1); unpack8(*(const LAS u32x4*)(TC + (r + 2) * 256 + ch0), c2);
            unpack8(*(const LAS u32x4*)(TB + r * 256 + ch0), zb);
#pragma unroll
            for (int q = 0; q < 8; ++q) y[q] = zb[q] * (w0[q] * c0[q] + w1[q] * c1[q] + w2[q] * c2[q]);
            *(u32x4*)(P.Y + (mb + t0 + r) * YW + 256 + ch0) = pack8(y); }
    }
    {
        float u[HR + 15];
#pragma unroll
        for (int i = 0; i < HR + 15; ++i) u[i] = bf2f(TU[(half * HR + i) * 256 + ch]);
        const int win = 2 << (ch >> 6);
#pragma unroll
        for (int r = 0; r < HR; ++r) { const int t = t0 + half * HR + r; float s = 0.f;
#pragma unroll
            for (int j = 0; j < 16; ++j) if (j < win) s += u[15 + r - j];
            const int pos = smp ? PAST + t : t; const int cnt = (pos + 1 < win) ? pos + 1 : win;
            DAB[(half * HR + r) * DAB_LD + ch] = (bf16_t)f2bf(s / (float)cnt - u[15 + r]); }
    }
    __syncthreads();
    {
        float g[HR + 30];
#pragma unroll
        for (int i = 0; i < HR + 30; ++i) g[i] = bf2f(TG[(half * HR + i) * 256 + ch]);
        float w[31];
#pragma unroll
        for (int j = 0; j < 31; ++j) w[j] = P.cconv_w[j * 256 + ch];
#pragma unroll
        for (int r = 0; r < HR; ++r) { float a = 0.f;
#pragma unroll
            for (int j = 0; j < 31; ++j) a += w[j] * g[r + j];
            cv[(half * HR + r) * 256 + ch] = a; }
    }
    {
        const int fr = lane & 15, fq = lane >> 4, g4 = wid >> 1, nt0 = (wid & 1) * 2;
        bf16x8 Bw[2][2], Ad[2][2];
#pragma unroll
        for (int nt = 0; nt < 2; ++nt)
#pragma unroll
            for (int ks = 0; ks < 2; ++ks) Bw[nt][ks] = *(const bf16x8*)(WTg + (size_t)(g4 * 64 + (nt0 + nt) * 16 + fr) * 64 + ks * 32 + fq * 8);
#pragma unroll
        for (int mt = 0; mt < NR / 16; ++mt)
#pragma unroll
            for (int ks = 0; ks < 2; ++ks) Ad[mt][ks] = *(const LAS bf16x8*)(DAB + (mt * 16 + fr) * DAB_LD + g4 * 64 + ks * 32 + fq * 8);
#pragma unroll
        for (int mt = 0; mt < NR / 16; ++mt)
#pragma unroll
            for (int nt = 0; nt < 2; ++nt) { f32x4 acc = {0.f, 0.f, 0.f, 0.f};
                acc = __builtin_amdgcn_mfma_f32_16x16x32_bf16(Bw[nt][0], Ad[mt][0], acc, 0, 0, 0);
                acc = __builtin_amdgcn_mfma_f32_16x16x32_bf16(Bw[nt][1], Ad[mt][1], acc, 0, 0, 0);
                const int col = g4 * 64 + (nt0 + nt) * 16 + 4 * fq; const f32x4 sc = *(const f32x4*)(P.pool_scale + col);
                u32x2 wv; wv.x = pk2f(acc[0] * sc[0], acc[1] * sc[1]); wv.y = pk2f(acc[2] * sc[2], acc[3] * sc[3]);
                *(u32x2*)(P.Y + (mb + t0 + mt * 16 + fr) * YW + col) = wv; }
    }
    __syncthreads();
    {
        const f32x4 bi = *(const f32x4*)(P.cconv_b + 4 * lane), lg = *(const f32x4*)(P.ln_g + 4 * lane), lb = *(const f32x4*)(P.ln_b + 4 * lane);
#pragma unroll
        for (int k = 0; k < NR / 8; ++k) { const int r = wid + 8 * k;
            f32x4 v = *(const LAS f32x4*)(cv + r * 256 + 4 * lane) + bi;
            const float mean = wsum((v[0] + v[1]) + (v[2] + v[3]), lane) * (1.f / 256.f);
            v = v - mean;
            const float rstd = 1.0f / sqrtf(wsum((v[0] * v[0] + v[1] * v[1]) + (v[2] * v[2] + v[3] * v[3]), lane) * (1.f / 256.f) + EPS);
            f32x4 y = v * rstd * lg + lb;
#pragma unroll
            for (int i = 0; i < 4; ++i) y[i] = y[i] * fsig(y[i]);
            u32x2 wv; wv.x = pk2f(y[0], y[1]); wv.y = pk2f(y[2], y[3]);
            *(u32x2*)(P.Y + (mb + t0 + r) * YW + 512 + 4 * lane) = wv; }
    }
    {
        const int map = lane >> 3, c8 = lane & 7, cm = c8 & 3;
        float gq[8], gk[8]; ld8f(P.qg + 8 * c8, gq); ld8f(P.kg + 8 * c8, gk);
        const float sgn = (c8 < 4) ? -1.0f : 1.0f;
#pragma unroll
        for (int k = 0; k < NR / 8; ++k) { const int rr = wid * (NR / 8) + k, t = t0 + rr; const int pos = smp ? PAST + t : t;
            float co[8], si[8]; ld8f(P.rope + (size_t)pos * 64 + 8 * cm, co); ld8f(P.rope + (size_t)pos * 64 + 32 + 8 * cm, si);
            const bf16_t* src = Z + (mb + t) * ZW + 1536 + lane * 8;
            const u32x4 wq = *(const u32x4*)src, wk = *(const u32x4*)(src + 512);
#pragma unroll
            for (int kind = 0; kind < 2; ++kind) { float v[8]; unpack8(kind ? wk : wq, v);
                float ss = 0.f;
#pragma unroll
                for (int j = 0; j < 8; ++j) ss += v[j] * v[j];
                ss += __builtin_bit_cast(float, __builtin_amdgcn_ds_bpermute((lane ^ 1) << 2, __builtin_bit_cast(int, ss)));
                ss += __builtin_bit_cast(float, __builtin_amdgcn_ds_bpermute((lane ^ 2) << 2, __builtin_bit_cast(int, ss)));
                ss += __builtin_bit_cast(float, __builtin_amdgcn_ds_bpermute((lane ^ 4) << 2, __builtin_bit_cast(int, ss)));
                const float rn = 1.0f / sqrtf(ss * (1.f / 64.f) + EPS);
                float a[8], o[8];
#pragma unroll
                for (int j = 0; j < 8; ++j) a[j] = v[j] * rn * (kind ? gk[j] : gq[j]);
#pragma unroll
                for (int j = 0; j < 8; ++j) { const float ap = __builtin_bit_cast(float, __builtin_amdgcn_ds_bpermute((lane ^ 4) << 2, __builtin_bit_cast(int, a[j])));
                    o[j] = a[j] * co[j] + sgn * ap * si[j]; }
                if (kind == 0) {
#pragma unroll
                    for (int j = 0; j < 8; ++j) o[j] *= C2;
                    bf16_t* dst = smp ? P.QS + ((size_t)b * QSROWS + t) * 512 + lane * 8 : P.Qp + (size_t)t * 512 + lane * 8;
                    *(u32x4*)dst = pack8(o);
                } else {
                    if (!smp) *(u32x4*)(P.Kp + (size_t)t * 512 + lane * 8) = pack8(o);
                    st8f(smp ? P.out + O_KS + (((size_t)l * DECB + b) * DECS + t) * 512 + lane * 8 : P.out + O_KP + ((size_t)l * SEQ + t) * 512 + lane * 8, o);
                }
            }
        }
#pragma unroll
        for (int k = 0; k < NR / 8; ++k) { const int idx = tid + 512 * k, r2 = idx >> 6, c8 = (idx & 63) * 8, t = t0 + r2;
            const u32x4 w = *(const u32x4*)(Z + (mb + t) * ZW + 2560 + c8);
            if (!smp) *(u32x4*)(P.Vp + (size_t)t * 512 + c8) = w;
            f32x4* od = (f32x4*)(smp ? P.out + O_VS + (((size_t)l * DECB + b) * DECS + t) * 512 + c8 : P.out + O_VP + ((size_t)l * SEQ + t) * 512 + c8);
            od[0] = (f32x4){__builtin_bit_cast(float, w.x << 16), __builtin_bit_cast(float, w.x & 0xffff0000u), __builtin_bit_cast(float, w.y << 16), __builtin_bit_cast(float, w.y & 0xffff0000u)};
            od[1] = (f32x4){__builtin_bit_cast(float, w.z << 16), __builtin_bit_cast(float, w.z & 0xffff0000u), __builtin_bit_cast(float, w.w << 16), __builtin_bit_cast(float, w.w & 0xffff0000u)}; }
    }
    __syncthreads();
}
}
#endif
#ifndef CPU_TEST_NEVER
namespace tailg {
#define TG_GAS __attribute__((address_space(1)))
typedef short bf16x8 __attribute__((ext_vector_type(8)));
typedef float f32x4 __attribute__((ext_vector_type(4)));
typedef unsigned u32x2 __attribute__((ext_vector_type(2)));
constexpr int TM = 32, TN = 64, NTILES = (MS / TM) * (D / TN);
template <int MODE> struct Tail {
    const bf16_t* A; const bf16_t* Bt;
    float* X; bf16_t* XB; float* SSP;
    bf16_t* OUT; const bf16_t* gate;
    int K, lda, ldb, ldg; float s; int pad;
};
template <int MODE> __device__ __forceinline__ void run(LAS unsigned char* lds, int tid, int bx, int G, const Tail<MODE>& t) {
    const int lane = tid & 63, w = __builtin_amdgcn_readfirstlane(tid >> 6), fr = lane & 15, fq = lane >> 4;
    LAS f32x4* RED = (LAS f32x4*)lds;
    const int nsteps = t.K / 32, per = nsteps / 8;
    for (int tile = bx; tile < NTILES; tile += G) {
        const int R0 = SEQ + (tile >> 4) * TM, C0 = (tile & 15) * TN;
        const bf16_t* ap = t.A + (size_t)(R0 + fr) * t.lda + fq * 8;
        const bf16_t* bp = t.Bt + (size_t)(C0 + fr) * t.ldb + fq * 8;
        f32x4 acc[2][4], tot[2][4];
#pragma unroll
        for (int m = 0; m < 2; ++m)
#pragma unroll
            for (int n = 0; n < 4; ++n) { acc[m][n] = (f32x4){0.f, 0.f, 0.f, 0.f}; tot[m][n] = (f32x4){0.f, 0.f, 0.f, 0.f}; }
        const int s0 = w * per;
        u32x2 xw0 = {0u, 0u};
        if (MODE == 0) xw0 = *(const TG_GAS u32x2*)(t.XB + (size_t)(R0 + (w >> 2) * 16 + fr) * D + C0 + (w & 3) * 16 + 4 * fq);
        for (int sb = 0; sb < per; sb += 6) {
            bf16x8 af[6][2], bf[6][4];
#pragma unroll
            for (int j = 0; j < 6; ++j) if (sb + j < per) { const int k0 = (s0 + sb + j) * 32;
#pragma unroll
                for (int m = 0; m < 2; ++m) af[j][m] = *(const TG_GAS bf16x8*)(ap + (size_t)(m * 16) * t.lda + k0);
#pragma unroll
                for (int n = 0; n < 4; ++n) bf[j][n] = *(const TG_GAS bf16x8*)(bp + (size_t)(n * 16) * t.ldb + k0); }
#pragma unroll
            for (int j = 0; j < 6; ++j) if (sb + j < per) {
#pragma unroll
                for (int m = 0; m < 2; ++m)
#pragma unroll
                    for (int n = 0; n < 4; ++n) acc[m][n] = __builtin_amdgcn_mfma_f32_16x16x32_bf16(bf[j][n], af[j][m], acc[m][n], 0, 0, 0);
                if (MODE == 1) {
                    const int st = s0 + sb + j, br = st < 8 ? 0 : st < 16 ? 1 : st < 24 ? 2 : 3, nx = st + 1, brn = nx < 8 ? 0 : nx < 16 ? 1 : nx < 24 ? 2 : 3;
                    if (brn != br || sb + j + 1 == per) {
#pragma unroll
                        for (int m = 0; m < 2; ++m)
#pragma unroll
                            for (int n = 0; n < 4; ++n) { const bf16_t* fp = t.gate + (size_t)(R0 + m * 16 + fr) * t.ldg + C0 + n * 16 + 4 * fq;
                                const u32x2 gw = *(const TG_GAS u32x2*)(fp + br * 1024); f32x4 g;
                                g[0] = __builtin_bit_cast(float, gw.x << 16); g[1] = __builtin_bit_cast(float, gw.x & 0xffff0000u); g[2] = __builtin_bit_cast(float, gw.y << 16); g[3] = __builtin_bit_cast(float, gw.y & 0xffff0000u);
                                tot[m][n] += g * acc[m][n]; acc[m][n] = (f32x4){0.f, 0.f, 0.f, 0.f}; }
                    }
                }
            }
        }
#pragma unroll
        for (int m = 0; m < 2; ++m)
#pragma unroll
            for (int n = 0; n < 4; ++n) RED[(w * 8 + m * 4 + n) * 64 + lane] = (MODE == 1) ? tot[m][n] : acc[m][n];
        __syncthreads();
        f32x4 v = RED[(0 * 8 + w) * 64 + lane];
#pragma unroll
        for (int w2 = 1; w2 < 8; ++w2) v += RED[(w2 * 8 + w) * 64 + lane];
        const size_t row = (size_t)(R0 + (w >> 2) * 16 + fr); const int col = C0 + (w & 3) * 16 + 4 * fq;
        if (MODE == 0) { const u32x2 xw = xw0;
            f32x4 xn; xn[0] = __builtin_bit_cast(float, xw.x << 16); xn[1] = __builtin_bit_cast(float, xw.x & 0xffff0000u); xn[2] = __builtin_bit_cast(float, xw.y << 16); xn[3] = __builtin_bit_cast(float, xw.y & 0xffff0000u);
            xn += v * t.s;
            if (t.X) *(TG_GAS f32x4*)(t.X + row * D + col) = xn;
            else { u32x2 o; o.x = f2bf(xn[0]) | (f2bf(xn[1]) << 16); o.y = f2bf(xn[2]) | (f2bf(xn[3]) << 16); *(TG_GAS u32x2*)(t.XB + row * D + col) = o; }
            float ss = (xn[0] * xn[0] + xn[1] * xn[1]) + (xn[2] * xn[2] + xn[3] * xn[3]);
            ss += __builtin_bit_cast(float, __builtin_amdgcn_ds_bpermute((lane ^ 16) << 2, __builtin_bit_cast(int, ss)));
            ss += __builtin_bit_cast(float, __builtin_amdgcn_ds_bpermute((lane ^ 32) << 2, __builtin_bit_cast(int, ss)));
            __syncthreads();
            LAS float* PS = (LAS float*)lds;
            if (fq == 0) PS[((w >> 2) * 16 + fr) * 4 + (w & 3)] = ss;
            __syncthreads();
            if (tid < TM) t.SSP[(size_t)(R0 - SEQ + tid) * 16 + (tile & 15)] = (PS[tid * 4] + PS[tid * 4 + 1]) + (PS[tid * 4 + 2] + PS[tid * 4 + 3]); }
        else { u32x2 o; o.x = f2bf(v[0]) | (f2bf(v[1]) << 16); o.y = f2bf(v[2]) | (f2bf(v[3]) << 16); *(TG_GAS u32x2*)(t.OUT + row * D + col) = o; }
        __syncthreads();
    }
}
}
#endif
#ifndef CPU_TEST
namespace sattn {
using attn_body::bf16x8; using attn_body::f32x16; using attn_body::s16x4; using attn_body::crow; using attn_body::vtr; using attn_body::lds_cptr; using attn_body::cvtpk_s;
typedef float f32x4 __attribute__((ext_vector_type(4)));
typedef float f32x2 __attribute__((ext_vector_type(2)));
typedef unsigned u32x4 __attribute__((ext_vector_type(4)));
#define SA_GAS __attribute__((address_space(1)))
constexpr int PART_LD = 132;
constexpr int N_ITEMS = DECB * 4 * 2;
__device__ __forceinline__ bf16x8 pack8f(const f32x4 a, const f32x4 c) { u32x4 w; w.x = cvtpk_s(a[0], a[1]); w.y = cvtpk_s(a[2], a[3]); w.z = cvtpk_s(c[0], c[1]); w.w = cvtpk_s(c[2], c[3]); return __builtin_bit_cast(bf16x8, w); }

__device__ __forceinline__ void item(int it, const float* __restrict__ ck, const float* __restrict__ cv, const float* __restrict__ knew, const float* __restrict__ vnew, const bf16_t* __restrict__ QS, float* PART,
                                     LAS unsigned char* lds, LAS float* ex, int tid) {
    const int lane = tid & 63, w = __builtin_amdgcn_readfirstlane(tid >> 6), r32 = lane & 31, hi = lane >> 5;
    const int b = it >> 3, h = (it >> 1) & 3, kh = it & 1;
    LAS float* EXM = ex; LAS float* wsf = ex + 512 + w * 32;
    bf16x8 qn[4]; const bool mp1 = (r32 >> 4) != 0;
    { const int q = r32 & 15, mp = r32 >> 4; const bf16_t* qrow = QS + ((size_t)b * QSROWS + q) * 512 + (2 * h + mp) * 64 + hi * 8;
#pragma unroll
      for (int j = 0; j < 4; ++j) qn[j] = *(const SA_GAS bf16x8*)(qrow + j * 16); }
    float m = -INFINITY, l = 0.f; f32x16 o[4];
#pragma unroll
    for (int d = 0; d < 4; ++d) o[d] = f32x16{};
    LAS unsigned char* vbuf = lds + w * 8192;
    const lds_cptr vp = (lds_cptr)vbuf + ((lane >> 4) & 1) * 32 + (lane & 3) * 8 + (4 * hi + ((lane & 15) >> 2)) * 64;
    const int nsteps = (kh == 1 && w == 7) ? 5 : 4;
    f32x4 ka[8], kc[8], va[2][4], vc[2][4];
#define SA_STEP_PTRS(ss, Kp_, Vp_, nv_) do { if ((ss) < 4) { const size_t k0_ = (size_t)b * PAST + 1024 * kh + 128 * w + 32 * (ss); Kp_ = ck + k0_ * 512 + h * 128; Vp_ = cv + k0_ * 512 + h * 128; nv_ = 32; } \
        else { Kp_ = knew + (size_t)b * DECS * 512 + h * 128; Vp_ = vnew + (size_t)b * DECS * 512 + h * 128; nv_ = DECS; } } while (0)
#define SA_LOAD_K(ss) do { const float* Kp_; const float* Vp_; int nv_; SA_STEP_PTRS(ss, Kp_, Vp_, nv_); (void)Vp_; int t_ = tid; asm volatile("" : "+v"(t_)); const int r_ = t_ & 31, h_ = (t_ >> 5) & 1; \
        const int krow_ = r_ < nv_ ? r_ : nv_ - 1; const SA_GAS f32x4* kp_ = (const SA_GAS f32x4*)(Kp_ + (size_t)krow_ * 512 + h_ * 8); \
        _Pragma("unroll") for (int j = 0; j < 8; ++j) { ka[j] = kp_[j * 4]; kc[j] = kp_[j * 4 + 1]; } } while (0)
#define SA_LOAD_V(ss) do { const float* Kp_; const float* Vp_; int nv_; SA_STEP_PTRS(ss, Kp_, Vp_, nv_); (void)Kp_; \
        int t_ = tid; asm volatile("" : "+v"(t_)); const int k16_ = (t_ & 63) >> 2, c4_ = t_ & 3; \
        _Pragma("unroll") for (int kq = 0; kq < 2; ++kq) { const int vr_ = kq * 16 + k16_, vrow_ = vr_ < nv_ ? vr_ : nv_ - 1; const SA_GAS f32x4* vpn_ = (const SA_GAS f32x4*)(Vp_ + (size_t)vrow_ * 512 + c4_ * 8); \
            _Pragma("unroll") for (int db = 0; db < 4; ++db) { va[kq][db] = vpn_[db * 8]; vc[kq][db] = vpn_[db * 8 + 1]; } } } while (0)
    SA_LOAD_K(0);
    for (int s = 0; s < nsteps; ++s) {
        const int nvalid = (s < 4) ? 32 : DECS;
        SA_LOAD_V(s);
        __builtin_amdgcn_sched_barrier(0);
        f32x16 S = f32x16{};
#pragma unroll
        for (int j = 0; j < 8; ++j) { const bf16x8 z8 = {0, 0, 0, 0, 0, 0, 0, 0}; const bf16x8 qb = ((j >= 4) == mp1) ? qn[j & 3] : z8; S = __builtin_amdgcn_mfma_f32_32x32x16_bf16(pack8f(ka[j], kc[j]), qb, S, 0, 0, 0); }
        if (nvalid < 32) {
#pragma unroll
            for (int r = 0; r < 16; ++r) if (crow(r, hi) >= nvalid) S[r] = -INFINITY; }
        float rm = S[0];
#pragma unroll
        for (int r = 1; r < 16; ++r) rm = fmaxf(rm, S[r]);
        { auto rr = __builtin_amdgcn_permlane32_swap(__float_as_uint(rm), __float_as_uint(rm), false, false); rm = fmaxf(__uint_as_float(rr[0]), __uint_as_float(rr[1])); }
        const float mn = fmaxf(m, rm), alpha = __builtin_amdgcn_exp2f(m - mn); m = mn;
        float ls = 0.f;
#pragma unroll
        for (int r = 0; r < 16; ++r) { S[r] = __builtin_amdgcn_exp2f(S[r] - mn); ls += S[r]; }
        l = l * alpha + ls;
        u32x4 pw0, pw1;
        pw0 = (u32x4){cvtpk_s(S[0], S[1]), cvtpk_s(S[2], S[3]), cvtpk_s(S[4], S[5]), cvtpk_s(S[6], S[7])};
        pw1 = (u32x4){cvtpk_s(S[8], S[9]), cvtpk_s(S[10], S[11]), cvtpk_s(S[12], S[13]), cvtpk_s(S[14], S[15])};
        if (hi == 0) wsf[r32] = alpha;
        __builtin_amdgcn_sched_barrier(0);
        if (s + 1 < nsteps) SA_LOAD_K(s + 1);
        __builtin_amdgcn_sched_barrier(0);
#pragma unroll
        for (int kq = 0; kq < 2; ++kq)
#pragma unroll
            for (int db = 0; db < 4; ++db) *(LAS bf16x8*)(vbuf + (db * 2 + kq) * 1024 + lane * 16) = pack8f(va[kq][db], vc[kq][db]);
        asm volatile("s_waitcnt lgkmcnt(0)" ::: "memory");
#pragma unroll
        for (int d = 0; d < 4; ++d)
#pragma unroll
            for (int r = 0; r < 16; ++r) o[d][r] *= wsf[crow(r, hi)];
#pragma unroll
        for (int kq = 0; kq < 2; ++kq)
#pragma unroll
            for (int db = 0; db < 4; ++db) { const s16x4 vlo = vtr(vp + (db * 2 + kq) * 1024), vhi = vtr(vp + (db * 2 + kq) * 1024 + 512);
                const bf16x8 vf = (bf16x8){vlo[0], vlo[1], vlo[2], vlo[3], vhi[0], vhi[1], vhi[2], vhi[3]};
                o[db] = __builtin_amdgcn_mfma_f32_32x32x16_bf16(__builtin_bit_cast(bf16x8, kq ? pw1 : pw0), vf, o[db], 0, 0, 0); }
        asm volatile("s_waitcnt lgkmcnt(0)" ::: "memory");
    }
#undef SA_STEP_PTRS
#undef SA_LOAD_K
#undef SA_LOAD_V
    int tidb = tid; asm volatile("" : "+v"(tidb)); const int laneb = tidb & 63, r32b = laneb & 31, hib = laneb >> 5;
    LAS float* wsfb = ex + 512 + w * 32;
    { auto rr = __builtin_amdgcn_permlane32_swap(__float_as_uint(l), __float_as_uint(l), false, false); l = __uint_as_float(rr[0]) + __uint_as_float(rr[1]); }
    if (hib == 0) { EXM[w * 64 + r32b] = m; EXM[w * 64 + 32 + r32b] = l; }
    __syncthreads();
    float Mx = EXM[r32b];
#pragma unroll
    for (int w2 = 1; w2 < 8; ++w2) Mx = fmaxf(Mx, EXM[w2 * 64 + r32b]);
    float Lx = 0.f;
#pragma unroll
    for (int w2 = 0; w2 < 8; ++w2) Lx += __builtin_amdgcn_exp2f(EXM[w2 * 64 + r32b] - Mx) * EXM[w2 * 64 + 32 + r32b];
    if (hib == 0) wsfb[r32b] = __builtin_amdgcn_exp2f(m - Mx);
    asm volatile("s_waitcnt lgkmcnt(0)" ::: "memory");
#pragma unroll
    for (int d = 0; d < 4; ++d)
#pragma unroll
        for (int r = 0; r < 16; ++r) o[d][r] *= wsfb[crow(r, hib)];
    __syncthreads();
    LAS float* OX = (LAS float*)lds;
#pragma unroll
    for (int d = 0; d < 4; ++d)
#pragma unroll
        for (int r = 0; r < 16; ++r) OX[(w * 32 + crow(r, hib)) * 128 + 32 * d + r32b] = o[d][r];
    __syncthreads();
#pragma unroll
    for (int k = 0; k < 4; ++k) { const int row = 4 * w + k; f32x2 acc = *(const LAS f32x2*)(OX + row * 128 + 2 * laneb);
#pragma unroll
        for (int w2 = 1; w2 < 8; ++w2) acc += *(const LAS f32x2*)(OX + (w2 * 32 + row) * 128 + 2 * laneb);
        *(SA_GAS f32x2*)(PART + ((size_t)it * 32 + row) * PART_LD + 2 * laneb) = acc; }
    if (hib == 0 && (r32b >> 2) == w) { SA_GAS float* pp = (SA_GAS float*)(PART + ((size_t)it * 32 + r32b) * PART_LD + 128); pp[0] = Mx; pp[1] = Lx; }
    __syncthreads();
}
__device__ __forceinline__ void post_sample(const float* PART, bf16_t* Ydst  , int b, int t, int h, float lam, float scale, const float* subln_g) {
    const SA_GAS float* p00 = (const SA_GAS float*)(PART + ((size_t)(((b * 4 + h) * 2 + 0) * 32) + t) * PART_LD);
    const SA_GAS float* p01 = p00 + 16 * PART_LD; const SA_GAS float* p10 = p00 + 32 * PART_LD; const SA_GAS float* p11 = p10 + 16 * PART_LD;
    float a0, a1, c0, c1;
    { const float M0 = p00[128], L0 = p00[129], M1 = p10[128], L1 = p10[129], Mx = fmaxf(M0, M1), f0 = __builtin_amdgcn_exp2f(M0 - Mx), f1 = __builtin_amdgcn_exp2f(M1 - Mx), inv = 1.0f / (f0 * L0 + f1 * L1); a0 = f0 * inv; a1 = f1 * inv; }
    { const float M0 = p01[128], L0 = p01[129], M1 = p11[128], L1 = p11[129], Mx = fmaxf(M0, M1), f0 = __builtin_amdgcn_exp2f(M0 - Mx), f1 = __builtin_amdgcn_exp2f(M1 - Mx), inv = 1.0f / (f0 * L0 + f1 * L1); c0 = f0 * inv; c1 = f1 * inv; }
    float ss = 0.f;
    for (int i = 0; i < 32; ++i) { const f32x4 x0 = *(const SA_GAS f32x4*)(p00 + 4 * i), x1 = *(const SA_GAS f32x4*)(p10 + 4 * i), y0 = *(const SA_GAS f32x4*)(p01 + 4 * i), y1 = *(const SA_GAS f32x4*)(p11 + 4 * i);
        const f32x4 ov = (x0 * a0 + x1 * a1) - lam * (y0 * c0 + y1 * c1); ss += (ov[0] * ov[0] + ov[1] * ov[1]) + (ov[2] * ov[2] + ov[3] * ov[3]); }
    const float rn = scale / sqrtf(ss * (1.f / 128.f) + EPS);
    for (int i = 0; i < 16; ++i) { float ob[8];
#pragma unroll
        for (int hh = 0; hh < 2; ++hh) { const int i4 = 2 * i + hh; const f32x4 x0 = *(const SA_GAS f32x4*)(p00 + 4 * i4), x1 = *(const SA_GAS f32x4*)(p10 + 4 * i4), y0 = *(const SA_GAS f32x4*)(p01 + 4 * i4), y1 = *(const SA_GAS f32x4*)(p11 + 4 * i4);
            const f32x4 ov = (x0 * a0 + x1 * a1) - lam * (y0 * c0 + y1 * c1);
#pragma unroll
            for (int j = 0; j < 4; ++j) ob[4 * hh + j] = ov[j] * rn * subln_g[8 * i + 4 * hh + j]; }
        st_bf16x8(Ydst + 8 * i, ob); }
}
__device__ __forceinline__ void post_sample_wave(const float* PART, bf16_t* Ydst  , int b, int t, int h, float lam, float scale, const float* subln_g, int lane) {
    const SA_GAS float* p00 = (const SA_GAS float*)(PART + ((size_t)(((b * 4 + h) * 2 + 0) * 32) + t) * PART_LD);
    const SA_GAS float* p01 = p00 + 16 * PART_LD; const SA_GAS float* p10 = p00 + 32 * PART_LD; const SA_GAS float* p11 = p10 + 16 * PART_LD;
    const f32x2 x0 = *(const SA_GAS f32x2*)(p00 + 2 * lane), x1 = *(const SA_GAS f32x2*)(p10 + 2 * lane), y0 = *(const SA_GAS f32x2*)(p01 + 2 * lane), y1 = *(const SA_GAS f32x2*)(p11 + 2 * lane);
    const f32x2 ml00 = *(const SA_GAS f32x2*)(p00 + 128), ml10 = *(const SA_GAS f32x2*)(p10 + 128), ml01 = *(const SA_GAS f32x2*)(p01 + 128), ml11 = *(const SA_GAS f32x2*)(p11 + 128);
    const f32x2 sg = *(const SA_GAS f32x2*)(subln_g + 2 * lane);
    float a0, a1, c0, c1;
    { const float Mx = fmaxf(ml00[0], ml10[0]), f0 = __builtin_amdgcn_exp2f(ml00[0] - Mx), f1 = __builtin_amdgcn_exp2f(ml10[0] - Mx), inv = 1.0f / (f0 * ml00[1] + f1 * ml10[1]); a0 = f0 * inv; a1 = f1 * inv; }
    { const float Mx = fmaxf(ml01[0], ml11[0]), f0 = __builtin_amdgcn_exp2f(ml01[0] - Mx), f1 = __builtin_amdgcn_exp2f(ml11[0] - Mx), inv = 1.0f / (f0 * ml01[1] + f1 * ml11[1]); c0 = f0 * inv; c1 = f1 * inv; }
    const f32x2 ov = (x0 * a0 + x1 * a1) - lam * (y0 * c0 + y1 * c1);
    const float ss = mixf::wsum(ov[0] * ov[0] + ov[1] * ov[1], lane);
    const float rn = scale / sqrtf(ss * (1.f / 128.f) + EPS);
    const unsigned w = f2bf(ov[0] * rn * sg[0]) | (f2bf(ov[1] * rn * sg[1]) << 16);
    *(SA_GAS unsigned*)(Ydst + 2 * lane) = w;
}
}
#endif
constexpr int NWAVES = 8;
static_assert(M % 256 == 0 && SEQ % 512 == 0 && PAST % 64 == 0 && KSROWS % 128 == 0, "shape assumptions of the GEMM / attention bodies");
constexpr size_t MiB = 1u << 20;
constexpr size_t alup(size_t x) { return (x + MiB - 1) / MiB * MiB; }
constexpr size_t LW_GU1 = 0, LW_D1 = LW_GU1 + (size_t)NGU * D * 2, LW_IN = LW_D1 + (size_t)D * FF * 2, LW_P = LW_IN + (size_t)ZW * D * 2, LW_O = LW_P + (size_t)D * YW * 2,
                 LW_GU2 = LW_O + (size_t)D * D * 2, LW_D2 = LW_GU2 + (size_t)NGU * D * 2, LW_BYTES = LW_D2 + (size_t)D * FF * 2;
constexpr size_t WS_CTL = 0, CTL_ZERO_BYTES = 1 * MiB;
constexpr size_t WS_ROPE = 1 * MiB;
constexpr size_t WS_PWT = alup(WS_ROPE + (size_t)ROPE_ROWS * 64 * 4);
constexpr size_t WS_W = alup(WS_PWT + (size_t)DEPTH * 256 * 64 * 2);
constexpr size_t WS_XN = alup(WS_W + (size_t)DEPTH * LW_BYTES);
constexpr size_t WS_ACT = alup(WS_XN + (size_t)M * D * 2);
constexpr size_t WS_Z = alup(WS_ACT + (size_t)M * FF * 2);
constexpr size_t WS_Y = alup(WS_Z + (size_t)M * ZW * 2);
constexpr size_t WS_QP = alup(WS_Y + (size_t)M * YW * 2);
constexpr size_t WS_KP = alup(WS_QP + (size_t)SEQ * 512 * 2);
constexpr size_t WS_VP = alup(WS_KP + (size_t)SEQ * 512 * 2);
constexpr size_t WS_OB = alup(WS_VP + (size_t)SEQ * 512 * 2);
constexpr size_t WS_QS = alup(WS_OB + (size_t)SEQ * 1024 * 2);
constexpr size_t WS_KS = alup(WS_QS + (size_t)DECB * QSROWS * 512 * 2);
constexpr size_t WS_VS = alup(WS_KS + (size_t)DECB * KSROWS * 512 * 2);
constexpr size_t WS_OS = alup(WS_VS + (size_t)DECB * KSROWS * 512 * 2);
constexpr size_t WS_MG = alup(WS_OS + (size_t)DECB * QSROWS * 1024 * 2);
constexpr size_t WS_MRG = alup(WS_MG + (size_t)M * D * 4);
constexpr size_t WS_SSP = alup(WS_MRG + (size_t)M * D * 2);
constexpr size_t WS_SS4 = alup(WS_SSP + (size_t)M * 16 * 4);
constexpr size_t WS_PART = alup(WS_SS4 + (size_t)SEQ * 4 * 4);
constexpr size_t WS_FAC = alup(WS_PART + (size_t)DECB * 8 * 32 * 132 * 4);
constexpr size_t WS_END = alup(WS_FAC + (size_t)(SEQ / 256) * 4 * 4 * 131072);
constexpr int CW_TMO = 0, CW_BAR = 4096;

constexpr int RING_OFF = 0, RING_BYTES = 131072;
constexpr int LDSCTL_OFF = RING_BYTES, MISC_OFF = LDSCTL_OFF + 320;
constexpr int LDS_BYTES = 147456;

typedef unsigned v4u __attribute__((ext_vector_type(4)));
typedef unsigned v2u __attribute__((ext_vector_type(2)));
typedef float f32x4 __attribute__((ext_vector_type(4)));
#define LDS_WAIT() asm volatile("s_waitcnt lgkmcnt(0)" ::: "memory")
#define VM_WAIT() asm volatile("s_waitcnt vmcnt(0)" ::: "memory")
__device__ __forceinline__ unsigned pk2(float lo, float hi) { return f2bf(lo) | (f2bf(hi) << 16); }

__device__ __forceinline__ int tid_now(int wv) { int z = 0; asm volatile("" : "+v"(z)); return wv * 64 + (int)__builtin_amdgcn_mbcnt_hi(~0u, __builtin_amdgcn_mbcnt_lo(~0u, (unsigned)z)); }
#define XB_TMO      128
#define XB_XCNT(j)  (256  + 64 * (j))
#define XB_XSUB(j)  (1280 + 64 * (j))
#define XB_XGEN(j)  (2304 + 64 * (j))
#define XB_TOP      3328
#define XB_TOPGEN   3392
#define XCD_BAR_WORDS 3456
#define XB_SPIN_CAP (1u << 18)
__device__ __forceinline__ unsigned xb_ld(unsigned* p)              { return __hip_atomic_load(p, __ATOMIC_RELAXED, __HIP_MEMORY_SCOPE_AGENT); }
__device__ __forceinline__ unsigned xb_add(unsigned* p, unsigned v) { return __hip_atomic_fetch_add(p, v, __ATOMIC_RELAXED, __HIP_MEMORY_SCOPE_AGENT); }
__device__ __forceinline__ unsigned xb_xcc_id() { return (unsigned)__builtin_amdgcn_s_getreg((3 << 11) | 20) & 0xFu; }
#define XB_SPIN(cond, bar) do { unsigned _sp = 0; while (cond) { __builtin_amdgcn_s_sleep(1); \
    if ((++_sp & 255u) == 0u) { if (xb_ld(&(bar)[XB_TMO])) break; if (_sp > XB_SPIN_CAP) { atomicAdd(&(bar)[XB_TMO], 1u); break; } } } } while (0)
struct XcdBarrier { unsigned* bar; unsigned x; volatile LAS unsigned* st; };
__device__ __forceinline__ XcdBarrier xcd_barrier_post(unsigned* bar, volatile LAS unsigned* st, int wv) {
    XcdBarrier b; b.bar = bar; b.x = xb_xcc_id(); b.st = st;
    if (tid_now(wv) == 0) (void)xb_add(&bar[XB_XCNT(b.x)], 1u);
    return b;
}
__device__ __forceinline__ void xcd_barrier_complete(unsigned* bar, unsigned x, unsigned& nloc, unsigned& nx) {
    const unsigned G = gridDim.x * gridDim.y * gridDim.z;
    unsigned sum, cnt, mine, sp = 0u;
    for (;;) {
        sum = 0u; cnt = 0u; mine = 0u;
#pragma unroll
        for (unsigned j = 0; j < 16; ++j) { const unsigned c = xb_ld(&bar[XB_XCNT(j)]); sum += c; cnt += (c > 0u) ? 1u : 0u; mine = (j == x) ? c : mine; }
        if (sum == G) break;
        __builtin_amdgcn_s_sleep(1);
        if ((++sp & 255u) == 0u) { if (xb_ld(&bar[XB_TMO])) break; if (sp > XB_SPIN_CAP) { atomicAdd(&bar[XB_TMO], 1u); break; } }
    }
    nloc = mine > 0u ? mine : 1u; nx = cnt > 0u ? cnt : 1u;
}
__device__ __forceinline__ void xcd_barrier(const XcdBarrier& b, int wv) {
    asm volatile("s_waitcnt vmcnt(0)" ::: "memory");
    __syncthreads();
    if (tid_now(wv) == 0) {
        unsigned* bar = b.bar; asm volatile("" : "+s"(bar));
        unsigned bx_ = b.x; asm volatile("" : "+s"(bx_));
        __builtin_amdgcn_s_waitcnt(0);
        unsigned nloc = b.st[0], nx = b.st[1];
        if (nloc == 0u) { xcd_barrier_complete(bar, bx_, nloc, nx); b.st[0] = nloc; b.st[1] = nx; }
        const unsigned old = xb_add(&bar[XB_XSUB(bx_)], 1u);
        const unsigned gen = old / nloc;
        if (old + 1u == (gen + 1u) * nloc) {
            __builtin_amdgcn_fence(__ATOMIC_RELEASE, "agent");
            asm volatile("s_waitcnt vmcnt(0)" ::: "memory");
            const unsigned og = xb_add(&bar[XB_TOP], 1u);
            const unsigned tg = og / nx;
            if (og + 1u == (tg + 1u) * nx) xb_add(&bar[XB_TOPGEN], 1u);
            else XB_SPIN(xb_ld(&bar[XB_TOPGEN]) == tg, bar);
            __builtin_amdgcn_fence(__ATOMIC_ACQUIRE, "agent");
            xb_add(&bar[XB_XGEN(bx_)], 1u);
            asm volatile("s_waitcnt vmcnt(0)" ::: "memory");
        } else {
            XB_SPIN(xb_ld(&bar[XB_XGEN(bx_)]) == gen, bar);
            __builtin_amdgcn_fence(__ATOMIC_ACQUIRE, "agent");
            asm volatile("s_waitcnt vmcnt(0)" ::: "memory");
        }
    }
    __syncthreads();
}

__device__ __forceinline__ float wave_sum(float v, int lane) {
#pragma unroll
    for (int o = 1; o < 64; o <<= 1) v += __builtin_bit_cast(float, __builtin_amdgcn_ds_bpermute((lane ^ o) << 2, __builtin_bit_cast(int, v)));
    return v;
}
__device__ __forceinline__ void transpose_item(const float* W, int K, int N, bf16_t* WT, int ldk, int koff, int mode, LAS float* scr, int item, int lane, const float* gk = nullptr) {
    const int nblk = N / 32, kb = item / nblk, nb = item % nblk, k0 = 64 * kb, n0 = 32 * nb;
    const int drow0 = (mode == 0 || mode == 3) ? n0 : ((n0 >> 7) * 256 + (mode - 1) * 128 + (n0 & 127));
    float wv_[32];
#pragma unroll
    for (int i = 0; i < 32; ++i) wv_[i] = W[(size_t)(k0 + 2 * i + (lane >> 5)) * N + n0 + (lane & 31)];
#pragma unroll
    for (int i = 0; i < 32; ++i) scr[(2 * i + (lane >> 5)) * 33 + (lane & 31)] = wv_[i];
    LDS_WAIT(); asm volatile("" ::: "memory");
    const int c = lane & 7;
    f32x4 ga = {1.f, 1.f, 1.f, 1.f}, gb = {1.f, 1.f, 1.f, 1.f}; if (gk) { ga = *(const f32x4*)(gk + k0 + 8 * c); gb = *(const f32x4*)(gk + k0 + 8 * c + 4); }
#pragma unroll
    for (int j = 0; j < 4; ++j) { const int n = (lane >> 3) + 8 * j; const LAS float* s = scr + (8 * c) * 33 + n;
        v4u o; o.x = pk2(s[0 * 33] * ga[0], s[1 * 33] * ga[1]); o.y = pk2(s[2 * 33] * ga[2], s[3 * 33] * ga[3]); o.z = pk2(s[4 * 33] * gb[0], s[5 * 33] * gb[1]); o.w = pk2(s[6 * 33] * gb[2], s[7 * 33] * gb[3]);
        int drow = drow0 + n;
        if (mode == 3 && n0 >= 3072) { const int gi = n0 + n - 3072, br = gi >> 10, oc = gi & 1023, r6 = oc & 63; drow = (12 + (oc >> 6)) * 256 + 128 * (br >> 1) + 32 * (r6 >> 4) + 8 * ((r6 & 15) >> 2) + 4 * (br & 1) + (oc & 3); }
        *(v4u*)(WT + (size_t)drow * ldk + koff + k0 + 8 * c) = o; }
    LDS_WAIT(); asm volatile("" ::: "memory");
}
__device__ __forceinline__ void sincos_d(double a, float& s_out, float& c_out) {
    const double k = rint(a * 0.63661977236758134308);
    double r = fma(-k, 1.57079632679489655800e+00, a); r = fma(-k, 6.12323399573676603587e-17, r);
    const double r2 = r * r;
    const double sp = r * (1.0 + r2 * (-1.0 / 6 + r2 * (1.0 / 120 + r2 * (-1.0 / 5040 + r2 * (1.0 / 362880 + r2 * (-1.0 / 39916800 + r2 * (1.0 / 6227020800.0)))))));
    const double cp = 1.0 + r2 * (-0.5 + r2 * (1.0 / 24 + r2 * (-1.0 / 720 + r2 * (1.0 / 40320 + r2 * (-1.0 / 3628800 + r2 * (1.0 / 479001600 + r2 * (-1.0 / 87178291200.0)))))));
    const int q = (int)((long long)k & 3);
    const double s = (q == 0) ? sp : (q == 1) ? cp : (q == 2) ? -sp : -cp;
    const double c = (q == 0) ? cp : (q == 1) ? -sp : (q == 2) ? -cp : sp;
    s_out = (float)s; c_out = (float)c;
}

struct Args { const float* in[36]; float* out; unsigned char* ws; float inv_freq[32]; float lam_init[4]; };

#define LAUNDER_V(x) asm volatile("" : "+v"(x))
#define LAUNDER_S(x) asm volatile("" : "+s"(x))
struct Ctx { LAS unsigned char* lds; int tid, lane, wave, bx, vcu, G, gtid, GT; };
__device__ __forceinline__ Ctx mkctx(LAS unsigned char* lds, int wv) {
    Ctx c; c.lds = lds; int tid = tid_now(wv); LAUNDER_V(tid); int bx = blockIdx.x; LAUNDER_S(bx); int G = gridDim.x; LAUNDER_S(G);
    c.tid = tid; c.lane = tid & 63; c.wave = __builtin_amdgcn_readfirstlane(tid >> 6); c.bx = bx; c.G = G; c.vcu = (G % 8 == 0) ? (bx % 8) * (G / 8) + bx / 8 : bx;
    c.gtid = bx * (NWAVES * 64) + tid; c.GT = G * NWAVES * 64; return c;
}
#define GAS __attribute__((address_space(1)))
template <class T> __device__ __forceinline__ T* lp(T* q) { asm volatile("" : "+s"(q)); return (T*)(GAS T*)q; }
__device__ __forceinline__ const float* inptr(LAS unsigned char* lds, int i) {
    int ii = i; LAUNDER_S(ii);
    const LAS unsigned* t = (const LAS unsigned*)(lds + LDSCTL_OFF) + 2 * ii; const unsigned lo = __builtin_amdgcn_readfirstlane(t[0]), hi = __builtin_amdgcn_readfirstlane(t[1]);
    return (const float*)(GAS const float*)(((unsigned long long)hi << 32) | lo);
}

__device__ __forceinline__ void norm_phase(LAS unsigned char* lds, int wv, const float* X, const float* g, bf16_t* XN) {
    const Ctx c = mkctx(lds, wv);
    const int gw = c.vcu * NWAVES + c.wave, NGW = c.G * NWAVES;
    f32x4 gv[4];
#pragma unroll
    for (int j = 0; j < 4; ++j) gv[j] = *((const f32x4*)g + c.lane + 64 * j);
    for (int m = gw; m < M; m += NGW) {
        const f32x4* xr = (const f32x4*)(X + (size_t)m * D) + c.lane;
        f32x4 v[4]; float s = 0.f;
#pragma unroll
        for (int j = 0; j < 4; ++j) { v[j] = xr[64 * j]; s += (v[j].x * v[j].x + v[j].y * v[j].y) + (v[j].z * v[j].z + v[j].w * v[j].w); }
        const float r = 1.0f / sqrtf(wave_sum(s, c.lane) * (1.f / D) + EPS);
        v2u* o8 = (v2u*)(XN + (size_t)m * D) + c.lane;
#pragma unroll
        for (int j = 0; j < 4; ++j) { v2u w; w.x = pk2(v[j].x * r * gv[j].x, v[j].y * r * gv[j].y); w.y = pk2(v[j].z * r * gv[j].z, v[j].w * r * gv[j].w); o8[64 * j] = w; }
    }
}

constexpr int I_G = (D / 64) * (FF / 32), I_D = (FF / 64) * (D / 32), I_IN = (D / 64) * (ZW / 32), I_PA = (256 / 64) * (D / 32), I_PD = (512 / 64) * (D / 32), I_O = (D / 64) * (D / 32);
constexpr int I_LAYER = 6 * I_G + I_IN + 3 * I_PA + I_PD + I_O; static_assert(I_G == I_D, "item counts");
__device__ __forceinline__ void weight_item(LAS unsigned char* lds, unsigned char* ws, LAS float* scr, int l, int r, int lane) {
    unsigned char* wl = ws + WS_W + (size_t)l * LW_BYTES;
    if (r < I_G) { transpose_item(inptr(lds, 8) + (size_t)l * D * FF, D, FF, (bf16_t*)(wl + LW_GU1), D, 0, 1, scr, r, lane, inptr(lds, 7) + (size_t)l * D); return; } r -= I_G;
    if (r < I_G) { transpose_item(inptr(lds, 9) + (size_t)l * D * FF, D, FF, (bf16_t*)(wl + LW_GU1), D, 0, 2, scr, r, lane, inptr(lds, 7) + (size_t)l * D); return; } r -= I_G;
    if (r < I_D) { transpose_item(inptr(lds, 10) + (size_t)l * FF * D, FF, D, (bf16_t*)(wl + LW_D1), FF, 0, 0, scr, r, lane); return; } r -= I_D;
    if (r < I_IN) { transpose_item(inptr(lds, 12) + (size_t)l * D * ZW, D, ZW, (bf16_t*)(wl + LW_IN), D, 0, 3, scr, r, lane, inptr(lds, 11) + (size_t)l * D); return; } r -= I_IN;
    if (r < I_PA) { transpose_item(inptr(lds, 27) + (size_t)l * 256 * D, 256, D, (bf16_t*)(wl + LW_P), YW, 0, 0, scr, r, lane); return; } r -= I_PA;
    if (r < I_PA) { transpose_item(inptr(lds, 28) + (size_t)l * 256 * D, 256, D, (bf16_t*)(wl + LW_P), YW, 256, 0, scr, r, lane); return; } r -= I_PA;
    if (r < I_PA) { transpose_item(inptr(lds, 29) + (size_t)l * 256 * D, 256, D, (bf16_t*)(wl + LW_P), YW, 512, 0, scr, r, lane); return; } r -= I_PA;
    if (r < I_PD) { transpose_item(inptr(lds, 30) + (size_t)l * 512 * D, 512, D, (bf16_t*)(wl + LW_P), YW, 768, 0, scr, r, lane); return; } r -= I_PD;
    if (r < I_O) { transpose_item(inptr(lds, 31) + (size_t)l * D * D, D, D, (bf16_t*)(wl + LW_O), D, 0, 0, scr, r, lane); return; } r -= I_O;
    if (r < I_G) { transpose_item(inptr(lds, 33) + (size_t)l * D * FF, D, FF, (bf16_t*)(wl + LW_GU2), D, 0, 1, scr, r, lane, inptr(lds, 32) + (size_t)l * D); return; } r -= I_G;
    if (r < I_G) { transpose_item(inptr(lds, 34) + (size_t)l * D * FF, D, FF, (bf16_t*)(wl + LW_GU2), D, 0, 2, scr, r, lane, inptr(lds, 32) + (size_t)l * D); return; } r -= I_G;
    transpose_item(inptr(lds, 35) + (size_t)l * FF * D, FF, D, (bf16_t*)(wl + LW_D2), FF, 0, 0, scr, r, lane);
}
constexpr int NU_GU = (M / 256) * (NGU / 256), NU_IN = (M / 256) * (ZW / 256);
constexpr int IDLE_GU = 256 - NU_GU % 256, IDLE_IN = 256 - NU_IN % 256, IDLE_ALL = 2 * IDLE_GU + IDLE_IN;
constexpr int WS1 = (int)((long)I_LAYER * IDLE_GU / IDLE_ALL), WS2 = WS1 + (int)((long)I_LAYER * IDLE_IN / IDLE_ALL);
static_assert(NU_GU % 256 != 0 && NU_IN % 256 != 0 && WS2 < I_LAYER, "idle-slot weight conversion needs idle workgroups in those phases");
__device__ __forceinline__ void weight_slice(LAS unsigned char* lds, int wv, unsigned char* ws, int l, int beg, int end, int nbusy) {
    const Ctx c = mkctx(lds, wv);
    if (c.G != 256 || l >= DEPTH || c.bx < nbusy) return;
    LAS float* scr = (LAS float*)(lds + RING_OFF + c.wave * 16384);
    const int nset = 256 - nbusy, iset = c.bx - nbusy;
    for (int it = beg + iset * NWAVES + c.wave; it < end; it += nset * NWAVES) weight_item(lds, ws, scr, l, it, c.lane);
}

__device__ __forceinline__ void prologue_phase(LAS unsigned char* lds, int wv, unsigned char* ws, float* X, const Args& args) {
    const Ctx c = mkctx(lds, wv);
    LAS float* scr = (LAS float*)(lds + RING_OFF + c.wave * 16384);
    const int gw = c.vcu * NWAVES + c.wave, NGW = c.G * NWAVES;
    { const int nl = (c.G == 256) ? 1 : DEPTH;
      for (int it = gw; it < nl * I_LAYER; it += NGW) weight_item(lds, ws, scr, it / I_LAYER, it % I_LAYER, c.lane); }
    { const float* s0 = inptr(lds, 0); const float* s1 = inptr(lds, 1); bf16_t* XB = (bf16_t*)(ws + WS_XN); float* SSP = (float*)(ws + WS_SSP); float* SS4 = (float*)(ws + WS_SS4);
      for (int m = gw; m < M; m += NGW) { const f32x4* xr = (const f32x4*)((m < SEQ) ? s0 + (size_t)m * D : s1 + (size_t)(m - SEQ) * D) + c.lane;
          v2u* o8 = (v2u*)(XB + (size_t)m * D) + c.lane; float ss = 0.f;
#pragma unroll
          for (int j = 0; j < 4; ++j) { const f32x4 v = xr[64 * j]; v2u w; w.x = pk2(v.x, v.y); w.y = pk2(v.z, v.w); o8[64 * j] = w; ss += (v.x * v.x + v.y * v.y) + (v.z * v.z + v.w * v.w); }
          ss = wave_sum(ss, c.lane);
          if (m < SEQ) { if (c.lane < 4) SS4[(size_t)m * 4 + c.lane] = (c.lane == 0) ? ss : 0.f; } else if (c.lane < 16) SSP[(size_t)(m - SEQ) * 16 + c.lane] = (c.lane == 0) ? ss : 0.f; } }
    { bf16_t* QS = (bf16_t*)(ws + WS_QS); v4u z = {0u, 0u, 0u, 0u};
      for (size_t i = c.gtid; i < (size_t)DECB * QSROWS * 512 / 8; i += c.GT) ((v4u*)QS)[i] = z;
    }
    { bf16_t* wt = (bf16_t*)(ws + WS_PWT); const float* pw = inptr(lds, 13);
      for (int i = c.gtid; i < DEPTH * 4 * 64 * 64; i += c.GT) { const int k = i & 63, n = (i >> 6) & 63, g = (i >> 12) & 3, l = i >> 14; wt[i] = (bf16_t)f2bf(pw[(((size_t)l * 4 + g) * 64 + k) * 64 + n]); } }
    { float* rope = (float*)(ws + WS_ROPE);
      for (int i = c.gtid; i < ROPE_ROWS * 32; i += c.GT) { const int p = i >> 5, j = i & 31; const float ang = (float)p * args.inv_freq[j]; float s, co; sincos_d((double)ang, s, co); rope[(size_t)p * 64 + j] = co; rope[(size_t)p * 64 + 32 + j] = s; } }
}

__device__ __forceinline__ void mix_phase(LAS unsigned char* lds, int wv, unsigned char* ws, float* out, int l) {
    const Ctx c = mkctx(lds, wv);
    MixP P; P.Z = (const bf16_t*)(ws + WS_Z); P.Y = (bf16_t*)(ws + WS_Y); P.Qp = (bf16_t*)(ws + WS_QP); P.Kp = (bf16_t*)(ws + WS_KP); P.Vp = (bf16_t*)(ws + WS_VP);
    P.QS = (bf16_t*)(ws + WS_QS); P.KS = (bf16_t*)(ws + WS_KS); P.VS = (bf16_t*)(ws + WS_VS); P.out = out;
    P.st_pool = inptr(lds, 4) + (size_t)l * DECB * 15 * 256; P.st_sconv = inptr(lds, 5) + (size_t)l * DECB * 2 * 256; P.st_cconv = inptr(lds, 6) + (size_t)l * DECB * 30 * 256;
    P.pool_w = inptr(lds, 13) + (size_t)l * 4 * 64 * 64; P.pool_scale = inptr(lds, 14) + (size_t)l * 256; P.sconv_w = inptr(lds, 15) + (size_t)l * 3 * 256; P.cconv_w = inptr(lds, 16) + (size_t)l * 31 * 256;
    P.cconv_b = inptr(lds, 17) + (size_t)l * 256; P.ln_g = inptr(lds, 18) + (size_t)l * 256; P.ln_b = inptr(lds, 19) + (size_t)l * 256; P.qg = inptr(lds, 20) + (size_t)l * 64; P.kg = inptr(lds, 21) + (size_t)l * 64;
    P.rope = (const float*)(ws + WS_ROPE); P.layer = l;
    const bf16_t* WTg = (const bf16_t*)(ws + WS_PWT) + (size_t)l * 256 * 64;
    for (int it = c.bx + ((N_MIX_ITEMS - 1 - c.bx) / c.G) * c.G; it >= c.bx; it -= c.G) { const MixItem I = mix_item(it);
        int tl = c.tid; LAUNDER_V(tl);
        if (I.nrows == 32) mixf::item<32>(P, I, WTg, tl, lds + RING_OFF); else mixf::item<16>(P, I, WTg, tl, lds + RING_OFF); }
}

__device__ __forceinline__ void attn_phase(unsigned char* lds_generic, LAS unsigned char* lds, int wv, unsigned char* ws, float* out, int l) {
    const Ctx c = mkctx(lds, wv);
    typedef attn_body::bf16 abf;
    constexpr int NQB = SEQ / 256, NPAIR = 8 * (NQB / 2);
    const abf* QP = (const abf*)(ws + WS_QP); const abf* KP = (const abf*)(ws + WS_KP); const abf* VP = (const abf*)(ws + WS_VP); abf* OB = (abf*)(ws + WS_OB);
    int p = c.vcu, half = 0;
    while (p < NPAIR) { const int map = p / (NQB / 2), s = p % (NQB / 2), qb = half ? NQB - 1 - s : s;
        attn_body::attn_unit<8>(QP + (size_t)qb * 256 * 512 + map * 64, KP + map * 64, VP + (map >> 1) * 128, OB + (size_t)qb * 256 * 1024 + map * 128, 4 * qb + 4, 0, (char*)lds_generic + RING_OFF, c.tid);
        if (half) { p += c.G; half = 0; } else half = 1; }
    const float* ck = inptr(lds, 2) + (size_t)l * DECB * PAST * 512; const float* cv = inptr(lds, 3) + (size_t)l * DECB * PAST * 512;
    const float* knew = out + O_KS + (size_t)l * MS * 512; const float* vnew = out + O_VS + (size_t)l * MS * 512;
    for (int it = c.vcu; it < sattn::N_ITEMS; it += c.G)
        sattn::item(it, ck, cv, knew, vnew, (const bf16_t*)(ws + WS_QS), (float*)(ws + WS_PART), lds + RING_OFF, (LAS float*)(lds + LDSCTL_OFF + 1024), c.tid);
}

__device__ __forceinline__ void post_phase(LAS unsigned char* lds, int wv, unsigned char* ws, int l) {
    const Ctx c = mkctx(lds, wv);
    const LAS float* LAMF = (const LAS float*)(lds + MISC_OFF + 64);
    const float lam = LAMF[l], sc = LAMF[4 + l]; const float* sg = inptr(lds, 26) + (size_t)l * 128;
    const bf16_t* OB = (const bf16_t*)(ws + WS_OB); bf16_t* Y = (bf16_t*)(ws + WS_Y);
    { const int gw = c.vcu * NWAVES + c.wave, NGW = c.G * NWAVES, lane = c.lane, odd = (lane >> 3) & 1, hh = lane >> 4, eo = 16 * (lane & 7) + 8 * odd;
      const f32x4 ga = *(const GAS f32x4*)(sg + eo), gb = *(const GAS f32x4*)(sg + eo + 4);
      for (int m = gw; m < SEQ; m += NGW) { const GAS v4u* src = (const GAS v4u*)(OB + (size_t)m * 1024) + 2 * lane; const v4u w0 = src[0], w1 = src[1];
          float v[16];
          v[0] = __builtin_bit_cast(float, w0.x << 16); v[1] = __builtin_bit_cast(float, w0.x & 0xffff0000u); v[2] = __builtin_bit_cast(float, w0.y << 16); v[3] = __builtin_bit_cast(float, w0.y & 0xffff0000u);
          v[4] = __builtin_bit_cast(float, w0.z << 16); v[5] = __builtin_bit_cast(float, w0.z & 0xffff0000u); v[6] = __builtin_bit_cast(float, w0.w << 16); v[7] = __builtin_bit_cast(float, w0.w & 0xffff0000u);
          v[8] = __builtin_bit_cast(float, w1.x << 16); v[9] = __builtin_bit_cast(float, w1.x & 0xffff0000u); v[10] = __builtin_bit_cast(float, w1.y << 16); v[11] = __builtin_bit_cast(float, w1.y & 0xffff0000u);
          v[12] = __builtin_bit_cast(float, w1.z << 16); v[13] = __builtin_bit_cast(float, w1.z & 0xffff0000u); v[14] = __builtin_bit_cast(float, w1.w << 16); v[15] = __builtin_bit_cast(float, w1.w & 0xffff0000u);
          float o[8], ss = 0.f;
#pragma unroll
          for (int j = 0; j < 8; ++j) { const float send = odd ? v[j] : v[8 + j];
              const float recv = __builtin_bit_cast(float, __builtin_amdgcn_ds_bpermute((lane ^ 8) << 2, __builtin_bit_cast(int, send)));
              o[j] = odd ? (recv - lam * v[8 + j]) : (v[j] - lam * recv); ss += o[j] * o[j]; }
#pragma unroll
          for (int x = 1; x < 16; x <<= 1) ss += __builtin_bit_cast(float, __builtin_amdgcn_ds_bpermute((lane ^ x) << 2, __builtin_bit_cast(int, ss)));
          const float rn = sc / sqrtf(ss * (1.f / 128.f) + EPS);
          v4u wo; wo.x = pk2(o[0] * rn * ga[0], o[1] * rn * ga[1]); wo.y = pk2(o[2] * rn * ga[2], o[3] * rn * ga[3]); wo.z = pk2(o[4] * rn * gb[0], o[5] * rn * gb[1]); wo.w = pk2(o[6] * rn * gb[2], o[7] * rn * gb[3]);
          *(GAS v4u*)(Y + (size_t)m * YW + 768 + hh * 128 + eo) = wo; } }
    for (int idx = c.vcu * NWAVES + c.wave; idx < MS * 4; idx += c.G * NWAVES) { const int ms = idx >> 2, h = idx & 3;
        sattn::post_sample_wave((const float*)(ws + WS_PART), Y + (size_t)(SEQ + ms) * YW + 768 + h * 128, ms / DECS, ms % DECS, h, lam, sc, sg, c.lane); }
}

template <class Epi> __device__ __forceinline__ void gemm_call(LAS unsigned char* lds, int wv, int Mrows, const bf16_t* A, const bf16_t* Bt, int N, int K, int lda, int ldb, const Epi& E) {
    int bx = blockIdx.x; LAUNDER_S(bx); int G = gridDim.x; LAUNDER_S(G);
    pg8::Gemm g{A, Bt, Mrows, N, K, lda, ldb}; pg8::StaticOrder S; S.init(Mrows, N, G, bx);
    pg8::gemm_phase<Epi, pg8::StaticOrder>(lds + RING_OFF, g, S, E, tid_now(wv));
}
template <int MODE> __device__ __forceinline__ void tail_call(LAS unsigned char* lds, int wv, const tailg::Tail<MODE>& t) {
    int bx = blockIdx.x; LAUNDER_S(bx); int G = gridDim.x; LAUNDER_S(G); int tid = tid_now(wv); LAUNDER_V(tid);
    tailg::run<MODE>(lds + RING_OFF, tid, bx, G, t);
}

__global__ void __launch_bounds__(NWAVES * 64, 2) enc_fwd(Args args) {
    extern __shared__ __attribute__((aligned(16))) unsigned char lds_raw[];
    LAS unsigned char* lds = (LAS unsigned char*)lds_raw;
    unsigned char* const ws = args.ws;
    float* const X = args.out;
    int wv;
    {
        const int tid = threadIdx.x;
        wv = __builtin_amdgcn_readfirstlane(tid >> 6);
        for (int u = tid; u < (LDS_BYTES - LDSCTL_OFF) / 4; u += NWAVES * 64) ((LAS unsigned*)(lds + LDSCTL_OFF))[u] = 0u;
        __syncthreads();
        if (tid < 36) ((LAS unsigned long long*)(lds + LDSCTL_OFF))[tid] = (unsigned long long)args.in[tid];
        LAS float* LAMF = (LAS float*)(lds + MISC_OFF + 64);
        if (tid >= 64 && tid < 64 * (1 + DEPTH)) { const int l = (tid >> 6) - 1, i = tid & 63;
            float d1 = args.in[22][l * 64 + i] * args.in[23][l * 64 + i], d2 = args.in[24][l * 64 + i] * args.in[25][l * 64 + i];
#pragma unroll
            for (int o = 1; o < 64; o <<= 1) { d1 += __builtin_bit_cast(float, __builtin_amdgcn_ds_bpermute((i ^ o) << 2, __builtin_bit_cast(int, d1))); d2 += __builtin_bit_cast(float, __builtin_amdgcn_ds_bpermute((i ^ o) << 2, __builtin_bit_cast(int, d2))); }
            if (i == 0) { LAMF[l] = expf(d1) - expf(d2) + args.lam_init[l]; LAMF[4 + l] = 1.0f - args.lam_init[l]; } }
        __syncthreads();
    }
    XcdBarrier bar = xcd_barrier_post((unsigned*)(ws + WS_CTL) + CW_BAR, (volatile LAS unsigned*)(lds + MISC_OFF) + 8, wv);
#define GRID_BAR() xcd_barrier(bar, wv)
    asm volatile("; MARK P0");
    prologue_phase(lds, wv, ws, X, args);
    GRID_BAR();

    for (int l = 0; l < DEPTH; ++l) {
#define WSP(T, off) ((T*)(lp(ws) + (off)))
#define WLP(off) ((const bf16_t*)(lp(ws) + WS_W + (size_t)l * LW_BYTES + (off)))
        asm volatile("; MARK FFN1");
        gemm_call(lds, wv, M, WSP(bf16_t, WS_XN), WLP(LW_GU1), NGU, D, D, D, pg8::EpiSwiGLU{WSP(bf16_t, WS_ACT), pg8::RowScale{WSP(float, WS_SS4), WSP(float, WS_SSP), SEQ}, FF, 0});
        weight_slice(lds, wv, lp(ws), l + 1, 0, WS1, NU_GU % 256); GRID_BAR();
        gemm_call(lds, wv, SEQ, WSP(bf16_t, WS_ACT), WLP(LW_D1), D, FF, FF, FF, pg8::EpiResid{WSP(bf16_t, WS_XN), WSP(float, WS_SS4), (l == DEPTH - 1 && false) ? lp(X) : nullptr, (LAS float*)(lds + LDSCTL_OFF + 1024), D, 0.5f});
        tail_call<0>(lds, wv, tailg::Tail<0>{WSP(bf16_t, WS_ACT), WLP(LW_D1), nullptr, WSP(bf16_t, WS_XN), WSP(float, WS_SSP), nullptr, nullptr, FF, FF, FF, 0, 0.5f, 0}); GRID_BAR();
        asm volatile("; MARK NORM2");
        gemm_call(lds, wv, M, WSP(bf16_t, WS_XN), WLP(LW_IN), ZW, D, D, D, pg8::EpiZ{WSP(bf16_t, WS_Z), WSP(bf16_t, WS_FAC), pg8::RowScale{WSP(float, WS_SS4), WSP(float, WS_SSP), SEQ}, ZW, 12, SEQ / 256, 0});
        weight_slice(lds, wv, lp(ws), l + 1, WS1, WS2, NU_IN % 256); GRID_BAR();
        asm volatile("; MARK MIX");
        mix_phase(lds, wv, lp(ws), lp(X), l); GRID_BAR();
        asm volatile("; MARK ATTN");
        attn_phase(lds_raw, lds, wv, lp(ws), lp(X), l); GRID_BAR();
        asm volatile("; MARK POST");
        post_phase(lds, wv, lp(ws), l); GRID_BAR();
        asm volatile("; MARK MERGE");
        gemm_call(lds, wv, SEQ, WSP(bf16_t, WS_Y), WLP(LW_P), D, YW, YW, YW, pg8::EpiMerged{WSP(bf16_t, WS_MRG), WSP(bf16_t, WS_FAC), D, ZW});
        tail_call<1>(lds, wv, tailg::Tail<1>{WSP(bf16_t, WS_Y), WLP(LW_P), nullptr, nullptr, nullptr, WSP(bf16_t, WS_MRG), WSP(bf16_t, WS_Z) + 3072, YW, YW, YW, ZW, 0.f, 0}); GRID_BAR();
        gemm_call(lds, wv, SEQ, WSP(bf16_t, WS_MRG), WLP(LW_O), D, D, D, D, pg8::EpiResid{WSP(bf16_t, WS_XN), WSP(float, WS_SS4), nullptr, (LAS float*)(lds + LDSCTL_OFF + 1024), D, 1.0f});
        tail_call<0>(lds, wv, tailg::Tail<0>{WSP(bf16_t, WS_MRG), WLP(LW_O), nullptr, WSP(bf16_t, WS_XN), WSP(float, WS_SSP), nullptr, nullptr, D, D, D, 0, 1.0f, 0}); GRID_BAR();
        asm volatile("; MARK FFN2");
        gemm_call(lds, wv, M, WSP(bf16_t, WS_XN), WLP(LW_GU2), NGU, D, D, D, pg8::EpiSwiGLU{WSP(bf16_t, WS_ACT), pg8::RowScale{WSP(float, WS_SS4), WSP(float, WS_SSP), SEQ}, FF, 0});
        weight_slice(lds, wv, lp(ws), l + 1, WS2, I_LAYER, NU_GU % 256); GRID_BAR();
        gemm_call(lds, wv, SEQ, WSP(bf16_t, WS_ACT), WLP(LW_D2), D, FF, FF, FF, pg8::EpiResid{WSP(bf16_t, WS_XN), WSP(float, WS_SS4), (l == DEPTH - 1 && true) ? lp(X) : nullptr, (LAS float*)(lds + LDSCTL_OFF + 1024), D, 0.5f});
        tail_call<0>(lds, wv, tailg::Tail<0>{WSP(bf16_t, WS_ACT), WLP(LW_D2), (l == DEPTH - 1) ? lp(X) : nullptr, WSP(bf16_t, WS_XN), WSP(float, WS_SSP), nullptr, nullptr, FF, FF, FF, 0, 0.5f, 0}); GRID_BAR();
#undef WSP
#undef WLP
    }
#undef GRID_BAR
}

extern "C" void kernel_launch(void* const* d_in, const int* in_sizes, int n_in, void* d_out, int out_size, void* d_ws, size_t ws_size, hipStream_t stream) {
    static int grid = 0;
    if (grid == 0) {
        if (n_in != 36 || in_sizes[0] != SEQ * D || (size_t)out_size != O_END || ws_size < WS_END) { fprintf(stderr, "kernel_launch: unexpected shapes (n_in %d, in0 %d, out %d, ws %zu need %zu)\n", n_in, n_in > 0 ? in_sizes[0] : -1, out_size, ws_size, (size_t)WS_END); grid = -1; return; }
        int dev = 0, cus = 0, per_cu = 0;
        if (hipGetDevice(&dev) != hipSuccess || hipDeviceGetAttribute(&cus, hipDeviceAttributeMultiprocessorCount, dev) != hipSuccess) { grid = -1; return; }
        if (hipFuncSetAttribute((const void*)enc_fwd, hipFuncAttributeMaxDynamicSharedMemorySize, LDS_BYTES) != hipSuccess) { fprintf(stderr, "kernel_launch: hipFuncSetAttribute failed\n"); grid = -1; return; }
        if (hipOccupancyMaxActiveBlocksPerMultiprocessor(&per_cu, (const void*)enc_fwd, NWAVES * 64, LDS_BYTES) != hipSuccess || per_cu < 1) fprintf(stderr, "kernel_launch: occupancy query reports %d\n", per_cu);
        (void)hipGetLastError();
        grid = cus;
    }
    if (grid < 0) return;
    if (hipMemsetAsync((char*)d_ws + WS_CTL, 0, CTL_ZERO_BYTES, stream) != hipSuccess) return;
    Args a; memset(&a, 0, sizeof(a));
    for (int i = 0; i < 36; ++i) a.in[i] = (const float*)d_in[i];
    a.out = (float*)d_out; a.ws = (unsigned char*)d_ws;
    for (int i = 0; i < 32; ++i) a.inv_freq[i] = (float)pow(10000.0, -(double)i / 32.0);
    for (int l = 0; l < 4; ++l) a.lam_init[l] = (float)(0.8 - 0.6 * exp(-0.3 * l));
    hipLaunchKernelGGL(enc_fwd, dim3(grid), dim3(NWAVES * 64), LDS_BYTES, stream, a);
    const hipError_t le = hipPeekAtLastError();
    if (le != hipSuccess) fprintf(stderr, "kernel_launch: launch failed: %s\n", hipGetErrorName(le));
}
#endif
```
